# Optimizing an MI355X kernel written in HIP

```python
import jax
import jax.numpy as jnp
from jax import lax
import numpy as np

D_MODEL = 2048
BATCH = 32
SEQ = 256
DEPTH = 2
DEC_BATCH = 8
DEC_SEQ = 4096
PAST_LEN = 512

GRID_W = 64
N_DIR = 2
N_BRANCH = 3
BRANCH_W = 1024
GLA_HEADS = 4
GLA_DK = 128
GLA_DV = 256
GLA_RANK = 16
GLA_TAU = 16.0
GLA_CHUNK = 64
MLSTM_HEADS = 4
MLSTM_DH = 256
MLSTM_CHUNK = 64
LRU_WIDTH = 1024
LRU_BLOCKS = 8
LRU_BLOCK = 128
LRU_CONV = 4
LRU_C = 8.0
D_FF = 5632
FFN_CONV = 3
EPS = 1e-6
IN_SPLITS = (
    GLA_HEADS * GLA_DK, GLA_HEADS * GLA_DK, GLA_HEADS * GLA_DV, GLA_HEADS * GLA_DV, N_DIR * GLA_RANK,
    MLSTM_HEADS * MLSTM_DH, MLSTM_HEADS * MLSTM_DH, MLSTM_HEADS * MLSTM_DH, MLSTM_HEADS * MLSTM_DH, N_DIR * 2 * MLSTM_HEADS,
    LRU_WIDTH, LRU_WIDTH,
    N_BRANCH * D_MODEL,
)
D_IN = sum(IN_SPLITS)

kernel_name = 'bidir_gla_mlstm_rglru_diffusion_step'


def _flip(t):
    return jnp.flip(t, axis=1)


def _chunks(t, size):
    b, n = t.shape[0], t.shape[1]
    return jnp.moveaxis(t.reshape((b, n // size, size) + t.shape[2:]), 1, 0)


def _unchunks(t):
    n, b, size = t.shape[0], t.shape[1], t.shape[2]
    return jnp.moveaxis(t, 0, 1).reshape((b, n * size) + t.shape[3:])


def rmsnorm(x, g):
    xf = x.astype(jnp.float32)
    y = xf * lax.rsqrt(jnp.mean(xf * xf, axis=-1, keepdims=True) + EPS)
    return (y * g.astype(jnp.float32)).astype(x.dtype)


def head_rmsnorm(x, g):
    b, t, h, d = x.shape
    y = x * lax.rsqrt(jnp.mean(x * x, axis=-1, keepdims=True) + EPS)
    return y.reshape(b, t, h * d) * g.astype(jnp.float32)


def dwconv1d(x, w, bias, left):
    k, t = w.shape[0], x.shape[1]
    xp = jnp.pad(x, ((0, 0), (left, k - 1 - left), (0, 0)))
    return sum(xp[:, j:j + t] * w[j] for j in range(k)) + bias


def dwconv_grid(x, w, bias):
    b, t, ch = x.shape
    rows = t // GRID_W
    p = FFN_CONV // 2
    xg = jnp.pad(x.reshape(b, rows, GRID_W, ch), ((0, 0), (p, p), (p, p), (0, 0)))
    y = sum(xg[:, dy:dy + rows, dx:dx + GRID_W] * w[dy, dx] for dy in range(FFN_CONV) for dx in range(FFN_CONV))
    return (y + bias).reshape(b, t, ch)


def gla_scan(q, k, v, log_a, s0):
    causal = jnp.tril(jnp.ones((GLA_CHUNK, GLA_CHUNK), dtype=bool))

    def step(s, inp):
        qc, kc, vc, lc = inp
        cum = jnp.cumsum(lc, axis=1)
        last = cum[:, -1]
        q_in = qc * jnp.exp(cum)
        k_in = kc * jnp.exp(-cum)
        att = jnp.where(causal, jnp.einsum('bihd,bjhd->bhij', q_in, k_in), 0.0)
        o = jnp.einsum('bhij,bjhv->bihv', att, vc) + jnp.einsum('bihd,bhdv->bihv', q_in, s)
        k_end = kc * jnp.exp(last[:, None] - cum)
        s = jnp.exp(last)[..., None] * s + jnp.einsum('bjhd,bjhv->bhdv', k_end, vc)
        return s, o

    s_end, o = lax.scan(step, s0.astype(jnp.float32), tuple(_chunks(t, GLA_CHUNK) for t in (q, k, v, log_a)))
    return _unchunks(o), s_end


def mlstm_scan(q, k, v, log_f, log_i, c0, n0, m0):
    causal = jnp.tril(jnp.ones((MLSTM_CHUNK, MLSTM_CHUNK), dtype=bool))

    def step(carry, inp):
        cmat, nvec, m = carry
        qc, kc, vc, fc, ic = inp
        fcum = jnp.moveaxis(jnp.cumsum(fc, axis=1), 1, -1)
        ig = jnp.moveaxis(ic, 1, -1)
        dlog = jnp.where(causal, fcum[..., :, None] - fcum[..., None, :] + ig[..., None, :], -jnp.inf)
        prev = fcum + m[..., None]
        mj = jnp.maximum(prev, jnp.max(dlog, axis=-1))
        w = jnp.exp(dlog - mj[..., None])
        wp = jnp.moveaxis(jnp.exp(prev - mj), -1, 1)[..., None]
        s = jnp.einsum('bjhd,bihd->bhji', qc, kc) * w
        qp = qc * wp
        num = jnp.einsum('bhji,bihv->bjhv', s, vc) + jnp.einsum('bjhd,bhdv->bjhv', qp, cmat)
        den = jnp.moveaxis(jnp.sum(s, axis=-1), -1, 1) + jnp.einsum('bjhd,bhd->bjh', qp, nvec)
        floor = jnp.moveaxis(jnp.exp(-mj), -1, 1)
        h = num / jnp.maximum(jnp.abs(den), floor)[..., None]
        m_new = mj[..., -1]
        wl = jnp.exp(fcum[..., -1:] - fcum + ig - m_new[..., None])
        decay = jnp.exp(fcum[..., -1] + m - m_new)
        kw = kc * jnp.moveaxis(wl, -1, 1)[..., None]
        cmat = decay[..., None, None] * cmat + jnp.einsum('bihd,bihv->bhdv', kw, vc)
        nvec = decay[..., None] * nvec + jnp.sum(kw, axis=1)
        return (cmat, nvec, m_new), h

    f32 = jnp.float32
    init = (c0.astype(f32), n0.astype(f32), m0.astype(f32))
    (c_end, n_end, m_end), h = lax.scan(step, init, tuple(_chunks(t, MLSTM_CHUNK) for t in (q, k, v, log_f, log_i)))
    return _unchunks(h), c_end, n_end, m_end


def rglru_dir(x, gate_w, gate_b, lam, h0):
    b, t, w = x.shape
    f32 = jnp.float32
    xb = x.reshape(b, t, LRU_BLOCKS, LRU_BLOCK)
    pre = jnp.einsum('btnk,gnkj->gbtnj', xb, gate_w.astype(f32)).reshape(2, b, t, w)
    gates = jax.nn.sigmoid(pre + gate_b.astype(f32)[:, None, None, :])
    log_a = -LRU_C * gates[0] * jax.nn.softplus(-lam.astype(f32))
    a = jnp.exp(log_a)
    inp = jnp.sqrt(-jnp.expm1(2.0 * log_a)) * (gates[1] * x)
    inp = inp.at[:, 0].add(a[:, 0] * h0.astype(f32))

    def combine(left, right):
        return left[0] * right[0], right[0] * left[1] + right[1]

    _, h = lax.associative_scan(combine, (a, inp), axis=1)
    return h, h[:, -1]


def token_mix(u, init, w_in, gla_w_alpha, gla_b_alpha, gla_norm_g, mlstm_b_if, mlstm_norm_g,
              lru_conv_w, lru_conv_b, lru_gate_w, lru_gate_b, lru_lambda, w_branch, b_merge, w_out):
    b, t, _ = u.shape
    f32 = jnp.float32
    s_gla0, c_ml0, n_ml0, m_ml0, h_lru0 = init
    z = u @ w_in
    (qa, ka, va, ga, ra, qb, kb, vb, ob, gb, xr, yr, mg) = jnp.split(z, np.cumsum(IN_SPLITS)[:-1].tolist(), axis=-1)

    qa = qa.reshape(b, t, GLA_HEADS, GLA_DK).astype(f32) * GLA_DK ** -0.5
    ka = ka.reshape(b, t, GLA_HEADS, GLA_DK).astype(f32)
    va = va.reshape(b, t, GLA_HEADS, GLA_DV).astype(f32)
    la = jax.nn.log_sigmoid(jnp.einsum('btnr,nrk->btnk', ra.reshape(b, t, N_DIR, GLA_RANK).astype(f32),
                                       gla_w_alpha.astype(f32)) + gla_b_alpha.astype(f32)) / GLA_TAU
    la = la.reshape(b, t, N_DIR, GLA_HEADS, GLA_DK)
    oa_f, sa_f = gla_scan(qa, ka, va, la[:, :, 0], s_gla0[:, 0])
    oa_r, sa_r = gla_scan(_flip(qa), _flip(ka), _flip(va), _flip(la[:, :, 1]), s_gla0[:, 1])
    y_a = head_rmsnorm(oa_f + _flip(oa_r), gla_norm_g) * jax.nn.silu(ga.astype(f32))

    qb = qb.reshape(b, t, MLSTM_HEADS, MLSTM_DH).astype(f32)
    kb = kb.reshape(b, t, MLSTM_HEADS, MLSTM_DH).astype(f32) * MLSTM_DH ** -0.5
    vb = vb.reshape(b, t, MLSTM_HEADS, MLSTM_DH).astype(f32)
    gif = gb.reshape(b, t, N_DIR, 2, MLSTM_HEADS).astype(f32) + mlstm_b_if.astype(f32)
    log_i = gif[:, :, :, 0]
    log_f = jax.nn.log_sigmoid(gif[:, :, :, 1])
    hb_f, cb_f, nb_f, mb_f = mlstm_scan(qb, kb, vb, log_f[:, :, 0], log_i[:, :, 0], c_ml0[:, 0], n_ml0[:, 0], m_ml0[:, 0])
    hb_r, cb_r, nb_r, mb_r = mlstm_scan(_flip(qb), _flip(kb), _flip(vb), _flip(log_f[:, :, 1]), _flip(log_i[:, :, 1]),
                                        c_ml0[:, 1], n_ml0[:, 1], m_ml0[:, 1])
    y_b = jax.nn.sigmoid(ob.astype(f32)) * head_rmsnorm(hb_f + _flip(hb_r), mlstm_norm_g)

    xr = dwconv1d(xr.astype(f32), lru_conv_w.astype(f32), lru_conv_b.astype(f32), LRU_CONV // 2)
    hc_f, hc_f_end = rglru_dir(xr, lru_gate_w[0], lru_gate_b[0], lru_lambda[0], h_lru0[:, 0])
    hc_r, hc_r_end = rglru_dir(_flip(xr), lru_gate_w[1], lru_gate_b[1], lru_lambda[1], h_lru0[:, 1])
    y_c = (hc_f + _flip(hc_r)) * jax.nn.gelu(yr.astype(f32))

    g = jax.nn.sigmoid(mg.reshape(b, t, N_BRANCH, D_MODEL).astype(f32) + b_merge.reshape(N_BRANCH, D_MODEL).astype(f32))
    merged = sum(g[:, :, n] * (y @ w_branch[n]) for n, y in enumerate((y_a, y_b, y_c)))
    out = merged.astype(u.dtype) @ w_out
    new_state = (jnp.stack([sa_f, sa_r], axis=1), jnp.stack([cb_f, cb_r], axis=1), jnp.stack([nb_f, nb_r], axis=1),
                 jnp.stack([mb_f, mb_r], axis=1), jnp.stack([hc_f_end, hc_r_end], axis=1))
    return out, new_state


def conv_ffn(v, w_up, conv_w, conv_b, w_down, on_grid):
    hg, hu = jnp.split(v @ w_up, 2, axis=-1)
    if on_grid:
        hg = dwconv_grid(hg, conv_w, conv_b)
    else:
        hg = dwconv1d(hg, conv_w[FFN_CONV // 2], conv_b, FFN_CONV // 2)
    return (jax.nn.silu(hg) * hu) @ w_down


def block(x, mod, on_grid, init, lp):
    (n1, n2, w_in, gwa, gba, gng, mbif, mng, lcw, lcb, lgw, lgb, llam, wbr, bmg, wout, fup, fcw, fcb, fdown) = lp
    sh1, sc1, g1, sh2, sc2, g2 = jnp.split(mod, 6, axis=-1)
    u = rmsnorm(x, n1) * (1.0 + sc1) + sh1
    mix, new_state = token_mix(u, init, w_in, gwa, gba, gng, mbif, mng, lcw, lcb, lgw, lgb, llam, wbr, bmg, wout)
    x = x + g1 * mix
    v = rmsnorm(x, n2) * (1.0 + sc2) + sh2
    x = x + g2 * conv_ffn(v, fup, fcw, fcb, fdown, on_grid)
    return x, new_state


def zero_context_state(b):
    f32 = jnp.float32
    return (jnp.zeros((b, N_DIR, GLA_HEADS, GLA_DK, GLA_DV), f32),
            jnp.zeros((b, N_DIR, MLSTM_HEADS, MLSTM_DH, MLSTM_DH), f32),
            jnp.zeros((b, N_DIR, MLSTM_HEADS, MLSTM_DH), f32),
            jnp.zeros((b, N_DIR, MLSTM_HEADS), f32),
            jnp.zeros((b, N_DIR, LRU_WIDTH), f32))


def setup_inputs(seed: int = 0) -> dict:
    key = jax.random.key(seed)
    keys = iter(jax.random.split(key, 40))
    f32 = jnp.float32
    d = D_MODEL

    def nrm(shape, scale):
        return jax.random.normal(next(keys), shape, f32) * scale

    a_c = jax.random.uniform(next(keys), (DEPTH, N_DIR, LRU_WIDTH), f32, 0.9, 0.999)
    a = a_c ** (1.0 / LRU_C)
    lru_lambda = jnp.log(a) - jnp.log1p(-a)
    return {
        'x_prompt': nrm((BATCH, SEQ, d), 1.0),
        'x_sample': nrm((DEC_BATCH, DEC_SEQ, d), 1.0),
        'state_gla': nrm((DEC_BATCH, DEPTH, N_DIR, GLA_HEADS, GLA_DK, GLA_DV), 1.0),
        'state_mlstm_c': nrm((DEC_BATCH, DEPTH, N_DIR, MLSTM_HEADS, MLSTM_DH, MLSTM_DH), 0.1),
        'state_mlstm_n': nrm((DEC_BATCH, DEPTH, N_DIR, MLSTM_HEADS, MLSTM_DH), 0.2),
        'state_mlstm_m': nrm((DEC_BATCH, DEPTH, N_DIR, MLSTM_HEADS), 1.0),
        'state_rglru': nrm((DEC_BATCH, DEPTH, N_DIR, LRU_WIDTH), 0.5),
        'c': nrm((DEC_BATCH, d), 1.0),
        'c_ctx': nrm((d,), 1.0),
        'norm1_g': 1.0 + nrm((DEPTH, d), 0.02),
        'norm2_g': 1.0 + nrm((DEPTH, d), 0.02),
        'w_mod': nrm((DEPTH, d, 6 * d), 0.5 * d ** -0.5),
        'b_mod': nrm((DEPTH, 6 * d), 0.01),
        'w_in': nrm((DEPTH, d, D_IN), d ** -0.5),
        'gla_w_alpha': nrm((DEPTH, N_DIR, GLA_RANK, GLA_HEADS * GLA_DK), GLA_RANK ** -0.5),
        'gla_b_alpha': nrm((DEPTH, N_DIR, GLA_HEADS * GLA_DK), 0.1),
        'gla_norm_g': 1.0 + nrm((DEPTH, GLA_HEADS * GLA_DV), 0.02),
        'mlstm_b_if': nrm((DEPTH, N_DIR, 2, MLSTM_HEADS), 0.1) + jnp.array([0.0, 3.0], f32)[:, None],
        'mlstm_norm_g': 1.0 + nrm((DEPTH, MLSTM_HEADS * MLSTM_DH), 0.02),
        'lru_conv_w': nrm((DEPTH, LRU_CONV, LRU_WIDTH), LRU_CONV ** -0.5),
        'lru_conv_b': nrm((DEPTH, LRU_WIDTH), 0.01),
        'lru_gate_w': nrm((DEPTH, N_DIR, 2, LRU_BLOCKS, LRU_BLOCK, LRU_BLOCK), LRU_BLOCK ** -0.5),
        'lru_gate_b': nrm((DEPTH, N_DIR, 2, LRU_WIDTH), 0.01),
        'lru_lambda': lru_lambda,
        'w_branch': nrm((DEPTH, N_BRANCH, BRANCH_W, d), BRANCH_W ** -0.5),
        'b_merge': nrm((DEPTH, N_BRANCH * d), 0.01),
        'w_out': nrm((DEPTH, d, d), d ** -0.5),
        'ffn_w_up': nrm((DEPTH, d, 2 * D_FF), d ** -0.5),
        'ffn_conv_w': nrm((DEPTH, FFN_CONV, FFN_CONV, D_FF), 1.0 / FFN_CONV),
        'ffn_conv_b': nrm((DEPTH, D_FF), 0.01),
        'ffn_w_down': nrm((DEPTH, D_FF, d), D_FF ** -0.5),
        'norm_f_g': 1.0 + nrm((d,), 0.02),
    }


def reference(x_prompt, x_sample, state_gla, state_mlstm_c, state_mlstm_n, state_mlstm_m, state_rglru, c, c_ctx,
              norm1_g, norm2_g, w_mod, b_mod, w_in, gla_w_alpha, gla_b_alpha, gla_norm_g, mlstm_b_if, mlstm_norm_g,
              lru_conv_w, lru_conv_b, lru_gate_w, lru_gate_b, lru_lambda, w_branch, b_merge, w_out,
              ffn_w_up, ffn_conv_w, ffn_conv_b, ffn_w_down, norm_f_g):
    xp, xs = x_prompt, x_sample
    ctx_init = zero_context_state(x_prompt.shape[0])
    new_gla, new_mc, new_mn, new_mm, new_lru = [], [], [], [], []
    for l in range(DEPTH):
        lp = (norm1_g[l], norm2_g[l], w_in[l], gla_w_alpha[l], gla_b_alpha[l], gla_norm_g[l], mlstm_b_if[l],
              mlstm_norm_g[l], lru_conv_w[l], lru_conv_b[l], lru_gate_w[l], lru_gate_b[l], lru_lambda[l],
              w_branch[l], b_merge[l], w_out[l], ffn_w_up[l], ffn_conv_w[l], ffn_conv_b[l], ffn_w_down[l])
        mod_ctx = (jax.nn.silu(c_ctx) @ w_mod[l] + b_mod[l])[None, None, :]
        mod_lat = (jax.nn.silu(c) @ w_mod[l] + b_mod[l])[:, None, :]
        xp, st = block(xp, mod_ctx, False, ctx_init, lp)
        new_gla.append(st[0])
        new_mc.append(st[1])
        new_mn.append(st[2])
        new_mm.append(st[3])
        new_lru.append(st[4])
        lat_init = (state_gla[:, l], state_mlstm_c[:, l], state_mlstm_n[:, l], state_mlstm_m[:, l], state_rglru[:, l])
        xs, _ = block(xs, mod_lat, True, lat_init, lp)
    y_prompt = rmsnorm(xp, norm_f_g)
    y_sample = rmsnorm(xs, norm_f_g)
    new_state_gla = jnp.stack(new_gla, axis=1)
    new_state_mlstm_c = jnp.stack(new_mc, axis=1)
    new_state_mlstm_n = jnp.stack(new_mn, axis=1)
    new_state_mlstm_m = jnp.stack(new_mm, axis=1)
    new_state_rglru = jnp.stack(new_lru, axis=1)
    return (y_prompt, y_sample, new_state_gla, new_state_mlstm_c, new_state_mlstm_n, new_state_mlstm_m, new_state_rglru)
```

```cpp
#include <hip/hip_runtime.h>
#include <cstdio>
#include <cstdint>

#ifndef MK_PER_PHASE
#define MK_PER_PHASE 1
#endif

#ifndef DBG_DIR
#define DBG_DIR 0
#endif
#ifndef DBG_CHUNK
#define DBG_CHUNK 0
#endif
#ifndef DBG_CHECKS
#define DBG_CHECKS 0
#endif
#ifndef DBG_MASK
#define DBG_MASK 1
#endif
#ifndef DBG_STATIC_Q
#define DBG_STATIC_Q 0
#endif
#define LAS __attribute__((address_space(3)))
typedef unsigned short bf16_t;
typedef short bf16x8 __attribute__((ext_vector_type(8)));
typedef float f32x4 __attribute__((ext_vector_type(4)));
typedef float f32x2 __attribute__((ext_vector_type(2)));
typedef unsigned u32x4 __attribute__((ext_vector_type(4)));
typedef unsigned u32x2 __attribute__((ext_vector_type(2)));

constexpr int D = 2048, NCTX = 8192, NTOK = 40960, TG = 20480;
constexpr int ZLD = 15360, NZ = 15616, DFF = 5632, NUP = 11264;
constexpr int NTHREADS = 512;
constexpr float EPS = 1e-6f;

constexpr size_t MiB = 1u << 20;
constexpr size_t WS_CTL = 0, CTL_BYTES = 1 * MiB;
constexpr size_t WS_MOD = 1 * MiB;
constexpr size_t WS_W = 2 * MiB;
constexpr size_t W_IN = WS_W;
constexpr size_t W_BR = W_IN + (size_t)NZ * D * 2;
constexpr size_t W_OUT = W_BR + (size_t)3 * D * 1024 * 2;
constexpr size_t W_UP = W_OUT + (size_t)D * D * 2;
constexpr size_t W_DOWN = W_UP + (size_t)NUP * D * 2;
constexpr size_t W_LRU = W_DOWN + (size_t)D * DFF * 2;
constexpr size_t W_END = W_LRU + (size_t)32 * 128 * 128 * 2;
static_assert(W_END == 150 * MiB, "weight block");
constexpr size_t WS_U = 150 * MiB;
constexpr size_t WS_SM = 230 * MiB;
constexpr size_t WS_Z = 235 * MiB;
constexpr size_t WS_O = 835 * MiB;
constexpr size_t WS_SLAB = WS_O + 120 * MiB;
constexpr size_t WS_END = 1075 * MiB;
constexpr size_t WS_DBG = 1076 * MiB;
constexpr int CW_BAR = 4096;
constexpr int CW_Q = 16384;

constexpr int ZC_QA = 0, ZC_KA = 512, ZC_VA = 1024, ZC_GA = 2048, ZC_QB = 3072, ZC_KB = 4096, ZC_VB = 5120, ZC_OB = 6144, ZC_XR = 7168, ZC_YR = 8192, ZC_MG = 9216;

constexpr int LDS_BYTES = 155648;
constexpr int LDS_MISC = 153600;

struct Params {
    const float* in[32];
    float* out;
    unsigned char* ws;
    int ph_lo, ph_hi;
};

__device__ __forceinline__ float bf2f(unsigned short h) { return __uint_as_float(((unsigned)h) << 16); }
__device__ __forceinline__ unsigned short f2bf(float f) { unsigned u = __float_as_uint(f); return (unsigned short)((u + 0x7fffu + ((u >> 16) & 1u)) >> 16); }
typedef __bf16 bf16x2_t __attribute__((ext_vector_type(2)));
__device__ __forceinline__ unsigned cvt_pk_bf16(float lo, float hi) { const f32x2 f = {lo, hi}; const bf16x2_t v = __builtin_convertvector(f, bf16x2_t); return __builtin_bit_cast(unsigned, v); }
__device__ __forceinline__ float sigmoid_f(float x) { return 1.f / (1.f + __expf(-x)); }
__device__ __forceinline__ float silu_f(float x) { return x * sigmoid_f(x); }
__device__ __forceinline__ float logsigmoid_f(float x) { return fminf(x, 0.f) - log1pf(__expf(-fabsf(x))); }
__device__ __forceinline__ float softplus_f(float x) { return fmaxf(x, 0.f) + log1pf(__expf(-fabsf(x))); }
__device__ __forceinline__ float gelu_tanh_f(float x) { const float u = 0.7978845608028654f * (x + 0.044715f * x * x * x); const float t = 1.f - 2.f / (1.f + __expf(2.f * u)); return 0.5f * x * (1.f + t); }
__device__ __forceinline__ float wave_sum(float v) {
#pragma unroll
    for (int o = 1; o < 64; o <<= 1) v += __shfl_xor(v, o);
    return v;
}
__device__ __forceinline__ int tidx() { int t = threadIdx.x; asm volatile("" : "+v"(t)); return t; }
#define LDS_WAIT() asm volatile("s_waitcnt lgkmcnt(0)" ::: "memory")
#define VM_WAIT() asm volatile("s_waitcnt vmcnt(0)" ::: "memory")

namespace pg8 {
constexpr int BM = 256, BK = 64, HALF = 128, HTB = HALF * BK * 2, STAGE_BYTES = 8 * HTB, NXCD = 8, WGM = 8;
__host__ __device__ __forceinline__ int lds_byte(int r, int c) { const int st = (r >> 4) * 2 + (c >> 5), rr = r & 15, cc = c & 31, ob = rr * 64 + cc * 2; return st * 1024 + (ob ^ (((ob >> 9) & 1) << 5)); }
__host__ __device__ __forceinline__ void stage_rc(int b, int& R, int& C) { const int st = b / 1024, sb = b % 1024, swz = sb ^ (((sb >> 9) & 1) << 5); R = (st >> 1) * 16 + swz / 64; C = (st & 1) * 32 + (swz % 64) / 2; }
__host__ __device__ __forceinline__ int perm32(int rho) { const int n = rho >> 4, i = rho & 15; return 8 * (i >> 2) + 4 * n + (i & 3); }
struct Unit { int pm, pn; };
struct Gemm { const bf16_t* A; const bf16_t* Bt; int M, N, K; };
struct StaticOrder {
    int nM, nN, nwg, G, c;
    __device__ void init(int M, int N, int G_, int c_) { nM = M / BM; nN = N / BM; nwg = nM * nN; G = G_; c = c_; }
    __device__ bool next(int i, Unit& u) const {
        const long L = (long)i * G + c; if (L >= nwg) return false;
        int wgid = (int)L; { const int q = nwg / NXCD, r = nwg % NXCD, xcd = wgid % NXCD, off = wgid / NXCD; wgid = (xcd < r ? xcd * (q + 1) : r * (q + 1) + (xcd - r) * q) + off; }
        const int nig = WGM * nN, gid = wgid / nig, fm = gid * WGM, gsz = (nM - fm) < WGM ? (nM - fm) : WGM;
        u.pm = fm + ((wgid % nig) % gsz); u.pn = (wgid % nig) / gsz; return true;
    }
};
struct BranchOrder {
    int G, c;
    __device__ bool next(int i, Unit& u) const {
        const int L = (i / 3) * G + c, n = i % 3; if (L >= 80 * 8) return false;
        u.pm = n * 80 + (L >> 3); u.pn = n * 8 + (L & 7); return true;
    }
};

template <class Epi, class Sched, bool ALIGN_EPI, bool SP2>
__device__ __forceinline__ void gemm_phase(LAS unsigned char* lds, const Gemm g, const Sched& S, const Epi& E) {
    const int tid = tidx(), wid = __builtin_amdgcn_readfirstlane(tid >> 6), lane = tid & 63, wr = wid >> 2, wc = wid & 3, fr = lane & 15, fq = lane >> 4;
    const int K = g.K, nt = K / BK;
    unsigned voffA[2], voffB[2];
#pragma unroll
    for (int i = 0; i < 2; ++i) { int R, C; stage_rc(tid * 16 + i * 8192, R, C); const int Rb = Epi::PERM ? ((R & ~31) + perm32(R & 31)) : R;
        voffA[i] = (unsigned)(R * K + C) * 2u; voffB[i] = (unsigned)(Rb * K + C) * 2u; }
    const size_t kstep = (size_t)(BK * 2);
    const size_t hstep = (size_t)HALF * K * 2;
    const size_t tstep = 2 * hstep;
    const unsigned ldsw = (unsigned)wid * 1024u;
    const int aoff = lds_byte(wr * 64 + fr, fq * 8), boff = lds_byte(wc * 32 + fr, fq * 8);
#define PG8_SA(b, h) (((b) * 2 + (h)) * HTB)
#define PG8_SB(b, h) ((4 + (b) * 2 + (h)) * HTB)
#define PG8_STAGE(bufoff, gbase, voff) do { _Pragma("unroll") for (int _i = 0; _i < 2; ++_i) \
        __builtin_amdgcn_global_load_lds((const unsigned*)((const char*)(gbase) + (voff)[_i]), (LAS unsigned*)(lds + (bufoff) + ldsw + _i * 8192), 16, 0, 0); } while (0)
#define PG8_LDA(dst, b, h) do { _Pragma("unroll") for (int m = 0; m < 4; ++m) _Pragma("unroll") for (int k = 0; k < 2; ++k) dst[m][k] = *(const LAS bf16x8*)(lds + PG8_SA(b, h) + aoff + m * 2048 + k * 1024); } while (0)
#define PG8_LDB(dst, b, h) do { _Pragma("unroll") for (int n = 0; n < 2; ++n) _Pragma("unroll") for (int k = 0; k < 2; ++k) dst[n][k] = *(const LAS bf16x8*)(lds + PG8_SB(b, h) + boff + n * 2048 + k * 1024); } while (0)
#define PG8_MMA(ai, bj, At, Bt) do { __builtin_amdgcn_s_setprio(1); _Pragma("unroll") for (int m = 0; m < 4; ++m) _Pragma("unroll") for (int n = 0; n < 2; ++n) _Pragma("unroll") for (int k = 0; k < 2; ++k) \
        acc[ai][bj][m][n] = __builtin_amdgcn_mfma_f32_16x16x32_bf16(Bt[n][k], At[m][k], acc[ai][bj][m][n], 0, 0, 0); __builtin_amdgcn_s_setprio(0); } while (0)
#define PG8_WAIT_V(n) asm volatile("s_waitcnt vmcnt(" #n ")" ::: "memory")
#define PG8_WAIT_L(n) asm volatile("s_waitcnt lgkmcnt(" #n ")" ::: "memory")
#define PG8_BAR __builtin_amdgcn_s_barrier()
#define PG8_SCHED __builtin_amdgcn_sched_barrier(0)
    Unit cur, nxt; int ui = 0;
    if (!S.next(0, cur)) return;
    f32x4 acc[2][2][4][2];
#pragma unroll
    for (int a = 0; a < 2; ++a)
#pragma unroll
        for (int b = 0; b < 2; ++b)
#pragma unroll
            for (int m = 0; m < 4; ++m)
#pragma unroll
                for (int n = 0; n < 2; ++n) acc[a][b][m][n] = (f32x4){0.f, 0.f, 0.f, 0.f};
    bf16x8 At[4][2], B0[2][2], B1[2][2];
    const char* cA = (const char*)g.A + (size_t)cur.pm * tstep; const char* cB = (const char*)g.Bt + (size_t)cur.pn * tstep;
    if constexpr (SP2) {
        PG8_STAGE(PG8_SB(0, 0), cB, voffB); PG8_STAGE(PG8_SB(0, 1), cB + hstep, voffB); PG8_STAGE(PG8_SA(0, 0), cA, voffA); PG8_STAGE(PG8_SA(0, 1), cA + hstep, voffA);
        if (wr == 1) PG8_BAR;
        PG8_WAIT_V(2); PG8_BAR;
        PG8_STAGE(PG8_SB(1, 0), cB + kstep, voffB); PG8_STAGE(PG8_SA(1, 0), cA + kstep, voffA); PG8_STAGE(PG8_SB(1, 1), cB + hstep + kstep, voffB);
        PG8_WAIT_V(6); PG8_BAR;
    } else {
        PG8_STAGE(PG8_SB(0, 0), cB, voffB); PG8_STAGE(PG8_SA(0, 0), cA, voffA); PG8_STAGE(PG8_SB(0, 1), cB + hstep, voffB); PG8_STAGE(PG8_SA(0, 1), cA + hstep, voffA);
        if (wr == 1) PG8_BAR;
        PG8_WAIT_V(4); PG8_BAR;
        PG8_STAGE(PG8_SB(1, 0), cB + kstep, voffB); PG8_STAGE(PG8_SA(1, 0), cA + kstep, voffA); PG8_STAGE(PG8_SB(1, 1), cB + hstep + kstep, voffB);
        PG8_WAIT_V(6); PG8_BAR;
    }
    for (;;) {
        const bool has_next = S.next(ui + 1, nxt);
        const char* nA = has_next ? (const char*)g.A + (size_t)nxt.pm * tstep : cA; const char* nB = has_next ? (const char*)g.Bt + (size_t)nxt.pn * tstep : cB;
        for (int t = 0; t < nt; t += 2) {
            const bool last = (t == nt - 2);
            const char* a1 = cA + (size_t)(t + 1) * kstep;
            const char* a2 = last ? nA : cA + (size_t)(t + 2) * kstep; const char* b2 = last ? nB : cB + (size_t)(t + 2) * kstep;
            const char* a3 = a2 + kstep; const char* b3 = b2 + kstep;
            if constexpr (SP2) {
            PG8_LDB(B0, 0, 0); PG8_LDB(B1, 0, 1); PG8_SCHED; PG8_LDA(At, 0, 0); PG8_STAGE(PG8_SA(1, 1), a1 + hstep, voffA);
            PG8_WAIT_V(8); PG8_WAIT_L(0); PG8_BAR; PG8_MMA(0, 0, At, B0); PG8_MMA(0, 1, At, B1); PG8_BAR; PG8_SCHED;
            PG8_LDA(At, 0, 1); PG8_STAGE(PG8_SB(0, 0), b2, voffB); PG8_STAGE(PG8_SB(0, 1), b2 + hstep, voffB); PG8_STAGE(PG8_SA(0, 0), a2, voffA);
            PG8_WAIT_V(8); PG8_WAIT_L(0); PG8_BAR; PG8_MMA(1, 0, At, B0); PG8_MMA(1, 1, At, B1); PG8_BAR; PG8_SCHED;
            PG8_LDB(B0, 1, 0); PG8_LDB(B1, 1, 1); PG8_SCHED; PG8_LDA(At, 1, 0); PG8_STAGE(PG8_SA(0, 1), a2 + hstep, voffA);
            PG8_WAIT_V(8); PG8_WAIT_L(0); PG8_BAR; PG8_MMA(0, 0, At, B0); PG8_MMA(0, 1, At, B1); PG8_BAR; PG8_SCHED;
            PG8_LDA(At, 1, 1); PG8_STAGE(PG8_SB(1, 0), b3, voffB); PG8_STAGE(PG8_SB(1, 1), b3 + hstep, voffB); PG8_STAGE(PG8_SA(1, 0), a3, voffA);
            PG8_WAIT_V(8); PG8_WAIT_L(0); PG8_BAR; PG8_MMA(1, 0, At, B0); PG8_MMA(1, 1, At, B1); PG8_BAR; PG8_SCHED;
            } else {
            PG8_LDB(B0, 0, 0); PG8_SCHED; PG8_LDA(At, 0, 0); PG8_STAGE(PG8_SA(1, 1), a1 + hstep, voffA);
            PG8_WAIT_L(8); PG8_BAR; PG8_WAIT_L(0); PG8_MMA(0, 0, At, B0); PG8_BAR; PG8_SCHED;
            PG8_LDB(B1, 0, 1); PG8_STAGE(PG8_SB(0, 0), b2, voffB);
            PG8_BAR; PG8_WAIT_L(0); PG8_MMA(0, 1, At, B1); PG8_BAR;
            PG8_LDA(At, 0, 1); PG8_STAGE(PG8_SA(0, 0), a2, voffA);
            PG8_BAR; PG8_WAIT_L(0); PG8_MMA(1, 0, At, B0); PG8_BAR; PG8_SCHED;
            PG8_STAGE(PG8_SB(0, 1), b2 + hstep, voffB);
            PG8_WAIT_V(6); PG8_BAR; PG8_MMA(1, 1, At, B1); PG8_BAR;
            PG8_LDB(B0, 1, 0); PG8_SCHED; PG8_LDA(At, 1, 0); PG8_STAGE(PG8_SA(0, 1), a2 + hstep, voffA);
            PG8_WAIT_L(8); PG8_BAR; PG8_WAIT_L(0); PG8_MMA(0, 0, At, B0); PG8_BAR; PG8_SCHED;
            PG8_LDB(B1, 1, 1); PG8_STAGE(PG8_SB(1, 0), b3, voffB);
            PG8_BAR; PG8_WAIT_L(0); PG8_MMA(0, 1, At, B1); PG8_BAR;
            PG8_LDA(At, 1, 1); PG8_STAGE(PG8_SA(1, 0), a3, voffA);
            PG8_BAR; PG8_WAIT_L(0); PG8_MMA(1, 0, At, B0); PG8_BAR; PG8_SCHED;
            PG8_STAGE(PG8_SB(1, 1), b3 + hstep, voffB);
            PG8_WAIT_V(6); PG8_BAR; PG8_MMA(1, 1, At, B1); PG8_BAR;
            }
        }
        if constexpr (ALIGN_EPI) { if (wr == 0) PG8_BAR; }
        E(acc, cur, wr, wc, fr, fq);
        if (!has_next) break;
#pragma unroll
        for (int a = 0; a < 2; ++a)
#pragma unroll
            for (int b = 0; b < 2; ++b)
#pragma unroll
                for (int m = 0; m < 4; ++m)
#pragma unroll
                    for (int n = 0; n < 2; ++n) acc[a][b][m][n] = (f32x4){0.f, 0.f, 0.f, 0.f};
        cur = nxt; cA = nA; cB = nB; ++ui;
        if constexpr (ALIGN_EPI) { if (wr == 1) PG8_BAR; }
    }
    PG8_WAIT_V(0);
    if constexpr (!ALIGN_EPI) { if (wr == 0) PG8_BAR; }
    PG8_BAR;
#undef PG8_SA
#undef PG8_SB
#undef PG8_STAGE
#undef PG8_LDA
#undef PG8_LDB
#undef PG8_MMA
#undef PG8_WAIT_V
#undef PG8_WAIT_L
#undef PG8_BAR
#undef PG8_SCHED
}


struct EpiZ {
    static constexpr bool PERM = true;
    bf16_t* Z; float* SM; const float* b_merge;
    __device__ __forceinline__ void operator()(const f32x4 (&acc)[2][2][4][2], const Unit& u, int wr, int wc, int fr, int fq) const {
        const int row0 = u.pm * BM + wr * 64 + fr;
        if (u.pn < 60) {
            const int col0 = u.pn * BM + wc * 32 + 8 * fq; const bool mg = u.pn >= 36;
            if (!mg) {
#pragma unroll
                for (int ai = 0; ai < 2; ++ai)
#pragma unroll
                    for (int m = 0; m < 4; ++m) { bf16_t* rowp = Z + (size_t)(row0 + ai * HALF + m * 16) * ZLD + col0;
#pragma unroll
                        for (int bj = 0; bj < 2; ++bj) { const f32x4 v0 = acc[ai][bj][m][0], v1 = acc[ai][bj][m][1];
                            u32x4 w; w.x = cvt_pk_bf16(v0[0], v0[1]); w.y = cvt_pk_bf16(v0[2], v0[3]); w.z = cvt_pk_bf16(v1[0], v1[1]); w.w = cvt_pk_bf16(v1[2], v1[3]);
                            *(u32x4*)(rowp + bj * HALF) = w; } }
            } else {
#pragma unroll
                for (int bj = 0; bj < 2; ++bj) {
                    const f32x4 b0 = *(const f32x4*)(b_merge + (col0 - ZC_MG) + bj * HALF), b1 = *(const f32x4*)(b_merge + (col0 - ZC_MG) + bj * HALF + 4);
#pragma unroll
                    for (int ai = 0; ai < 2; ++ai)
#pragma unroll
                        for (int m = 0; m < 4; ++m) { bf16_t* rowp = Z + (size_t)(row0 + ai * HALF + m * 16) * ZLD + col0;
                            f32x4 v0 = acc[ai][bj][m][0] + b0, v1 = acc[ai][bj][m][1] + b1;
#pragma unroll
                            for (int e = 0; e < 4; ++e) { v0[e] = sigmoid_f(v0[e]); v1[e] = sigmoid_f(v1[e]); }
                            u32x4 w; w.x = cvt_pk_bf16(v0[0], v0[1]); w.y = cvt_pk_bf16(v0[2], v0[3]); w.z = cvt_pk_bf16(v1[0], v1[1]); w.w = cvt_pk_bf16(v1[2], v1[3]);
                            *(u32x4*)(rowp + bj * HALF) = w; asm volatile("" ::: "memory"); }
                }
            }
        } else {
            const int lc = wc * 32 + 8 * fq;
            if (lc < 48) {
#pragma unroll
                for (int ai = 0; ai < 2; ++ai)
#pragma unroll
                    for (int m = 0; m < 4; ++m) { float* rowp = SM + (size_t)(row0 + ai * HALF + m * 16) * 64 + lc;
                        *(f32x4*)(rowp) = acc[ai][0][m][0]; *(f32x4*)(rowp + 4) = acc[ai][0][m][1]; }
            }
        }
    }
};
struct EpiBranch {
    static constexpr bool PERM = true;
    const bf16_t* Z; float* slab; bf16_t* MG;
    __device__ __forceinline__ void operator()(const f32x4 (&acc)[2][2][4][2], const Unit& u, int wr, int wc, int fr, int fq) const {
        const int n = u.pn >> 3, pm = u.pm - n * 80, pn = u.pn & 7;
        const int row0 = pm * BM + wr * 64 + fr, col0 = pn * BM + wc * 32 + 8 * fq;
        float* sl = slab + (size_t)(((wr * 4 + wc) * 64 + fq * 16 + fr) * 128);
#pragma unroll
        for (int ai = 0; ai < 2; ++ai)
#pragma unroll
            for (int m = 0; m < 4; ++m) { const size_t row = (size_t)(row0 + ai * HALF + m * 16);
#pragma unroll
                for (int bj = 0; bj < 2; ++bj) {
                    const u32x4 gw = *(const u32x4*)(Z + row * ZLD + ZC_MG + n * D + col0 + bj * HALF);
                    f32x4 v0 = acc[ai][bj][m][0], v1 = acc[ai][bj][m][1];
                    v0[0] *= __uint_as_float(gw.x << 16); v0[1] *= __uint_as_float(gw.x & 0xffff0000u); v0[2] *= __uint_as_float(gw.y << 16); v0[3] *= __uint_as_float(gw.y & 0xffff0000u);
                    v1[0] *= __uint_as_float(gw.z << 16); v1[1] *= __uint_as_float(gw.z & 0xffff0000u); v1[2] *= __uint_as_float(gw.w << 16); v1[3] *= __uint_as_float(gw.w & 0xffff0000u);
                    const int e = ((ai * 4 + m) * 2 + bj) * 2;
                    float* s0 = sl + e * 4, * s1 = sl + (e + 1) * 4;
                    if (n > 0) { v0 += *(const f32x4*)s0; v1 += *(const f32x4*)s1; }
                    if (n < 2) { *(f32x4*)s0 = v0; *(f32x4*)s1 = v1; }
                    else { u32x4 w; w.x = cvt_pk_bf16(v0[0], v0[1]); w.y = cvt_pk_bf16(v0[2], v0[3]); w.z = cvt_pk_bf16(v1[0], v1[1]); w.w = cvt_pk_bf16(v1[2], v1[3]);
                        *(u32x4*)(MG + row * D + col0 + bj * HALF) = w; }
                    asm volatile("" ::: "memory");
                } }
    }
};
struct EpiResid {
    static constexpr bool PERM = false;
    const float* xin_ctx; const float* xin_lat; float* xout; const float* mod_l; int gidx; int row_off;
    __device__ __forceinline__ void operator()(const f32x4 (&acc)[2][2][4][2], const Unit& u, int wr, int wc, int fr, int fq) const {
        const int t0 = row_off + u.pm * BM;
        const int cond = t0 < NCTX ? 8 : (t0 - NCTX) >> 12;
        const float* xin = t0 < NCTX ? xin_ctx : xin_lat;
        const float* gate = mod_l + (size_t)cond * 12288 + gidx * D;
        const int row0 = t0 + wr * 64 + fr, col0 = u.pn * BM + wc * 32 + 4 * fq;
        f32x4 gv[2][2];
#pragma unroll
        for (int bj = 0; bj < 2; ++bj)
#pragma unroll
            for (int n = 0; n < 2; ++n) gv[bj][n] = *(const f32x4*)(gate + col0 + bj * HALF + n * 16);
#pragma unroll
        for (int ai = 0; ai < 2; ++ai)
#pragma unroll
            for (int m = 0; m < 4; ++m) { const size_t off = (size_t)(row0 + ai * HALF + m * 16) * D + col0;
#pragma unroll
                for (int bj = 0; bj < 2; ++bj)
#pragma unroll
                    for (int n = 0; n < 2; ++n) { const f32x4 xi = *(const f32x4*)(xin + off + bj * HALF + n * 16);
                        *(f32x4*)(xout + off + bj * HALF + n * 16) = xi + gv[bj][n] * acc[ai][bj][m][n]; } }
    }
};
struct EpiBf16 {
    static constexpr bool PERM = true;
    bf16_t* O; int ldc;
    __device__ __forceinline__ void operator()(const f32x4 (&acc)[2][2][4][2], const Unit& u, int wr, int wc, int fr, int fq) const {
        const int row0 = u.pm * BM + wr * 64 + fr, col0 = u.pn * BM + wc * 32 + 8 * fq;
#pragma unroll
        for (int ai = 0; ai < 2; ++ai)
#pragma unroll
            for (int m = 0; m < 4; ++m) { bf16_t* rowp = O + (size_t)(row0 + ai * HALF + m * 16) * ldc + col0;
#pragma unroll
                for (int bj = 0; bj < 2; ++bj) { const f32x4 v0 = acc[ai][bj][m][0], v1 = acc[ai][bj][m][1];
                    u32x4 w; w.x = cvt_pk_bf16(v0[0], v0[1]); w.y = cvt_pk_bf16(v0[2], v0[3]); w.z = cvt_pk_bf16(v1[0], v1[1]); w.w = cvt_pk_bf16(v1[2], v1[3]);
                    *(u32x4*)(rowp + bj * HALF) = w; } }
    }
};
}

#define XB_TMO      128
#define XB_XCNT(j)  (256  + 64 * (j))
#define XB_XSUB(j)  (1280 + 64 * (j))
#define XB_XGEN(j)  (2304 + 64 * (j))
#define XB_TOP      3328
#define XB_TOPGEN   3392
#define XCD_BAR_WORDS 3456
#define XB_SPIN_CAP (1u << 18)
__device__ __forceinline__ unsigned xb_ld(unsigned* p)              { return __hip_atomic_load(p, __ATOMIC_RELAXED, __HIP_MEMORY_SCOPE_AGENT); }
__device__ __forceinline__ unsigned xb_add(unsigned* p, unsigned v) { return __hip_atomic_fetch_add(p, v, __ATOMIC_RELAXED, __HIP_MEMORY_SCOPE_AGENT); }
__device__ __forceinline__ unsigned xb_xcc_id() { return (unsigned)__builtin_amdgcn_s_getreg((3 << 11) | 20) & 0xFu; }
#define XB_SPIN(cond, bar) do { unsigned _sp = 0; while (cond) { __builtin_amdgcn_s_sleep(1); \
    if ((++_sp & 255u) == 0u) { if (xb_ld(&(bar)[XB_TMO])) break; if (_sp > XB_SPIN_CAP) { atomicAdd(&(bar)[XB_TMO], 1u); break; } } } } while (0)
struct XcdBarrier { unsigned* bar; unsigned x; volatile LAS unsigned* st; };
__device__ __forceinline__ XcdBarrier xcd_barrier_post(unsigned* bar, volatile LAS unsigned* st) {
    XcdBarrier b; b.bar = bar; b.x = xb_xcc_id(); b.st = st;
    if (threadIdx.x == 0) (void)xb_add(&bar[XB_XCNT(b.x)], 1u);
    return b;
}
__device__ __forceinline__ void xcd_barrier_complete(unsigned* bar, unsigned x, unsigned& nloc, unsigned& nx) {
    const unsigned G = gridDim.x * gridDim.y * gridDim.z;
    unsigned sum, cnt, mine, sp = 0u;
    for (;;) {
        sum = 0u; cnt = 0u; mine = 0u;
#pragma unroll
        for (unsigned j = 0; j < 16; ++j) { const unsigned c = xb_ld(&bar[XB_XCNT(j)]); sum += c; cnt += (c > 0u) ? 1u : 0u; mine = (j == x) ? c : mine; }
        if (sum == G) break;
        __builtin_amdgcn_s_sleep(1);
        if ((++sp & 255u) == 0u) { if (xb_ld(&bar[XB_TMO])) break; if (sp > XB_SPIN_CAP) { atomicAdd(&bar[XB_TMO], 1u); break; } }
    }
    nloc = mine > 0u ? mine : 1u; nx = cnt > 0u ? cnt : 1u;
}
__device__ __forceinline__ void xcd_barrier(const XcdBarrier& b) {
    asm volatile("s_waitcnt vmcnt(0)" ::: "memory");
    __syncthreads();
    if (threadIdx.x == 0) {
        unsigned* bar = b.bar;
        __builtin_amdgcn_s_waitcnt(0);
        unsigned nloc = b.st[0], nx = b.st[1];
        if (nloc == 0u) { xcd_barrier_complete(bar, b.x, nloc, nx); b.st[0] = nloc; b.st[1] = nx; }
        const unsigned old = xb_add(&bar[XB_XSUB(b.x)], 1u);
        const unsigned gen = old / nloc;
        if (old + 1u == (gen + 1u) * nloc) {
            __builtin_amdgcn_fence(__ATOMIC_RELEASE, "agent");
            asm volatile("s_waitcnt vmcnt(0)" ::: "memory");
            const unsigned og = xb_add(&bar[XB_TOP], 1u);
            const unsigned tg = og / nx;
            if (og + 1u == (tg + 1u) * nx) xb_add(&bar[XB_TOPGEN], 1u);
            else XB_SPIN(xb_ld(&bar[XB_TOPGEN]) == tg, bar);
            __builtin_amdgcn_fence(__ATOMIC_ACQUIRE, "agent");
            xb_add(&bar[XB_XGEN(b.x)], 1u);
            asm volatile("s_waitcnt vmcnt(0)" ::: "memory");
        } else {
            XB_SPIN(xb_ld(&bar[XB_XGEN(b.x)]) == gen, bar);
            __builtin_amdgcn_fence(__ATOMIC_ACQUIRE, "agent");
            asm volatile("s_waitcnt vmcnt(0)" ::: "memory");
        }
    }
    __syncthreads();
}

enum { I_XP = 0, I_XS, I_SGLA, I_SMC, I_SMN, I_SMM, I_SLRU, I_C, I_CCTX, I_N1G, I_N2G, I_WMOD, I_BMOD, I_WIN, I_GWA, I_GBA, I_GNG, I_MBIF, I_MNG,
       I_LCW, I_LCB, I_LGW, I_LGB, I_LLAM, I_WBR, I_BMG, I_WOUT, I_FUP, I_FCW, I_FCB, I_FDOWN, I_NFG };
constexpr size_t OUT_X = 0;
constexpr size_t OUT_GLA = (size_t)NTOK * D;
constexpr size_t OUT_MC = OUT_GLA + (size_t)32 * 2 * 2 * 4 * 128 * 256;
constexpr size_t OUT_MN = OUT_MC + (size_t)32 * 2 * 2 * 4 * 256 * 256;
constexpr size_t OUT_MM = OUT_MN + (size_t)32 * 2 * 2 * 4 * 256;
constexpr size_t OUT_LRU = OUT_MM + (size_t)32 * 2 * 2 * 4;
constexpr size_t OUT_END = OUT_LRU + (size_t)32 * 2 * 2 * 1024;

struct Seq { int tl0, len, b, ctx; };
__device__ __forceinline__ Seq seq_of(int g, int s) {
    Seq q;
    if (g == 0) { if (s < 32) { q.tl0 = s * 256; q.len = 256; q.b = s; q.ctx = 1; } else { q.tl0 = NCTX + (s - 32) * 4096; q.len = 4096; q.b = s - 32; q.ctx = 0; } }
    else { q.tl0 = s * 4096; q.len = 4096; q.b = 3 + s; q.ctx = 0; }
    return q;
}
__device__ __forceinline__ int seq_index(int g, int k) { return g == 0 ? (k < 3 ? 32 + k : k - 3) : k; }
__device__ __forceinline__ int nseq_of(int g) { return g == 0 ? 35 : 5; }

__device__ __forceinline__ bf16x8 lds_frag(const LAS bf16_t* base, int ld, int row0, int k0, int lane) {
    return *(const LAS bf16x8*)(base + (row0 + (lane & 15)) * ld + k0 + (lane >> 4) * 8);
}
#define MFMA16(x, y, acc) __builtin_amdgcn_mfma_f32_16x16x32_bf16((x), (y), (acc), 0, 0, 0)

__device__ __forceinline__ void phase_mod(const Params& p, LAS unsigned char* lds) {
    LAS float* sc = (LAS float*)lds;
    LAS float* red = (LAS float*)(lds + 9 * 2048 * 4);
    const int tid = tidx();
    if ((int)blockIdx.x >= 384) return;
    for (int i = tid; i < 9 * 2048; i += NTHREADS) { const int r = i >> 11, k = i & 2047; const float v = r < 8 ? p.in[I_C][r * 2048 + k] : p.in[I_CCTX][k]; sc[i] = silu_f(v); }
    __syncthreads();
    float* mod = (float*)(p.ws + WS_MOD);
    for (int u = blockIdx.x; u < 384; u += gridDim.x) {
        const int l = u / 192, cb = u % 192, col = tid & 63, kp = tid >> 6;
        const float* w = p.in[I_WMOD] + (size_t)l * 2048 * 12288 + cb * 64 + col;
        float a[9];
#pragma unroll
        for (int r = 0; r < 9; ++r) a[r] = 0.f;
        for (int k = kp * 256; k < kp * 256 + 256; ++k) { const float wv = w[(size_t)k * 12288];
#pragma unroll
            for (int r = 0; r < 9; ++r) a[r] += sc[r * 2048 + k] * wv; }
#pragma unroll
        for (int r = 0; r < 9; ++r) red[(kp * 9 + r) * 64 + col] = a[r];
        __syncthreads();
        for (int i = tid; i < 9 * 64; i += NTHREADS) { const int r = i >> 6, c2 = i & 63; float s = 0.f;
#pragma unroll
            for (int q = 0; q < 8; ++q) s += red[(q * 9 + r) * 64 + c2];
            mod[((size_t)l * 9 + r) * 12288 + cb * 64 + c2] = s + p.in[I_BMOD][l * 12288 + cb * 64 + c2]; }
        __syncthreads();
    }
}

__device__ __forceinline__ void transpose_item(const float* W, int K, int Nsrc, int k0, int src_n0, int nvalid, float scale, bf16_t* dst, LAS float* scr, int lane) {
#pragma unroll 8
    for (int i = 0; i < 32; ++i) { const int kk = 2 * i + (lane >> 5), n = lane & 31; scr[kk * 33 + n] = n < nvalid ? W[(size_t)(k0 + kk) * Nsrc + src_n0 + n] * scale : 0.f; }
    LDS_WAIT(); asm volatile("" ::: "memory");
    const int c = lane & 7;
#pragma unroll
    for (int j = 0; j < 4; ++j) { const int n = (lane >> 3) + 8 * j; const LAS float* s = scr + (8 * c) * 33 + n;
        u32x4 o; o.x = cvt_pk_bf16(s[0 * 33], s[1 * 33]); o.y = cvt_pk_bf16(s[2 * 33], s[3 * 33]); o.z = cvt_pk_bf16(s[4 * 33], s[5 * 33]); o.w = cvt_pk_bf16(s[6 * 33], s[7 * 33]);
        *(u32x4*)(dst + (size_t)n * K + k0 + 8 * c) = o; }
    LDS_WAIT(); asm volatile("" ::: "memory");
}
__device__ __forceinline__ void phase_wconv(const Params& p, int l, LAS unsigned char* lds) {
    const int tid_ = tidx(); const int lane = tid_ & 63, wave = tid_ >> 6;
    LAS float* scr = (LAS float*)(lds + wave * 16384);
    const int gw = blockIdx.x * 8 + wave, NGW = gridDim.x * 8;
    constexpr int I_IN = 32 * 488, I_BRn = 16 * 64 * 3, I_OUTn = 32 * 64, I_UPn = 32 * 352, I_DNn = 88 * 64, I_LR = 32 * 8;
    constexpr int NITEMS = I_IN + I_BRn + I_OUTn + I_UPn + I_DNn + I_LR;
    for (int it = gw; it < NITEMS; it += NGW) {
        int r = it;
        if (r < I_IN) {
            const int kb = r / 488, nb = r % 488, d0 = nb * 32; int s0, nv = 32; float sc = 1.f;
            if (d0 < 3072) s0 = d0; else if (d0 < 7168) s0 = d0 + 32; else if (d0 < 15360) s0 = d0 + 48; else if (d0 < 15392) s0 = d0 - 15360 + 3072; else if (d0 < 15424) { s0 = 7200; nv = 16; } else { s0 = 0; nv = 0; }
            if (d0 < 512) sc = 0.08838834764831845f; else if (d0 >= ZC_KB && d0 < ZC_KB + 1024) sc = 0.0625f;
            transpose_item(p.in[I_WIN] + (size_t)l * 2048 * 15408, 2048, 15408, kb * 64, s0, nv, sc, (bf16_t*)(p.ws + W_IN) + (size_t)d0 * 2048, scr, lane); continue; }
        r -= I_IN;
        if (r < I_BRn) { const int n = r / (16 * 64), q = r % (16 * 64), kb = q / 64, nb = q % 64;
            transpose_item(p.in[I_WBR] + ((size_t)l * 3 + n) * 1024 * 2048, 1024, 2048, kb * 64, nb * 32, 32, 1.f, (bf16_t*)(p.ws + W_BR) + ((size_t)n * 2048 + nb * 32) * 1024, scr, lane); continue; }
        r -= I_BRn;
        if (r < I_OUTn) { const int kb = r / 64, nb = r % 64;
            transpose_item(p.in[I_WOUT] + (size_t)l * 2048 * 2048, 2048, 2048, kb * 64, nb * 32, 32, 1.f, (bf16_t*)(p.ws + W_OUT) + (size_t)(nb * 32) * 2048, scr, lane); continue; }
        r -= I_OUTn;
        if (r < I_UPn) { const int kb = r / 352, nb = r % 352;
            transpose_item(p.in[I_FUP] + (size_t)l * 2048 * NUP, 2048, NUP, kb * 64, nb * 32, 32, 1.f, (bf16_t*)(p.ws + W_UP) + (size_t)(nb * 32) * 2048, scr, lane); continue; }
        r -= I_UPn;
        if (r < I_DNn) { const int kb = r / 64, nb = r % 64;
            transpose_item(p.in[I_FDOWN] + (size_t)l * DFF * 2048, DFF, 2048, kb * 64, nb * 32, 32, 1.f, (bf16_t*)(p.ws + W_DOWN) + (size_t)(nb * 32) * DFF, scr, lane); continue; }
        r -= I_DNn;
        { const int mat = r / 8, q = r % 8, kb = q / 4, nb = q % 4;
            transpose_item(p.in[I_LGW] + ((size_t)l * 32 + mat) * 16384, 128, 128, kb * 64, nb * 32, 32, 1.f, (bf16_t*)(p.ws + W_LRU) + (size_t)mat * 16384 + (size_t)(nb * 32) * 128, scr, lane); }
    }
}

__device__ __forceinline__ void phase_norm(const Params& p, int l, int g, int which, bool from_input) {
    const int tid_ = tidx(); const int lane = tid_ & 63, wave = tid_ >> 6;
    const int gw = blockIdx.x * 8 + wave, NGW = gridDim.x * 8;
    const float* ng = p.in[which ? I_N2G : I_N1G] + l * D;
    const float* mod_l = (const float*)(p.ws + WS_MOD) + (size_t)l * 9 * 12288;
    bf16_t* U = (bf16_t*)(p.ws + WS_U);
    for (int tl = gw; tl < TG; tl += NGW) {
        const int t = g * TG + tl;
        const float* xr = from_input ? (t < NCTX ? p.in[I_XP] + (size_t)t * D : p.in[I_XS] + (size_t)(t - NCTX) * D) : p.out + OUT_X + (size_t)t * D;
        const int cond = t < NCTX ? 8 : (t - NCTX) >> 12;
        const float* sh = mod_l + (size_t)cond * 12288 + (which * 3) * D; const float* sc = sh + D;
        f32x4 v[8]; float s = 0.f;
#pragma unroll
        for (int j = 0; j < 8; ++j) { v[j] = *(const f32x4*)(xr + j * 256 + lane * 4); s += (v[j][0] * v[j][0] + v[j][1] * v[j][1]) + (v[j][2] * v[j][2] + v[j][3] * v[j][3]); }
        const float rstd = rsqrtf(wave_sum(s) * (1.f / D) + EPS);
#pragma unroll
        for (int j = 0; j < 8; ++j) { const int c = j * 256 + lane * 4; const f32x4 gv = *(const f32x4*)(ng + c), sv = *(const f32x4*)(sc + c), hv = *(const f32x4*)(sh + c);
            f32x4 o = v[j] * rstd * gv * (sv + 1.f) + hv;
            u32x2 w; w.x = cvt_pk_bf16(o[0], o[1]); w.y = cvt_pk_bf16(o[2], o[3]); *(u32x2*)(U + (size_t)tl * D + c) = w; }
    }
}
__device__ __forceinline__ void phase_final_norm(const Params& p) {
    const int tid_ = tidx(); const int lane = tid_ & 63, wave = tid_ >> 6;
    const int gw = blockIdx.x * 8 + wave, NGW = gridDim.x * 8;
    const float* ng = p.in[I_NFG];
    for (int t = gw; t < NTOK; t += NGW) {
        float* xr = p.out + OUT_X + (size_t)t * D;
        f32x4 v[8]; float s = 0.f;
#pragma unroll
        for (int j = 0; j < 8; ++j) { v[j] = *(const f32x4*)(xr + j * 256 + lane * 4); s += (v[j][0] * v[j][0] + v[j][1] * v[j][1]) + (v[j][2] * v[j][2] + v[j][3] * v[j][3]); }
        const float rstd = rsqrtf(wave_sum(s) * (1.f / D) + EPS);
#pragma unroll
        for (int j = 0; j < 8; ++j) { const int c = j * 256 + lane * 4; const f32x4 gv = *(const f32x4*)(ng + c); *(f32x4*)(xr + c) = v[j] * rstd * gv; }
    }
}

__device__ __forceinline__ bf16_t* o_buf(const Params& p, int dir, int mixer) { return (bf16_t*)(p.ws + WS_O) + ((size_t)(dir * 3 + mixer) * TG) * 1024; }

__device__ __forceinline__ void gla_item(const Params& p, int l, const Seq sq, int h, int dir, int slice, LAS unsigned char* lds) {
    LAS bf16_t* QIN = (LAS bf16_t*)(lds);
    LAS bf16_t* KIN = (LAS bf16_t*)(lds + 17408);
    LAS bf16_t* KET = (LAS bf16_t*)(lds + 34816);
    LAS bf16_t* VT  = (LAS bf16_t*)(lds + 53248);
    LAS bf16_t* ATT = (LAS bf16_t*)(lds + 62464);
    LAS bf16_t* SB  = (LAS bf16_t*)(lds + 71680);
    LAS float*  RA  = (LAS float*)(lds + 89088);
    LAS float*  GT  = (LAS float*)(lds + 93184);
    LAS float*  EL  = (LAS float*)(lds + 95232);
    const int tid = tidx(), lane = tid & 63, w = tid >> 6, q4 = lane >> 4, l15 = lane & 15;
    const bf16_t* Z = (const bf16_t*)(p.ws + WS_Z); const float* SM = (const float*)(p.ws + WS_SM);
    bf16_t* O = o_buf(p, dir, 0);
    const int d = tid & 127, rg = tid >> 7;
    float wal[16];
#pragma unroll
    for (int j = 0; j < 16; ++j) wal[j] = p.in[I_GWA][((size_t)(l * 2 + dir) * 16 + j) * 512 + h * 128 + d];
    const float bal = p.in[I_GBA][(l * 2 + dir) * 512 + h * 128 + d];
    f32x4 S[4];
    {
        const float* s0 = p.in[I_SGLA] + ((((size_t)sq.b * 2 + l) * 2 + dir) * 4 + h) * 128 * 256;
#pragma unroll
        for (int nt = 0; nt < 4; ++nt)
#pragma unroll
            for (int i = 0; i < 4; ++i) S[nt][i] = sq.ctx ? 0.f : s0[(size_t)(16 * w + 4 * q4 + i) * 256 + slice * 64 + nt * 16 + l15];
#pragma unroll
        for (int nt = 0; nt < 4; ++nt) { u32x2 pk; pk.x = cvt_pk_bf16(S[nt][0], S[nt][1]); pk.y = cvt_pk_bf16(S[nt][2], S[nt][3]); *(LAS u32x2*)(SB + (nt * 16 + l15) * 136 + 16 * w + 4 * q4) = pk; }
    }
    const int nch = sq.len >> 6;
    for (int c = 0; c < nch; ++c) {
#define TOK(r) (sq.tl0 + (dir ? sq.len - 1 - (c * 64 + (r)) : c * 64 + (r)))
        if (tid < 256) { const int r = tid >> 2, j4 = (tid & 3) * 4; *(LAS f32x4*)(RA + r * 16 + j4) = *(const f32x4*)(SM + (size_t)TOK(r) * 64 + dir * 16 + j4); }
        {
            const int cc = tid & 63, r8 = tid >> 6; unsigned short vv[8];
#pragma unroll
            for (int i = 0; i < 8; ++i) vv[i] = Z[(size_t)TOK(r8 * 8 + i) * ZLD + ZC_VA + h * 256 + slice * 64 + cc];
            u32x4 pk; pk.x = vv[0] | ((unsigned)vv[1] << 16); pk.y = vv[2] | ((unsigned)vv[3] << 16); pk.z = vv[4] | ((unsigned)vv[5] << 16); pk.w = vv[6] | ((unsigned)vv[7] << 16);
            *(LAS u32x4*)(VT + cc * 72 + r8 * 8) = pk;
        }
        unsigned short qv[16], kv[16];
#pragma unroll
        for (int i = 0; i < 16; ++i) { const size_t ro = (size_t)TOK(rg * 16 + i) * ZLD + h * 128 + d; qv[i] = Z[ro + ZC_QA]; kv[i] = Z[ro + ZC_KA]; }
        __syncthreads();
        float cum[16];
        {
            float run = 0.f;
#pragma unroll
            for (int i = 0; i < 16; ++i) { float pre = bal; const LAS float* rr = RA + (rg * 16 + i) * 16;
#pragma unroll
                for (int j = 0; j < 16; ++j) pre += rr[j] * wal[j];
                run += logsigmoid_f(pre) * 0.0625f; cum[i] = run; }
            GT[rg * 128 + d] = run;
        }
        __syncthreads();
        float pre = 0.f, last = 0.f;
#pragma unroll
        for (int g2 = 0; g2 < 4; ++g2) { const float t = GT[g2 * 128 + d]; last += t; if (g2 < rg) pre += t; }
        unsigned short ke[16];
#pragma unroll
        for (int i = 0; i < 16; ++i) { const float cu = cum[i] + pre; const float e = __expf(cu), ei = __expf(-cu), qf = bf2f(qv[i]), kf = bf2f(kv[i]);
            QIN[(rg * 16 + i) * 136 + d] = f2bf(qf * e); KIN[(rg * 16 + i) * 136 + d] = f2bf(kf * ei); ke[i] = f2bf(kf * __expf(last - cu)); }
        { u32x4 a, b; a.x = ke[0] | ((unsigned)ke[1] << 16); a.y = ke[2] | ((unsigned)ke[3] << 16); a.z = ke[4] | ((unsigned)ke[5] << 16); a.w = ke[6] | ((unsigned)ke[7] << 16);
            b.x = ke[8] | ((unsigned)ke[9] << 16); b.y = ke[10] | ((unsigned)ke[11] << 16); b.z = ke[12] | ((unsigned)ke[13] << 16); b.w = ke[14] | ((unsigned)ke[15] << 16);
            *(LAS u32x4*)(KET + d * 72 + rg * 16) = a; *(LAS u32x4*)(KET + d * 72 + rg * 16 + 8) = b; }
        if (rg == 0) EL[d] = __expf(last);
        const bool dbg_item = DBG_CHECKS && sq.ctx && sq.b == 1 && h == 0 && dir == DBG_DIR && slice == 0 && c == DBG_CHUNK;
        float* dbgp = (float*)(p.ws + WS_DBG);
        if (dbg_item) {
#pragma unroll
            for (int i = 0; i < 16; ++i) dbgp[(rg * 16 + i) * 128 + d] = cum[i] + pre;
        }
        __syncthreads();
        if (dbg_item) {
            for (int i = tid; i < 64 * 128; i += NTHREADS) { dbgp[8192 + i] = bf2f(QIN[(i >> 7) * 136 + (i & 127)]); dbgp[16384 + i] = bf2f(KIN[(i >> 7) * 136 + (i & 127)]); dbgp[24576 + i] = bf2f(KET[(i >> 6) * 72 + (i & 63)]); }
            for (int i = tid; i < 64 * 64; i += NTHREADS) dbgp[32768 + i] = bf2f(VT[(i >> 6) * 72 + (i & 63)]);
        }
        const int mt = w >> 1, nt0 = 2 * (w & 1);
        {
#pragma unroll
            for (int t2 = 0; t2 < 2; ++t2) { const int nt = nt0 + t2; f32x4 a = {0.f, 0.f, 0.f, 0.f};
                if (nt <= mt) {
#pragma unroll
                    for (int ks = 0; ks < 4; ++ks) a = MFMA16(lds_frag(KIN, 136, nt * 16, ks * 32, lane), lds_frag(QIN, 136, mt * 16, ks * 32, lane), a);
                }
                const int i = mt * 16 + l15, j0 = nt * 16 + 4 * q4;
#pragma unroll
                for (int e = 0; e < 4; ++e) if (j0 + e > i) a[e] = 0.f;
                u32x2 pk; pk.x = cvt_pk_bf16(a[0], a[1]); pk.y = cvt_pk_bf16(a[2], a[3]); *(LAS u32x2*)(ATT + i * 72 + j0) = pk; }
        }
        __syncthreads();
        if (dbg_item) { for (int i = tid; i < 64 * 64; i += NTHREADS) dbgp[36864 + i] = bf2f(ATT[(i >> 6) * 72 + (i & 63)]);
            for (int i = tid; i < 64 * 128; i += NTHREADS) dbgp[40960 + i] = bf2f(SB[(i >> 7) * 136 + (i & 127)]); }
        {
#pragma unroll
            for (int t2 = 0; t2 < 2; ++t2) { const int nt = nt0 + t2; f32x4 a = {0.f, 0.f, 0.f, 0.f};
#pragma unroll
                for (int ks = 0; ks < 2; ++ks) a = MFMA16(lds_frag(VT, 72, nt * 16, ks * 32, lane), lds_frag(ATT, 72, mt * 16, ks * 32, lane), a);
#pragma unroll
                for (int ks = 0; ks < 4; ++ks) a = MFMA16(lds_frag(SB, 136, nt * 16, ks * 32, lane), lds_frag(QIN, 136, mt * 16, ks * 32, lane), a);
                u32x2 pk; pk.x = cvt_pk_bf16(a[0], a[1]); pk.y = cvt_pk_bf16(a[2], a[3]);
                if (dbg_item) { for (int e = 0; e < 4; ++e) dbgp[49152 + (mt * 16 + l15) * 64 + nt * 16 + 4 * q4 + e] = a[e]; }
                *(u32x2*)(O + (size_t)TOK(mt * 16 + l15) * 1024 + h * 256 + slice * 64 + nt * 16 + 4 * q4) = pk; }
        }
        __syncthreads();
        {
            const f32x4 el = *(const LAS f32x4*)(EL + 16 * w + 4 * q4);
#pragma unroll
            for (int nt = 0; nt < 4; ++nt) { S[nt] = S[nt] * el;
#pragma unroll
                for (int ks = 0; ks < 2; ++ks) S[nt] = MFMA16(lds_frag(KET, 72, w * 16, ks * 32, lane), lds_frag(VT, 72, nt * 16, ks * 32, lane), S[nt]);
                u32x2 pk; pk.x = cvt_pk_bf16(S[nt][0], S[nt][1]); pk.y = cvt_pk_bf16(S[nt][2], S[nt][3]); *(LAS u32x2*)(SB + (nt * 16 + l15) * 136 + 16 * w + 4 * q4) = pk; }
        }
        __syncthreads();
#undef TOK
    }
    if (sq.ctx) {
        float* so = p.out + OUT_GLA + ((((size_t)sq.b * 2 + l) * 2 + dir) * 4 + h) * 128 * 256;
#pragma unroll
        for (int nt = 0; nt < 4; ++nt)
#pragma unroll
            for (int i = 0; i < 4; ++i) so[(size_t)(16 * w + 4 * q4 + i) * 256 + slice * 64 + nt * 16 + l15] = S[nt][i];
    }
}

__device__ __forceinline__ void mlstm_item(const Params& p, int l, const Seq sq, int h, int dir, int slice, LAS unsigned char* lds) {
    LAS bf16_t* KN  = (LAS bf16_t*)(lds);
    LAS bf16_t* KTW = (LAS bf16_t*)(lds + 33792);
    LAS bf16_t* VT  = (LAS bf16_t*)(lds + 70656);
    LAS bf16_t* SMm = (LAS bf16_t*)(lds + 82176);
    LAS bf16_t* CB  = (LAS bf16_t*)(lds + 91392);
    LAS float*  AA  = (LAS float*)(lds + 133632);
    LAS float*  MX  = AA + 64;
    LAS float*  WP  = AA + 128;
    LAS float*  FL  = AA + 192;
    LAS float*  WL  = AA + 256;
    LAS float*  DEN = AA + 320;
    LAS float*  SC  = AA + 384;
    const int tid = tidx(), lane = tid & 63, w = tid >> 6, q4 = lane >> 4, l15 = lane & 15;
    const bf16_t* Z = (const bf16_t*)(p.ws + WS_Z); const float* SM = (const float*)(p.ws + WS_SM);
    bf16_t* O = o_buf(p, dir, 1);
    const float bi = p.in[I_MBIF][((l * 2 + dir) * 2 + 0) * 4 + h], bfg = p.in[I_MBIF][((l * 2 + dir) * 2 + 1) * 4 + h];
    const size_t sidx = (((size_t)sq.b * 2 + l) * 2 + dir) * 4 + h;
    f32x4 S[2][5];
    {
        const float* c0 = p.in[I_SMC] + sidx * 256 * 256; const float* n0 = p.in[I_SMN] + sidx * 256;
#pragma unroll
        for (int dt = 0; dt < 2; ++dt)
#pragma unroll
            for (int ct = 0; ct < 5; ++ct)
#pragma unroll
                for (int i = 0; i < 4; ++i) { const int dd = 32 * w + 16 * dt + 4 * q4 + i; float v = 0.f;
                    if (!sq.ctx) { if (ct < 4) v = c0[(size_t)dd * 256 + slice * 64 + ct * 16 + l15]; else if (l15 == 0) v = n0[dd]; }
                    S[dt][ct][i] = v; }
#pragma unroll
        for (int dt = 0; dt < 2; ++dt)
#pragma unroll
            for (int ct = 0; ct < 5; ++ct) { u32x2 pk; pk.x = cvt_pk_bf16(S[dt][ct][0], S[dt][ct][1]); pk.y = cvt_pk_bf16(S[dt][ct][2], S[dt][ct][3]);
                *(LAS u32x2*)(CB + (ct * 16 + l15) * 264 + 32 * w + 16 * dt + 4 * q4) = pk; }
        for (int i = tid; i < 16 * 64; i += NTHREADS) { const int rr = i >> 6, cc = i & 63; VT[(64 + rr) * 72 + cc] = rr == 0 ? (bf16_t)0x3F80 : (bf16_t)0; }
        if (tid == 0) SC[1] = sq.ctx ? 0.f : p.in[I_SMM][sidx];
    }
    __syncthreads();
    const int mt = w & 3, hf = w >> 2;
    const int nch = sq.len >> 6;
    for (int c = 0; c < nch; ++c) {
#define TOK(r) (sq.tl0 + (dir ? sq.len - 1 - (c * 64 + (r)) : c * 64 + (r)))
        bf16x8 qf[8];
        { const bf16_t* qrow = Z + (size_t)TOK(mt * 16 + l15) * ZLD + ZC_QB + h * 256 + q4 * 8;
#pragma unroll
            for (int ks = 0; ks < 8; ++ks) qf[ks] = *(const bf16x8*)(qrow + ks * 32); }
        if (w == 0) {
            const float m_prev = SC[1];
            const float* sm = SM + (size_t)TOK(lane) * 64 + 32 + dir * 8 + h;
            const float gi = sm[0] + bi, lf = logsigmoid_f(sm[4] + bfg);
            float fc = lf;
#pragma unroll
            for (int o = 1; o < 64; o <<= 1) { const float t = __shfl_up(fc, o); if (lane >= o) fc += t; }
            const float a = gi - fc; float pm = a;
#pragma unroll
            for (int o = 1; o < 64; o <<= 1) { const float t = __shfl_up(pm, o); if (lane >= o) pm = fmaxf(pm, t); }
            const float mx = fmaxf(m_prev, pm), mj = fc + mx;
            const float mx63 = __shfl(mx, 63), fc63 = __shfl(fc, 63);
            AA[lane] = a; MX[lane] = mx; WP[lane] = __expf(m_prev - mx); FL[lane] = __expf(-mj); WL[lane] = __expf(a - mx63);
            LDS_WAIT();
            if (lane == 63) { SC[0] = __expf(m_prev - mx63); SC[1] = fc63 + mx63; }
        }
        {
            const int cc = tid & 63, r8 = tid >> 6; unsigned short vv[8];
#pragma unroll
            for (int i = 0; i < 8; ++i) vv[i] = Z[(size_t)TOK(r8 * 8 + i) * ZLD + ZC_VB + h * 256 + slice * 64 + cc];
            u32x4 pk; pk.x = vv[0] | ((unsigned)vv[1] << 16); pk.y = vv[2] | ((unsigned)vv[3] << 16); pk.z = vv[4] | ((unsigned)vv[5] << 16); pk.w = vv[6] | ((unsigned)vv[7] << 16);
            *(LAS u32x4*)(VT + cc * 72 + r8 * 8) = pk;
        }
        __syncthreads();
        {
            const int dd = tid & 255, r32 = tid >> 8;
#pragma unroll
            for (int i8 = 0; i8 < 4; ++i8) { unsigned short kk[8], kw[8];
#pragma unroll
                for (int i = 0; i < 8; ++i) { const int r = r32 * 32 + i8 * 8 + i; kk[i] = Z[(size_t)TOK(r) * ZLD + ZC_KB + h * 256 + dd]; KN[r * 264 + dd] = kk[i]; kw[i] = f2bf(bf2f(kk[i]) * WL[r]); }
                u32x4 pk; pk.x = kw[0] | ((unsigned)kw[1] << 16); pk.y = kw[2] | ((unsigned)kw[3] << 16); pk.z = kw[4] | ((unsigned)kw[5] << 16); pk.w = kw[6] | ((unsigned)kw[7] << 16);
                *(LAS u32x4*)(KTW + dd * 72 + r32 * 32 + i8 * 8) = pk; }
        }
        __syncthreads();
        {
            const int j = mt * 16 + l15; const float mxj = MX[j];
#pragma unroll
            for (int t2 = 0; t2 < 2; ++t2) { const int nt = 2 * hf + t2; f32x4 a = {0.f, 0.f, 0.f, 0.f};
                if (nt <= mt) {
#pragma unroll
                    for (int ks = 0; ks < 8; ++ks) a = MFMA16(lds_frag(KN, 264, nt * 16, ks * 32, lane), qf[ks], a);
                }
                const int i0 = nt * 16 + 4 * q4; const f32x4 av = *(const LAS f32x4*)(AA + i0);
#pragma unroll
                for (int e = 0; e < 4; ++e) a[e] = (i0 + e <= j) ? a[e] * __expf(av[e] - mxj) : 0.f;
                u32x2 pk; pk.x = cvt_pk_bf16(a[0], a[1]); pk.y = cvt_pk_bf16(a[2], a[3]); *(LAS u32x2*)(SMm + j * 72 + i0) = pk; }
        }
        __syncthreads();
        {
            const int j = mt * 16 + l15; const float wpj = WP[j];
            f32x4 nm[3];
#pragma unroll
            for (int t3 = 0; t3 < 3; ++t3) { const int ct = hf * 3 + t3; nm[t3] = (f32x4){0.f, 0.f, 0.f, 0.f};
                if (ct < 5) {
#pragma unroll
                    for (int ks = 0; ks < 8; ++ks) nm[t3] = MFMA16(lds_frag(CB, 264, ct * 16, ks * 32, lane), qf[ks], nm[t3]);
                    nm[t3] = nm[t3] * wpj;
#pragma unroll
                    for (int ks = 0; ks < 2; ++ks) nm[t3] = MFMA16(lds_frag(VT, 72, ct * 16, ks * 32, lane), lds_frag(SMm, 72, mt * 16, ks * 32, lane), nm[t3]);
                } }
            if (hf == 1 && q4 == 0) DEN[j] = nm[1][0];
            __syncthreads();
            const float dn = fmaxf(fabsf(DEN[j]), FL[j]), inv = 1.f / dn;
            bf16_t* orow = O + (size_t)TOK(j) * 1024 + h * 256 + slice * 64 + 4 * q4;
#pragma unroll
            for (int t3 = 0; t3 < 3; ++t3) { const int ct = hf * 3 + t3;
                if (ct < 4) { const f32x4 hv = nm[t3] * inv; u32x2 pk; pk.x = cvt_pk_bf16(hv[0], hv[1]); pk.y = cvt_pk_bf16(hv[2], hv[3]); *(u32x2*)(orow + ct * 16) = pk; } }
        }
        {
            const float dec = SC[0];
#pragma unroll
            for (int dt = 0; dt < 2; ++dt) { bf16x8 xa[2];
#pragma unroll
                for (int ks = 0; ks < 2; ++ks) xa[ks] = lds_frag(KTW, 72, 32 * w + 16 * dt, ks * 32, lane);
#pragma unroll
                for (int ct = 0; ct < 5; ++ct) { S[dt][ct] = S[dt][ct] * dec;
#pragma unroll
                    for (int ks = 0; ks < 2; ++ks) S[dt][ct] = MFMA16(xa[ks], lds_frag(VT, 72, ct * 16, ks * 32, lane), S[dt][ct]);
                    u32x2 pk; pk.x = cvt_pk_bf16(S[dt][ct][0], S[dt][ct][1]); pk.y = cvt_pk_bf16(S[dt][ct][2], S[dt][ct][3]);
                    *(LAS u32x2*)(CB + (ct * 16 + l15) * 264 + 32 * w + 16 * dt + 4 * q4) = pk; } }
        }
        __syncthreads();
#undef TOK
    }
    if (sq.ctx) {
        float* co = p.out + OUT_MC + sidx * 256 * 256; float* no = p.out + OUT_MN + sidx * 256;
#pragma unroll
        for (int dt = 0; dt < 2; ++dt)
#pragma unroll
            for (int ct = 0; ct < 5; ++ct)
#pragma unroll
                for (int i = 0; i < 4; ++i) { const int dd = 32 * w + 16 * dt + 4 * q4 + i;
                    if (ct < 4) co[(size_t)dd * 256 + slice * 64 + ct * 16 + l15] = S[dt][ct][i];
                    else if (slice == 0 && l15 == 0) no[dd] = S[dt][ct][i]; }
        if (slice == 0 && tid == 0) p.out[OUT_MM + sidx] = SC[1];
    }
    __syncthreads();
}

__device__ __forceinline__ void lru_item(const Params& p, int l, const Seq sq, int dir, int nb, LAS unsigned char* lds) {
    LAS bf16_t* XC = (LAS bf16_t*)(lds);
    LAS float*  XF = (LAS float*)(lds + 17408);
    LAS f32x2*  AI = (LAS f32x2*)(lds + 50176);
    const int tid = tidx(), lane = tid & 63, w = tid >> 6, q4 = lane >> 4, l15 = lane & 15;
    const bf16_t* Z = (const bf16_t*)(p.ws + WS_Z);
    bf16_t* O = o_buf(p, dir, 2);
    const int ch = tid & 127, rg = tid >> 7;
    float cw[4];
#pragma unroll
    for (int j = 0; j < 4; ++j) cw[j] = p.in[I_LCW][((size_t)l * 4 + j) * 1024 + nb * 128 + ch];
    const float cb = p.in[I_LCB][l * 1024 + nb * 128 + ch];
    bf16x8 wf[2][4];
#pragma unroll
    for (int gt = 0; gt < 2; ++gt) { const bf16_t* wt = (const bf16_t*)(p.ws + W_LRU) + (size_t)((dir * 2 + gt) * 8 + nb) * 16384 + (size_t)(16 * w + l15) * 128 + q4 * 8;
#pragma unroll
        for (int ks = 0; ks < 4; ++ks) wf[gt][ks] = *(const bf16x8*)(wt + ks * 32); }
    const int jc = nb * 128 + 16 * w + l15;
    const float gb0 = p.in[I_LGB][((size_t)(l * 2 + dir) * 2 + 0) * 1024 + jc], gb1 = p.in[I_LGB][((size_t)(l * 2 + dir) * 2 + 1) * 1024 + jc];
    const float c8 = 8.f * softplus_f(-p.in[I_LLAM][(size_t)(l * 2 + dir) * 1024 + jc]);
    float hst = 0.f;
    if (tid < 128 && !sq.ctx) hst = p.in[I_SLRU][(((size_t)sq.b * 2 + l) * 2 + dir) * 1024 + nb * 128 + tid];
    const int nch = sq.len >> 6;
    for (int c = 0; c < nch; ++c) {
        const int t0 = dir ? sq.len - 64 * (c + 1) : 64 * c;
        {
            float xv[19];
#pragma unroll
            for (int i = 0; i < 19; ++i) { const int pos = t0 + 16 * rg - 2 + i; xv[i] = (pos >= 0 && pos < sq.len) ? bf2f(Z[(size_t)(sq.tl0 + pos) * ZLD + ZC_XR + nb * 128 + ch]) : 0.f; }
#pragma unroll
            for (int i = 0; i < 16; ++i) { const float o = cb + cw[0] * xv[i] + cw[1] * xv[i + 1] + cw[2] * xv[i + 2] + cw[3] * xv[i + 3];
                const int tt = 16 * rg + i, r = dir ? 63 - tt : tt; XC[r * 136 + ch] = f2bf(o); XF[r * 128 + ch] = o; }
        }
        __syncthreads();
        {
#pragma unroll
            for (int mt = 0; mt < 4; ++mt) { f32x4 a0 = {0.f, 0.f, 0.f, 0.f}, a1 = {0.f, 0.f, 0.f, 0.f};
#pragma unroll
                for (int ks = 0; ks < 4; ++ks) { const bf16x8 xa = lds_frag(XC, 136, mt * 16, ks * 32, lane); a0 = MFMA16(xa, wf[0][ks], a0); a1 = MFMA16(xa, wf[1][ks], a1); }
#pragma unroll
                for (int i = 0; i < 4; ++i) { const int r = mt * 16 + 4 * q4 + i, jl = 16 * w + l15;
                    const float rgate = sigmoid_f(a0[i] + gb0), igate = sigmoid_f(a1[i] + gb1);
                    const float la = -c8 * rgate, av = __expf(la), mult = sqrtf(fmaxf(-expm1f(2.f * la), 0.f));
                    AI[r * 128 + jl] = (f32x2){av, mult * igate * XF[r * 128 + jl]}; } }
        }
        __syncthreads();
        if (tid < 128) {
#pragma unroll 8
            for (int r = 0; r < 64; ++r) { const f32x2 ai = AI[r * 128 + tid]; hst = ai.x * hst + ai.y;
                const int pos = dir ? sq.len - 1 - (c * 64 + r) : c * 64 + r;
                O[(size_t)(sq.tl0 + pos) * 1024 + nb * 128 + tid] = f2bf(hst); }
        }
    }
    if (sq.ctx && tid < 128) p.out[OUT_LRU + (((size_t)sq.b * 2 + l) * 2 + dir) * 1024 + nb * 128 + tid] = hst;
    __syncthreads();
}

__device__ __forceinline__ int queue_pop(unsigned* ctr, volatile LAS unsigned* slot) {
    __syncthreads();
    if (threadIdx.x == 0) *slot = __hip_atomic_fetch_add(ctr, 1u, __ATOMIC_RELAXED, __HIP_MEMORY_SCOPE_AGENT);
    __syncthreads();
    return (int)*slot;
}
__device__ __forceinline__ void phase_scan(const Params& p, int l, int g, LAS unsigned char* lds) {
    unsigned* ctl = (unsigned*)(p.ws + WS_CTL);
    unsigned* q0 = ctl + CW_Q + 64 * ((l * 2 + g) * 3);
    volatile LAS unsigned* slot = (volatile LAS unsigned*)(lds + LDS_MISC + 64);
    const int ns = nseq_of(g);
#if DBG_STATIC_Q
    for (int it = blockIdx.x; it < ns * 32; it += gridDim.x) { __syncthreads();
        const Seq sq = seq_of(g, seq_index(g, it >> 5)); const int sub = it & 31; mlstm_item(p, l, sq, sub >> 3, (sub >> 2) & 1, sub & 3, lds); }
    for (int it = blockIdx.x; it < ns * 32; it += gridDim.x) { __syncthreads();
        const Seq sq = seq_of(g, seq_index(g, it >> 5)); const int sub = it & 31; gla_item(p, l, sq, sub >> 3, (sub >> 2) & 1, sub & 3, lds); }
    for (int it = blockIdx.x; it < ns * 16; it += gridDim.x) { __syncthreads();
        const Seq sq = seq_of(g, seq_index(g, it >> 4)); const int sub = it & 15; lru_item(p, l, sq, sub >> 3, sub & 7, lds); }
#else
    for (;;) { const int it = queue_pop(q0, slot); if (it >= ns * 32) break;
        const Seq sq = seq_of(g, seq_index(g, it >> 5)); const int sub = it & 31; mlstm_item(p, l, sq, sub >> 3, (sub >> 2) & 1, sub & 3, lds); }
    for (;;) { const int it = queue_pop(q0 + 64, slot); if (it >= ns * 32) break;
        const Seq sq = seq_of(g, seq_index(g, it >> 5)); const int sub = it & 31; gla_item(p, l, sq, sub >> 3, (sub >> 2) & 1, sub & 3, lds); }
    for (;;) { const int it = queue_pop(q0 + 128, slot); if (it >= ns * 16) break;
        const Seq sq = seq_of(g, seq_index(g, it >> 4)); const int sub = it & 15; lru_item(p, l, sq, sub >> 3, sub & 7, lds); }
#endif
}

__device__ __forceinline__ void phase_combine(const Params& p, int l) {
    const int tid_ = tidx(); const int lane = tid_ & 63, wave = tid_ >> 6;
    const int gw = blockIdx.x * 8 + wave, NGW = gridDim.x * 8;
    const bf16_t* Z = (const bf16_t*)(p.ws + WS_Z);
    for (int tl = gw; tl < TG; tl += NGW) {
#pragma unroll
        for (int mx = 0; mx < 2; ++mx) {
            bf16_t* o0 = o_buf(p, 0, mx) + (size_t)tl * 1024; const bf16_t* o1 = o_buf(p, 1, mx) + (size_t)tl * 1024;
            const float* gain = p.in[mx ? I_MNG : I_GNG] + l * 1024;
            const bf16_t* gz = Z + (size_t)tl * ZLD + (mx ? ZC_OB : ZC_GA);
#pragma unroll
            for (int hh = 0; hh < 4; ++hh) { const int c = hh * 256 + lane * 4;
                const u32x2 a = *(const u32x2*)(o0 + c), b = *(const u32x2*)(o1 + c), gq = *(const u32x2*)(gz + c);
                f32x4 v; v[0] = __uint_as_float(a.x << 16) + __uint_as_float(b.x << 16); v[1] = __uint_as_float(a.x & 0xffff0000u) + __uint_as_float(b.x & 0xffff0000u);
                v[2] = __uint_as_float(a.y << 16) + __uint_as_float(b.y << 16); v[3] = __uint_as_float(a.y & 0xffff0000u) + __uint_as_float(b.y & 0xffff0000u);
                const float ss = wave_sum((v[0] * v[0] + v[1] * v[1]) + (v[2] * v[2] + v[3] * v[3]));
                const float rstd = rsqrtf(ss * (1.f / 256.f) + EPS);
                const f32x4 gn = *(const f32x4*)(gain + c);
                f32x4 gt; gt[0] = __uint_as_float(gq.x << 16); gt[1] = __uint_as_float(gq.x & 0xffff0000u); gt[2] = __uint_as_float(gq.y << 16); gt[3] = __uint_as_float(gq.y & 0xffff0000u);
                f32x4 o;
#pragma unroll
                for (int e = 0; e < 4; ++e) o[e] = v[e] * rstd * gn[e] * (mx ? sigmoid_f(gt[e]) : silu_f(gt[e]));
                u32x2 wv; wv.x = cvt_pk_bf16(o[0], o[1]); wv.y = cvt_pk_bf16(o[2], o[3]); *(u32x2*)(o0 + c) = wv; }
        }
        {
            bf16_t* o0 = o_buf(p, 0, 2) + (size_t)tl * 1024; const bf16_t* o1 = o_buf(p, 1, 2) + (size_t)tl * 1024; const bf16_t* gz = Z + (size_t)tl * ZLD + ZC_YR;
#pragma unroll
            for (int hh = 0; hh < 4; ++hh) { const int c = hh * 256 + lane * 4;
                const u32x2 a = *(const u32x2*)(o0 + c), b = *(const u32x2*)(o1 + c), gq = *(const u32x2*)(gz + c);
                f32x4 v; v[0] = __uint_as_float(a.x << 16) + __uint_as_float(b.x << 16); v[1] = __uint_as_float(a.x & 0xffff0000u) + __uint_as_float(b.x & 0xffff0000u);
                v[2] = __uint_as_float(a.y << 16) + __uint_as_float(b.y << 16); v[3] = __uint_as_float(a.y & 0xffff0000u) + __uint_as_float(b.y & 0xffff0000u);
                f32x4 gt; gt[0] = __uint_as_float(gq.x << 16); gt[1] = __uint_as_float(gq.x & 0xffff0000u); gt[2] = __uint_as_float(gq.y << 16); gt[3] = __uint_as_float(gq.y & 0xffff0000u);
                f32x4 o;
#pragma unroll
                for (int e = 0; e < 4; ++e) o[e] = v[e] * gelu_tanh_f(gt[e]);
                u32x2 wv; wv.x = cvt_pk_bf16(o[0], o[1]); wv.y = cvt_pk_bf16(o[2], o[3]); *(u32x2*)(o0 + c) = wv; }
        }
    }
}

__device__ __forceinline__ void phase_convact(const Params& p, int l, int g) {
    const int tid_ = tidx(); const int lane = tid_ & 63, wave = tid_ >> 6;
    const int gw = blockIdx.x * 8 + wave, NGW = gridDim.x * 8;
    const bf16_t* H = (const bf16_t*)(p.ws + WS_Z); bf16_t* ACT = (bf16_t*)(p.ws + WS_O);
    const float* cwp = p.in[I_FCW] + (size_t)l * 9 * DFF; const float* cbp = p.in[I_FCB] + (size_t)l * DFF;
    for (int u = gw; u < (TG / 64) * 11; u += NGW) {
        const int cc = u % 11, trow = u / 11, f0 = cc * 512 + lane * 8;
        const int tl0 = trow * 64, t0 = g * TG + tl0;
        const bool ctx = t0 < NCTX;
        float wgt[9][8], bias[8];
#pragma unroll
        for (int k = 0; k < 9; ++k) { const f32x4 a = *(const f32x4*)(cwp + (size_t)k * DFF + f0), b = *(const f32x4*)(cwp + (size_t)k * DFF + f0 + 4);
#pragma unroll
            for (int e = 0; e < 4; ++e) { wgt[k][e] = a[e]; wgt[k][4 + e] = b[e]; } }
        { const f32x4 a = *(const f32x4*)(cbp + f0), b = *(const f32x4*)(cbp + f0 + 4);
#pragma unroll
            for (int e = 0; e < 4; ++e) { bias[e] = a[e]; bias[4 + e] = b[e]; } }
        int seq_l0, pos0, len;
        if (ctx) { seq_l0 = (tl0 >> 8) << 8; pos0 = tl0 & 255; len = 256; }
        else { const int lt = t0 - NCTX; const int sl = (lt >> 12) << 12; seq_l0 = sl + NCTX - g * TG; pos0 = lt & 4095; len = 4096; }
        for (int x = 0; x < 64; ++x) {
            const int pos = pos0 + x;
            float acc[8];
#pragma unroll
            for (int e = 0; e < 8; ++e) acc[e] = bias[e];
#pragma unroll
            for (int dy = 0; dy < 3; ++dy) {
                if (ctx && dy != 1) continue;
#pragma unroll
                for (int dx = 0; dx < 3; ++dx) {
                    bool ok; int np;
                    if (ctx) { np = pos + dx - 1; ok = np >= 0 && np < len; }
                    else { const int ry = (pos >> 6) + dy - 1, cx = (pos & 63) + dx - 1; ok = ry >= 0 && ry < 64 && cx >= 0 && cx < 64; np = ry * 64 + cx; }
                    if (ok) { const u32x4 hv = *(const u32x4*)(H + (size_t)(seq_l0 + np) * NUP + f0); const int k = dy * 3 + dx;
                        acc[0] += wgt[k][0] * __uint_as_float(hv.x << 16); acc[1] += wgt[k][1] * __uint_as_float(hv.x & 0xffff0000u);
                        acc[2] += wgt[k][2] * __uint_as_float(hv.y << 16); acc[3] += wgt[k][3] * __uint_as_float(hv.y & 0xffff0000u);
                        acc[4] += wgt[k][4] * __uint_as_float(hv.z << 16); acc[5] += wgt[k][5] * __uint_as_float(hv.z & 0xffff0000u);
                        acc[6] += wgt[k][6] * __uint_as_float(hv.w << 16); acc[7] += wgt[k][7] * __uint_as_float(hv.w & 0xffff0000u); }
                }
            }
            const u32x4 uv = *(const u32x4*)(H + (size_t)(tl0 + x) * NUP + DFF + f0);
            float hu[8]; hu[0] = __uint_as_float(uv.x << 16); hu[1] = __uint_as_float(uv.x & 0xffff0000u); hu[2] = __uint_as_float(uv.y << 16); hu[3] = __uint_as_float(uv.y & 0xffff0000u);
            hu[4] = __uint_as_float(uv.z << 16); hu[5] = __uint_as_float(uv.z & 0xffff0000u); hu[6] = __uint_as_float(uv.w << 16); hu[7] = __uint_as_float(uv.w & 0xffff0000u);
            float o[8];
#pragma unroll
            for (int e = 0; e < 8; ++e) o[e] = silu_f(acc[e]) * hu[e];
            u32x4 wv; wv.x = cvt_pk_bf16(o[0], o[1]); wv.y = cvt_pk_bf16(o[2], o[3]); wv.z = cvt_pk_bf16(o[4], o[5]); wv.w = cvt_pk_bf16(o[6], o[7]);
            *(u32x4*)(ACT + (size_t)(tl0 + x) * DFF + f0) = wv;
        }
    }
}


#ifndef DBG_NPH
#define DBG_NPH 44
#endif
#ifndef DBG_WHICH
#define DBG_WHICH 2
#endif
__device__ __forceinline__ void phase_dump(const Params& p, int which) {
    const size_t gid = (size_t)blockIdx.x * NTHREADS + threadIdx.x, gsz = (size_t)gridDim.x * NTHREADS;
    if (which == 1) { const bf16_t* Z = (const bf16_t*)(p.ws + WS_Z); for (size_t i = gid; i < (size_t)TG * 4096; i += gsz) p.out[i] = bf2f(Z[(i >> 12) * ZLD + (i & 4095)]); }
    if (which == 2) { const bf16_t* O = (const bf16_t*)(p.ws + WS_O); for (size_t i = gid; i < (size_t)6 * 13632 * 1024; i += gsz) { const size_t b = i / ((size_t)13632 * 1024), r = i % ((size_t)13632 * 1024); const float v = bf2f(O[b * TG * 1024 + r]); p.out[i] = (v - v == 0.f) ? v : 12345.f; }
        for (size_t i = OUT_GLA + gid; i < OUT_END; i += gsz) { const float v = p.out[i]; if (!(v - v == 0.f)) p.out[i] = 777.f; } }
    if (which == 3) { const bf16_t* U = (const bf16_t*)(p.ws + WS_U); for (size_t i = gid; i < (size_t)TG * 2048; i += gsz) p.out[i] = bf2f(U[i]); }
    if (which == 4) { const float* SMp = (const float*)(p.ws + WS_SM); for (size_t i = gid; i < (size_t)TG * 48; i += gsz) p.out[i] = SMp[(i / 48) * 64 + (i % 48)]; }
}

#ifndef DBG_CHECKS
#define DBG_CHECKS 1
#endif
#if DBG_CHECKS
constexpr int CW_DBG = 32768;
__device__ __forceinline__ void dbg_report(unsigned* ctl, int k, float e) { if (!(e - e == 0.f)) e = 700.f; else if (e > 500.f) e = 500.f; atomicMax(ctl + CW_DBG + 64 * k, __float_as_uint(e)); }
__device__ __forceinline__ void dbg_slot(unsigned* ctl, int s_, float e) { if (!(e - e == 0.f)) e = 94.9f; else if (e > 90.f) e = 90.f; atomicMax(ctl + CW_DBG + 64 * (8 + s_), __float_as_uint(e)); }
__device__ __forceinline__ void dbg_rms(unsigned* ctl, int cat, float diff, float ref) { if (!(diff - diff == 0.f)) { atomicAdd(ctl + CW_DBG + 64 * 25, 1u); return; } atomicAdd((float*)(ctl + CW_DBG + 64 * (30 + 2 * cat)), diff * diff); atomicAdd((float*)(ctl + CW_DBG + 64 * (31 + 2 * cat)), ref * ref); }
__global__ void chk_mod(Params p, int l) {
    unsigned* ctl = (unsigned*)(p.ws + WS_CTL); const float* mod = (const float*)(p.ws + WS_MOD);
    for (int idx = blockIdx.x * blockDim.x + threadIdx.x; idx < 9 * 2458; idx += gridDim.x * blockDim.x) { const int r = idx / 2458, j = (idx % 2458) * 5;
        float s = 0.f; for (int k = 0; k < 2048; ++k) { const float c = r < 8 ? p.in[I_C][r * 2048 + k] : p.in[I_CCTX][k]; s += silu_f(c) * p.in[I_WMOD][((size_t)l * 2048 + k) * 12288 + j]; }
        s += p.in[I_BMOD][l * 12288 + j];
        dbg_report(ctl, 5, fabsf(s - mod[((size_t)l * 9 + r) * 12288 + j]) / (2e-3f * (fabsf(s) + 0.1f))); }
}
__global__ void chk_norm(Params p, int l, int g) {
    unsigned* ctl = (unsigned*)(p.ws + WS_CTL); const float* mod_l = (const float*)(p.ws + WS_MOD) + (size_t)l * 9 * 12288; const bf16_t* U = (const bf16_t*)(p.ws + WS_U);
    __shared__ float red[256];
    for (int sidx = blockIdx.x; sidx < 160; sidx += gridDim.x) { const int tl = sidx * 127 + 5, t = g * TG + tl;
        const float* xr = t < NCTX ? p.in[I_XP] + (size_t)t * D : p.in[I_XS] + (size_t)(t - NCTX) * D;
        float s = 0.f; for (int j = threadIdx.x; j < D; j += 256) s += xr[j] * xr[j];
        red[threadIdx.x] = s; __syncthreads(); for (int o = 128; o > 0; o >>= 1) { if ((int)threadIdx.x < o) red[threadIdx.x] += red[threadIdx.x + o]; __syncthreads(); }
        const float rstd = 1.f / sqrtf(red[0] / D + EPS); __syncthreads();
        const int cond = t < NCTX ? 8 : (t - NCTX) >> 12; const float* sh = mod_l + (size_t)cond * 12288; const float* sc = sh + D;
        for (int j = threadIdx.x; j < D; j += 256) { const float ref = xr[j] * rstd * p.in[I_N1G][l * D + j] * (1.f + sc[j]) + sh[j];
            dbg_report(ctl, 4, fabsf(ref - bf2f(U[(size_t)tl * D + j])) / (0.01f * (fabsf(ref) + 0.1f))); } }
}
__global__ void chk_z(Params p, int l) {
    unsigned* ctl = (unsigned*)(p.ws + WS_CTL); const bf16_t* U = (const bf16_t*)(p.ws + WS_U); const bf16_t* Z = (const bf16_t*)(p.ws + WS_Z); const float* SM = (const float*)(p.ws + WS_SM);
    __shared__ float us[2048];
    for (int sidx = blockIdx.x; sidx < 96; sidx += gridDim.x) { const int tl = sidx * 211 + 3;
        for (int j = threadIdx.x; j < D; j += 256) us[j] = bf2f(U[(size_t)tl * D + j]); __syncthreads();
        for (int d = threadIdx.x; d < 15408; d += 256) { int sc_; if (d < 3072) sc_ = d; else if (d < 7168) sc_ = d + 32; else if (d < 15360) sc_ = d + 48; else if (d < 15392) sc_ = d - 15360 + 3072; else sc_ = d - 15392 + 7200;
            float s = 0.f; for (int k = 0; k < D; ++k) s += us[k] * p.in[I_WIN][((size_t)l * D + k) * 15408 + sc_];
            if (d < 512) s *= 0.08838834764831845f; else if (d >= ZC_KB && d < ZC_KB + 1024) s *= 0.0625f;
            float got; if (d >= ZC_MG && d < 15360) s = sigmoid_f(s + p.in[I_BMG][l * 3 * D + d - ZC_MG]);
            if (d < 15360) got = bf2f(Z[(size_t)tl * ZLD + d]); else got = SM[(size_t)tl * 64 + d - 15360];
            dbg_report(ctl, 3, fabsf(s - got) / (0.02f * (fabsf(s) + 0.5f))); }
        __syncthreads(); }
}
__global__ void chk_gla(Params p, int l, int g) {
    unsigned* ctl = (unsigned*)(p.ws + WS_CTL); const bf16_t* Z = (const bf16_t*)(p.ws + WS_Z); const float* SM = (const float*)(p.ws + WS_SM);
    __shared__ float S[128 * 64]; __shared__ float al[128], qv[128], kv[128], vv[64], ra[16];
    const int tid = threadIdx.x;
    for (int ch = blockIdx.x; ch < 24 * 4; ch += gridDim.x) { const int slice = ch & 3, c3 = ch >> 2, dir = c3 & 1, h = (c3 >> 1) & 3, si = c3 >> 3;
        const int s_id = g == 0 ? (si == 0 ? 1 : si == 1 ? 30 : 32) : si * 2; const Seq sq = seq_of(g, s_id);
        const float* s0 = p.in[I_SGLA] + ((((size_t)sq.b * 2 + l) * 2 + dir) * 4 + h) * 128 * 256;
        for (int i = tid; i < 128 * 64; i += 512) S[i] = sq.ctx ? 0.f : s0[(size_t)(i >> 6) * 256 + slice * 64 + (i & 63)];
        __syncthreads();
        const bf16_t* O = o_buf(p, dir, 0);
        const int nsteps = sq.len < 1024 ? sq.len : 1024;
        for (int st = 0; st < nsteps; ++st) { const int tl = sq.tl0 + (dir ? sq.len - 1 - st : st);
            if (tid < 16) ra[tid] = SM[(size_t)tl * 64 + dir * 16 + tid];
            if (tid < 128) { qv[tid] = bf2f(Z[(size_t)tl * ZLD + ZC_QA + h * 128 + tid]); kv[tid] = bf2f(Z[(size_t)tl * ZLD + ZC_KA + h * 128 + tid]); }
            if (tid >= 128 && tid < 192) vv[tid - 128] = bf2f(Z[(size_t)tl * ZLD + ZC_VA + h * 256 + slice * 64 + tid - 128]);
            __syncthreads();
            if (tid < 128) { float pre = p.in[I_GBA][(l * 2 + dir) * 512 + h * 128 + tid]; for (int j = 0; j < 16; ++j) pre += ra[j] * p.in[I_GWA][((size_t)(l * 2 + dir) * 16 + j) * 512 + h * 128 + tid]; al[tid] = __expf(logsigmoid_f(pre) * 0.0625f); }
            __syncthreads();
            for (int i = tid; i < 128 * 64; i += 512) { const int dd = i >> 6, cc = i & 63; S[i] = al[dd] * S[i] + kv[dd] * vv[cc]; }
            __syncthreads();
            if (tid < 64) { float o = 0.f; for (int dd = 0; dd < 128; ++dd) o += qv[dd] * S[dd * 64 + tid];
                const float e = fabsf(o - bf2f(O[(size_t)tl * 1024 + h * 256 + slice * 64 + tid])) / (0.03f * (fabsf(o) + 0.3f));
                dbg_report(ctl, 2, e); dbg_slot(ctl, 6, e);
                dbg_rms(ctl, (sq.ctx ? 0 : 2) + dir, o - bf2f(O[(size_t)tl * 1024 + h * 256 + slice * 64 + tid]), o); }
            __syncthreads(); }
        if (sq.ctx) { const float* so = p.out + OUT_GLA + ((((size_t)sq.b * 2 + l) * 2 + dir) * 4 + h) * 128 * 256;
            for (int i = tid; i < 128 * 64; i += 512) { const float e = fabsf(S[i] - so[(size_t)(i >> 6) * 256 + slice * 64 + (i & 63)]) / (0.03f * (fabsf(S[i]) + 0.3f)); dbg_report(ctl, 2, e); dbg_rms(ctl, 4, S[i] - so[(size_t)(i >> 6) * 256 + slice * 64 + (i & 63)], S[i]); } }
        __syncthreads(); }
}
__global__ void chk_mlstm(Params p, int l, int g) {
    unsigned* ctl = (unsigned*)(p.ws + WS_CTL); const bf16_t* Z = (const bf16_t*)(p.ws + WS_Z); const float* SM = (const float*)(p.ws + WS_SM);
    __shared__ float C[256 * 32]; __shared__ float nn[256], qv[256], kv[256], vv[32], red[512]; __shared__ float sc[4];
    const int tid = threadIdx.x;
    for (int ch = blockIdx.x; ch < 24 * 2; ch += gridDim.x) { const int sl = (ch & 1) * 5, c3 = ch >> 1, dir = c3 & 1, h = (c3 >> 1) & 3, si = c3 >> 3;
        const int s_id = g == 0 ? (si == 0 ? 2 : si == 1 ? 29 : 33) : si * 2; const Seq sq = seq_of(g, s_id);
        const size_t sidx = (((size_t)sq.b * 2 + l) * 2 + dir) * 4 + h;
        for (int i = tid; i < 256 * 32; i += 512) C[i] = sq.ctx ? 0.f : p.in[I_SMC][sidx * 65536 + (size_t)(i >> 5) * 256 + sl * 32 + (i & 31)];
        if (tid < 256) nn[tid] = sq.ctx ? 0.f : p.in[I_SMN][sidx * 256 + tid];
        float m = sq.ctx ? 0.f : p.in[I_SMM][sidx];
        __syncthreads();
        const bf16_t* O = o_buf(p, dir, 1);
        const float bi = p.in[I_MBIF][((l * 2 + dir) * 2 + 0) * 4 + h], bfg = p.in[I_MBIF][((l * 2 + dir) * 2 + 1) * 4 + h];
        const int nsteps = sq.len < 1024 ? sq.len : 1024;
        for (int st = 0; st < nsteps; ++st) { const int tl = sq.tl0 + (dir ? sq.len - 1 - st : st);
            if (tid < 256) { qv[tid] = bf2f(Z[(size_t)tl * ZLD + ZC_QB + h * 256 + tid]); kv[tid] = bf2f(Z[(size_t)tl * ZLD + ZC_KB + h * 256 + tid]); }
            if (tid >= 256 && tid < 288) vv[tid - 256] = bf2f(Z[(size_t)tl * ZLD + ZC_VB + h * 256 + sl * 32 + tid - 256]);
            const float gi = SM[(size_t)tl * 64 + 32 + dir * 8 + h] + bi, lf = logsigmoid_f(SM[(size_t)tl * 64 + 32 + dir * 8 + 4 + h] + bfg);
            const float mn = fmaxf(lf + m, gi), fp = __expf(lf + m - mn), ip = __expf(gi - mn); m = mn;
            __syncthreads();
            for (int i = tid; i < 256 * 32; i += 512) { const int dd = i >> 5, cc = i & 31; C[i] = fp * C[i] + ip * kv[dd] * vv[cc]; }
            if (tid < 256) nn[tid] = fp * nn[tid] + ip * kv[tid];
            __syncthreads();
            red[tid] = tid < 256 ? qv[tid] * nn[tid] : 0.f; __syncthreads();
            for (int o = 256; o > 0; o >>= 1) { if (tid < o) red[tid] += red[tid + o]; __syncthreads(); }
            const float den = fmaxf(fabsf(red[0]), __expf(-m));
            if (tid < 32) { float o = 0.f; for (int dd = 0; dd < 256; ++dd) o += qv[dd] * C[dd * 32 + tid]; o /= den;
                const float e = fabsf(o - bf2f(O[(size_t)tl * 1024 + h * 256 + sl * 32 + tid])) / (0.03f * (fabsf(o) + 0.05f));
                dbg_report(ctl, 1, e); dbg_slot(ctl, 6, e);
                dbg_rms(ctl, (sq.ctx ? 0 : 2) + dir, o - bf2f(O[(size_t)tl * 1024 + h * 256 + sl * 32 + tid]), o); }
            __syncthreads(); }
        if (sq.ctx) { for (int i = tid; i < 256 * 32; i += 512) { const float e = fabsf(C[i] - p.out[OUT_MC + sidx * 65536 + (size_t)(i >> 5) * 256 + sl * 32 + (i & 31)]) / (0.03f * (fabsf(C[i]) + 0.05f)); dbg_report(ctl, 1, e); dbg_rms(ctl, 4, C[i] - p.out[OUT_MC + sidx * 65536 + (size_t)(i >> 5) * 256 + sl * 32 + (i & 31)], C[i]); }
            if (tid < 256) dbg_report(ctl, 1, fabsf(nn[tid] - p.out[OUT_MN + sidx * 256 + tid]) / (0.03f * (fabsf(nn[tid]) + 0.05f)));
            if (tid == 0) dbg_report(ctl, 1, fabsf(m - p.out[OUT_MM + sidx]) / 0.02f); }
        __syncthreads(); }
}
__global__ void chk_lru(Params p, int l, int g) {
    unsigned* ctl = (unsigned*)(p.ws + WS_CTL); const bf16_t* Z = (const bf16_t*)(p.ws + WS_Z);
    __shared__ float xc[128];
    const int tid = threadIdx.x;
    for (int ch = blockIdx.x; ch < 3 * 2 * 8; ch += gridDim.x) { const int nb = ch & 7, dir = (ch >> 3) & 1, si = ch >> 4;
        const int s_id = g == 0 ? (si == 0 ? 3 : si == 1 ? 31 : 34) : si * 2; const Seq sq = seq_of(g, s_id);
        const int chn = nb * 128 + tid;
        float hst = sq.ctx ? 0.f : p.in[I_SLRU][(((size_t)sq.b * 2 + l) * 2 + dir) * 1024 + chn];
        const float c8 = 8.f * softplus_f(-p.in[I_LLAM][(size_t)(l * 2 + dir) * 1024 + chn]);
        const bf16_t* O = o_buf(p, dir, 2);
        const int nsteps = sq.len < 1024 ? sq.len : 1024;
        for (int st = 0; st < nsteps; ++st) { const int pos = dir ? sq.len - 1 - st : st;
            float x = p.in[I_LCB][l * 1024 + chn];
            for (int j = 0; j < 4; ++j) { const int pp = pos + j - 2; if (pp >= 0 && pp < sq.len) x += p.in[I_LCW][((size_t)l * 4 + j) * 1024 + chn] * bf2f(Z[(size_t)(sq.tl0 + pp) * ZLD + ZC_XR + chn]); }
            __syncthreads(); xc[tid] = x; __syncthreads();
            float p0 = p.in[I_LGB][((size_t)(l * 2 + dir) * 2 + 0) * 1024 + chn], p1 = p.in[I_LGB][((size_t)(l * 2 + dir) * 2 + 1) * 1024 + chn];
            const float* w0 = p.in[I_LGW] + ((((size_t)l * 2 + dir) * 2 + 0) * 8 + nb) * 16384; const float* w1 = w0 + 8 * 16384;
            for (int k = 0; k < 128; ++k) { p0 += xc[k] * w0[k * 128 + tid]; p1 += xc[k] * w1[k * 128 + tid]; }
            const float la = -c8 * sigmoid_f(p0), a = __expf(la); hst = a * hst + sqrtf(fmaxf(1.f - a * a, 0.f)) * sigmoid_f(p1) * x;
            dbg_report(ctl, 0, fabsf(hst - bf2f(O[(size_t)(sq.tl0 + pos) * 1024 + chn])) / (0.03f * (fabsf(hst) + 0.1f)));
            dbg_rms(ctl, (sq.ctx ? 0 : 2) + dir, hst - bf2f(O[(size_t)(sq.tl0 + pos) * 1024 + chn]), hst); }
        if (sq.ctx) dbg_report(ctl, 0, fabsf(hst - p.out[OUT_LRU + (((size_t)sq.b * 2 + l) * 2 + dir) * 1024 + chn]) / (0.03f * (fabsf(hst) + 0.1f)));
        if (sq.ctx) dbg_rms(ctl, 4, hst - p.out[OUT_LRU + (((size_t)sq.b * 2 + l) * 2 + dir) * 1024 + chn], hst);
        __syncthreads(); }
}

__global__ void chk_gla_lds(Params p, int l) {
    unsigned* ctl = (unsigned*)(p.ws + WS_CTL); const bf16_t* Z = (const bf16_t*)(p.ws + WS_Z); const float* SM = (const float*)(p.ws + WS_SM); const float* dbgp = (const float*)(p.ws + WS_DBG);
    __shared__ float cu[64 * 128]; __shared__ float qi[64 * 128 / 2];
    const int tid = threadIdx.x, h = 0, dir = DBG_DIR, c = DBG_CHUNK; const Seq sq = seq_of(0, 1);
    if (tid < 128) { float run = 0.f; for (int r = 0; r < 64; ++r) { const int tl = sq.tl0 + (dir ? sq.len - 1 - (c * 64 + r) : c * 64 + r);
            float pre = p.in[I_GBA][(l * 2 + dir) * 512 + h * 128 + tid]; for (int j = 0; j < 16; ++j) pre += SM[(size_t)tl * 64 + dir * 16 + j] * p.in[I_GWA][((size_t)(l * 2 + dir) * 16 + j) * 512 + h * 128 + tid];
            run += logsigmoid_f(pre) * 0.0625f; cu[r * 128 + tid] = run; } }
    __syncthreads();
    for (int i = tid; i < 64 * 128; i += blockDim.x) { const int r = i >> 7, d = i & 127; const int tl = sq.tl0 + (dir ? sq.len - 1 - (c * 64 + r) : c * 64 + r);
        const float cv = cu[i], last = cu[63 * 128 + d], q = bf2f(Z[(size_t)tl * ZLD + ZC_QA + h * 128 + d]), k = bf2f(Z[(size_t)tl * ZLD + ZC_KA + h * 128 + d]);
        const float qr = q * __expf(cv), kr = k * __expf(-cv), ker = k * __expf(last - cv);
        dbg_slot(ctl, 2, fabsf(kr - dbgp[16384 + i]) / (0.01f * (fabsf(kr) + 0.05f)));
        dbg_slot(ctl, 3, fabsf(ker - dbgp[24576 + d * 64 + r]) / (0.01f * (fabsf(ker) + 0.05f))); }
    for (int i = tid; i < 64 * 64; i += blockDim.x) { const int cc = i >> 6, r = i & 63; const int tl = sq.tl0 + (dir ? sq.len - 1 - (c * 64 + r) : c * 64 + r);
        const float v = bf2f(Z[(size_t)tl * ZLD + ZC_VA + h * 256 + cc]); dbg_slot(ctl, 4, fabsf(v - dbgp[32768 + i]) / (0.01f * (fabsf(v) + 0.05f))); }
    for (int i = tid; i < 64 * 64; i += blockDim.x) { const int ii = i >> 6, jj = i & 63; float a = 0.f;
        if (jj <= ii) for (int d = 0; d < 128; ++d) a += dbgp[8192 + ii * 128 + d] * dbgp[16384 + jj * 128 + d];
        dbg_slot(ctl, 6, fabsf(a - dbgp[36864 + i]) / (0.02f * (fabsf(a) + 0.1f))); }
    const bf16_t* Og = o_buf(p, dir, 0);
    for (int i = tid; i < 64 * 64; i += blockDim.x) { const int ii = i >> 6, cc = i & 63; float o = 0.f;
        for (int j = 0; j < 64; ++j) o += dbgp[36864 + ii * 64 + j] * dbgp[32768 + cc * 64 + j];
        for (int d = 0; d < 128; ++d) o += dbgp[8192 + ii * 128 + d] * dbgp[40960 + cc * 128 + d];
        const float od = dbgp[49152 + i]; const int tl = sq.tl0 + (dir ? sq.len - 1 - (c * 64 + ii) : c * 64 + ii);
        dbg_slot(ctl, 0, 10.f + fabsf(o - od) / (0.01f * (fabsf(o) + 0.1f)));
        dbg_slot(ctl, 1, 10.f + fabsf(bf2f(Og[(size_t)tl * 1024 + h * 256 + cc]) - od) / (0.01f * (fabsf(od) + 0.1f)));
        if (!(od - od == 0.f)) atomicAdd(ctl + CW_DBG + 64 * 18, 1u); }
    float mx = 0.f; for (int i = tid; i < 64 * 128; i += blockDim.x) mx = fmaxf(mx, fabsf(dbgp[40960 + i]));
    atomicMax(ctl + CW_DBG + 64 * 17, __float_as_uint(mx - mx == 0.f ? mx : 39.9f));
}
__global__ void chk_fin(Params p, int mask) {
    unsigned* ctl = (unsigned*)(p.ws + WS_CTL);
    const size_t offs[8] = {OUT_X, OUT_X + (size_t)NCTX * D, OUT_GLA, OUT_MC, OUT_MN, OUT_MM, OUT_LRU, OUT_END};
    for (int k = 0; k < 7; ++k) {
        int N;
        if (k < 5 && (mask & 7)) { const float a = *(float*)(ctl + CW_DBG + 64 * (30 + 2 * k)), b = *(float*)(ctl + CW_DBG + 64 * (31 + 2 * k)); const float r = b > 0.f ? sqrtf(a / b) : 0.9f; N = 1 + (int)(fminf(r, 0.9f) * 1000.f); }
        else if (k == 5 && (mask & 7)) { N = 1 + (int)ctl[CW_DBG + 64 * 25]; if (N > 400) N = 400; }
        else if (k < 6 && (mask & 6)) { N = 1 + (int)ctl[CW_DBG + 64 * (20 + k)]; if (N > (k == 5 ? 400 : 999)) N = (k == 5 ? 400 : 999); }
        else if (k == 4 && (mask & 64)) { N = 1 + (int)ctl[CW_DBG + 64 * 18]; if (N > 999) N = 999; }
        else if (k == 5 && (mask & 64)) { const float e = __uint_as_float(ctl[CW_DBG + 64 * 17]); N = 1 + (int)(fminf(e, 39.9f) * 10.f); }
        else if (k == 5) { const unsigned v = ctl[CW_DBG + 64 * 16]; N = v == 0u ? 1 : 2 + (int)((100000u - v) >> 6); if (N > 400) N = 400; }
        else { const int s_ = k == 6 ? 6 : k; const float e = __uint_as_float(ctl[CW_DBG + 64 * (8 + s_)]); N = 1 + (int)(e * 10.f); }
        for (size_t i = offs[k] + (size_t)blockIdx.x * blockDim.x + threadIdx.x; i < offs[k + 1]; i += (size_t)gridDim.x * blockDim.x) p.out[i] = (i - offs[k] < (size_t)N) ? __uint_as_float(0xAAAAAAAAu) : 0.f;
    }
}
#endif

#ifndef SKIPMASK
#define SKIPMASK 0
#endif
#define PH_SEL(bit, ...) { if constexpr (!((SKIPMASK >> (bit)) & 1)) { __VA_ARGS__ } }
#define PH_A(...) PH_SEL(0, __VA_ARGS__)
#define PH_B(...) PH_SEL(1, __VA_ARGS__)
#define PH_C(...) PH_SEL(2, __VA_ARGS__)
#define PH_D(...) PH_SEL(3, __VA_ARGS__)
#define PH_E(...) PH_SEL(4, __VA_ARGS__)
#define PH_G1(...) PH_SEL(5, __VA_ARGS__)
#define PH_G2(...) PH_SEL(6, __VA_ARGS__)
#define PH_G3(...) PH_SEL(7, __VA_ARGS__)
#define PH_G4(...) PH_SEL(8, __VA_ARGS__)
#define PH_G5(...) PH_SEL(9, __VA_ARGS__)
constexpr int N_PHASES = 44;
__global__ void __launch_bounds__(NTHREADS, 2) fwd_kernel(Params p) {
    extern __shared__ __attribute__((aligned(16))) unsigned char lds_raw[];
    LAS unsigned char* lds = (LAS unsigned char*)lds_raw;
    const int tid = threadIdx.x;
    volatile LAS unsigned* MISC = (volatile LAS unsigned*)(lds + LDS_MISC);
    if (tid < 32) MISC[tid] = 0u;
    __syncthreads();
    unsigned* ctl = (unsigned*)(p.ws + WS_CTL);
#if MK_PER_PHASE
#define GRID_BAR() do { } while (0)
#else
    XcdBarrier bar = xcd_barrier_post(ctl + CW_BAR, MISC + 8);
#define GRID_BAR() xcd_barrier(bar)
#endif
    const int lo = p.ph_lo, hi = p.ph_hi;
    const int G = gridDim.x, bx = blockIdx.x;
    const int vcu = (G % 8 == 0) ? (bx % 8) * (G / 8) + bx / 8 : bx;
#define IN(k) (lo <= (k) && (k) < hi)
#define SEAM(k) do { if (IN(k) && IN((k) + 1)) GRID_BAR(); } while (0)

    if (IN(0)) { if (bx == 0 && tid < 12) ctl[CW_Q + 64 * tid] = 0u;
        PH_A(phase_mod(p, lds); __syncthreads(); phase_wconv(p, 0, lds);) }
    SEAM(0);
    for (int l = 0; l < 2; ++l) {
        const int base = 1 + 21 * l;
        if (IN(base)) { PH_A(if (l > 0) phase_wconv(p, l, lds);) }
        SEAM(base);
        const float* mod_l = (const float*)(p.ws + WS_MOD) + (size_t)l * 9 * 12288;
        for (int g = 0; g < 2; ++g) {
            const int pb = base + 1 + 10 * g;
            if (IN(pb + 0)) { PH_B(phase_norm(p, l, g, 0, l == 0);) }
            SEAM(pb + 0);
            if (IN(pb + 1)) {
                pg8::Gemm gm{(const bf16_t*)(p.ws + WS_U), (const bf16_t*)(p.ws + W_IN), TG, NZ, D}; pg8::StaticOrder S; S.init(TG, NZ, G, bx);
                pg8::EpiZ E{(bf16_t*)(p.ws + WS_Z), (float*)(p.ws + WS_SM), p.in[I_BMG] + (size_t)l * 3 * D};
                PH_G1(pg8::gemm_phase<pg8::EpiZ, pg8::StaticOrder, true, true>(lds, gm, S, E);)
            }
            SEAM(pb + 1);
            if (IN(pb + 2)) { PH_C(phase_scan(p, l, g, lds);) }
            SEAM(pb + 2);
            if (IN(pb + 3)) { PH_D(phase_combine(p, l);) }
            SEAM(pb + 3);
            if (IN(pb + 4)) {
                pg8::Gemm gm{o_buf(p, 0, 0), (const bf16_t*)(p.ws + W_BR), 3 * TG, 3 * D, 1024}; pg8::BranchOrder S{G, vcu};
                pg8::EpiBranch E{(const bf16_t*)(p.ws + WS_Z), (float*)(p.ws + WS_SLAB) + (size_t)bx * 65536, (bf16_t*)(p.ws + WS_U)};
                PH_G2(pg8::gemm_phase<pg8::EpiBranch, pg8::BranchOrder, true, true>(lds, gm, S, E);)
            }
            SEAM(pb + 4);
            if (IN(pb + 5)) {
                pg8::Gemm gm{(const bf16_t*)(p.ws + WS_U), (const bf16_t*)(p.ws + W_OUT), TG, D, D}; pg8::StaticOrder S; S.init(TG, D, G, bx);
                const float* xc = l == 0 ? p.in[I_XP] : p.out + OUT_X; const float* xl = l == 0 ? p.in[I_XS] - (size_t)NCTX * D : p.out + OUT_X;
                pg8::EpiResid E{xc, xl, p.out + OUT_X, mod_l, 2, g * TG};
                PH_G3(pg8::gemm_phase<pg8::EpiResid, pg8::StaticOrder, true, true>(lds, gm, S, E);)
            }
            SEAM(pb + 5);
            if (IN(pb + 6)) { PH_B(phase_norm(p, l, g, 1, false);) }
            SEAM(pb + 6);
            if (IN(pb + 7)) {
                pg8::Gemm gm{(const bf16_t*)(p.ws + WS_U), (const bf16_t*)(p.ws + W_UP), TG, NUP, D}; pg8::StaticOrder S; S.init(TG, NUP, G, bx);
                pg8::EpiBf16 E{(bf16_t*)(p.ws + WS_Z), NUP};
                PH_G4(pg8::gemm_phase<pg8::EpiBf16, pg8::StaticOrder, true, true>(lds, gm, S, E);)
            }
            SEAM(pb + 7);
            if (IN(pb + 8)) { PH_E(phase_convact(p, l, g);) }
            SEAM(pb + 8);
            if (IN(pb + 9)) {
                pg8::Gemm gm{(const bf16_t*)(p.ws + WS_O), (const bf16_t*)(p.ws + W_DOWN), TG, D, DFF}; pg8::StaticOrder S; S.init(TG, D, G, bx);
                pg8::EpiResid E{p.out + OUT_X, p.out + OUT_X, p.out + OUT_X, mod_l, 5, g * TG};
                PH_G5(pg8::gemm_phase<pg8::EpiResid, pg8::StaticOrder, true, true>(lds, gm, S, E);)
            }
            SEAM(pb + 9);
        }
    }
    if (IN(43)) { PH_B(phase_final_norm(p);) }
    if (lo >= 100) phase_dump(p, lo - 100);
#undef IN
#undef SEAM
}

extern "C" void kernel_launch(void* const* d_in, const int* in_sizes, int n_in, void* d_out, int out_size, void* d_ws, size_t ws_size, hipStream_t stream) {
    static int grid = 0;
    if (grid == 0) {
        if (ws_size < WS_DBG + MiB) { fprintf(stderr, "kernel_launch: unexpected shapes (n_in %d out %d ws %zu)\n", n_in, out_size, ws_size); grid = -1; return; }
        int dev = 0, cus = 0;
        if (hipGetDevice(&dev) != hipSuccess || hipDeviceGetAttribute(&cus, hipDeviceAttributeMultiprocessorCount, dev) != hipSuccess) { grid = -1; return; }
        if (hipFuncSetAttribute((const void*)fwd_kernel, hipFuncAttributeMaxDynamicSharedMemorySize, LDS_BYTES) != hipSuccess) { fprintf(stderr, "kernel_launch: hipFuncSetAttribute failed\n"); grid = -1; return; }
        int per_cu = 0;
        if (hipOccupancyMaxActiveBlocksPerMultiprocessor(&per_cu, (const void*)fwd_kernel, NTHREADS, LDS_BYTES) != hipSuccess || per_cu < 1) { fprintf(stderr, "kernel_launch: occupancy query says %d\n", per_cu); (void)hipGetLastError(); grid = -1; return; }
        grid = cus;
    }
    if (grid < 0) return;
    (void)hipMemsetAsync((char*)d_ws + WS_CTL, 0, CTL_BYTES, stream);
    Params p{};
    for (int i = 0; i < 32; ++i) p.in[i] = (const float*)d_in[i];
    p.out = (float*)d_out; p.ws = (unsigned char*)d_ws;
#if MK_PER_PHASE
    for (int ph = 0; ph < DBG_NPH; ++ph) { if (ph == 1) continue; p.ph_lo = ph; p.ph_hi = ph + 1; hipLaunchKernelGGL(fwd_kernel, dim3(grid), dim3(NTHREADS), LDS_BYTES, stream, p); }
#if DBG_CHECKS
    { const int mask = DBG_MASK;
      if (mask & 32) hipLaunchKernelGGL(chk_mod, dim3(87), dim3(256), 0, stream, p, 0);
      if (mask & 16) hipLaunchKernelGGL(chk_norm, dim3(160), dim3(256), 0, stream, p, 0, 0);
      if (mask & 8) hipLaunchKernelGGL(chk_z, dim3(96), dim3(256), 0, stream, p, 0);
      if (mask & 4) hipLaunchKernelGGL(chk_gla, dim3(96), dim3(512), 0, stream, p, 0, 0);
      if (mask & 64) hipLaunchKernelGGL(chk_gla_lds, dim3(1), dim3(512), 0, stream, p, 0);
      if (mask & 2) hipLaunchKernelGGL(chk_mlstm, dim3(48), dim3(512), 0, stream, p, 0, 0);
      if (mask & 1) hipLaunchKernelGGL(chk_lru, dim3(48), dim3(128), 0, stream, p, 0, 0);
      hipLaunchKernelGGL(chk_fin, dim3(1024), dim3(256), 0, stream, p, mask); }
#endif
#else
    p.ph_lo = 0; p.ph_hi = N_PHASES;
    hipLaunchKernelGGL(fwd_kernel, dim3(grid), dim3(NTHREADS), LDS_BYTES, stream, p);
#endif
}
```

```cpp
#include <hip/hip_runtime.h>
#include <cstdio>
#include <cstdint>

#ifndef MK_PER_PHASE
#define MK_PER_PHASE 0
#endif

#ifndef DBG_DIR
#define DBG_DIR 0
#endif
#ifndef DBG_CHUNK
#define DBG_CHUNK 0
#endif
#ifndef DBG_CHECKS
#define DBG_CHECKS 0
#endif
#ifndef DBG_MASK
#define DBG_MASK 1
#endif
#ifndef DBG_STATIC_Q
#define DBG_STATIC_Q 0
#endif
#define LAS __attribute__((address_space(3)))
typedef unsigned short bf16_t;
typedef short bf16x8 __attribute__((ext_vector_type(8)));
typedef float f32x4 __attribute__((ext_vector_type(4)));
typedef float f32x2 __attribute__((ext_vector_type(2)));
typedef unsigned u32x4 __attribute__((ext_vector_type(4)));
typedef unsigned u32x2 __attribute__((ext_vector_type(2)));

constexpr int D = 2048, NCTX = 8192, NTOK = 40960, TG = 20480;
constexpr int ZLD = 15360, NZ = 15616, DFF = 5632, NUP = 11264;
constexpr int NTHREADS = 512;
constexpr float EPS = 1e-6f;

constexpr size_t MiB = 1u << 20;
constexpr size_t WS_CTL = 0, CTL_BYTES = 1 * MiB;
constexpr size_t WS_MOD = 1 * MiB;
constexpr size_t WS_W = 2 * MiB;
constexpr size_t W_IN = WS_W;
constexpr size_t W_BR = W_IN + (size_t)NZ * D * 2;
constexpr size_t W_OUT = W_BR + (size_t)3 * D * 1024 * 2;
constexpr size_t W_UP = W_OUT + (size_t)D * D * 2;
constexpr size_t W_DOWN = W_UP + (size_t)NUP * D * 2;
constexpr size_t W_LRU = W_DOWN + (size_t)D * DFF * 2;
constexpr size_t W_END = W_LRU + (size_t)32 * 128 * 128 * 2;
static_assert(W_END == 150 * MiB, "weight block");
constexpr size_t WS_U = 150 * MiB;
constexpr size_t WS_SM = 230 * MiB;
constexpr size_t WS_Z = 235 * MiB;
constexpr size_t WS_O = 835 * MiB;
constexpr size_t WS_SLAB = WS_O + 120 * MiB;
constexpr size_t WS_END = 1075 * MiB;
constexpr size_t WS_DBG = 1076 * MiB;
constexpr int CW_BAR = 4096;
constexpr int CW_Q = 16384;

constexpr int ZC_QA = 0, ZC_KA = 512, ZC_VA = 1024, ZC_GA = 2048, ZC_QB = 3072, ZC_KB = 4096, ZC_VB = 5120, ZC_OB = 6144, ZC_XR = 7168, ZC_YR = 8192, ZC_MG = 9216;

constexpr int LDS_BYTES = 155648;
constexpr int LDS_MISC = 153600;

struct Params {
    const float* in[32];
    float* out;
    unsigned char* ws;
    int ph_lo, ph_hi;
};

__device__ __forceinline__ float bf2f(unsigned short h) { return __uint_as_float(((unsigned)h) << 16); }
__device__ __forceinline__ unsigned short f2bf(float f) { unsigned u = __float_as_uint(f); return (unsigned short)((u + 0x7fffu + ((u >> 16) & 1u)) >> 16); }
typedef __bf16 bf16x2_t __attribute__((ext_vector_type(2)));
__device__ __forceinline__ unsigned cvt_pk_bf16(float lo, float hi) { const f32x2 f = {lo, hi}; const bf16x2_t v = __builtin_convertvector(f, bf16x2_t); return __builtin_bit_cast(unsigned, v); }
__device__ __forceinline__ float sigmoid_f(float x) { return 1.f / (1.f + __expf(-x)); }
__device__ __forceinline__ float silu_f(float x) { return x * sigmoid_f(x); }
__device__ __forceinline__ float logsigmoid_f(float x) { return fminf(x, 0.f) - log1pf(__expf(-fabsf(x))); }
__device__ __forceinline__ float softplus_f(float x) { return fmaxf(x, 0.f) + log1pf(__expf(-fabsf(x))); }
__device__ __forceinline__ float gelu_tanh_f(float x) { const float u = 0.7978845608028654f * (x + 0.044715f * x * x * x); const float t = 1.f - 2.f / (1.f + __expf(2.f * u)); return 0.5f * x * (1.f + t); }
__device__ __forceinline__ float wave_sum(float v) {
#pragma unroll
    for (int o = 1; o < 64; o <<= 1) v += __shfl_xor(v, o);
    return v;
}
__device__ __forceinline__ int tidx() { int t = threadIdx.x; asm volatile("" : "+v"(t)); return t; }
#define LDS_WAIT() asm volatile("s_waitcnt lgkmcnt(0)" ::: "memory")
#define VM_WAIT() asm volatile("s_waitcnt vmcnt(0)" ::: "memory")

namespace pg8 {
constexpr int BM = 256, BK = 64, HALF = 128, HTB = HALF * BK * 2, STAGE_BYTES = 8 * HTB, NXCD = 8, WGM = 8;
__host__ __device__ __forceinline__ int lds_byte(int r, int c) { const int st = (r >> 4) * 2 + (c >> 5), rr = r & 15, cc = c & 31, ob = rr * 64 + cc * 2; return st * 1024 + (ob ^ (((ob >> 9) & 1) << 5)); }
__host__ __device__ __forceinline__ void stage_rc(int b, int& R, int& C) { const int st = b / 1024, sb = b % 1024, swz = sb ^ (((sb >> 9) & 1) << 5); R = (st >> 1) * 16 + swz / 64; C = (st & 1) * 32 + (swz % 64) / 2; }
__host__ __device__ __forceinline__ int perm32(int rho) { const int n = rho >> 4, i = rho & 15; return 8 * (i >> 2) + 4 * n + (i & 3); }
struct Unit { int pm, pn; };
struct Gemm { const bf16_t* A; const bf16_t* Bt; int M, N, K; };
struct StaticOrder {
    int nM, nN, nwg, G, c;
    __device__ void init(int M, int N, int G_, int c_) { nM = M / BM; nN = N / BM; nwg = nM * nN; G = G_; c = c_; }
    __device__ bool next(int i, Unit& u) const {
        const long L = (long)i * G + c; if (L >= nwg) return false;
        int wgid = (int)L; { const int q = nwg / NXCD, r = nwg % NXCD, xcd = wgid % NXCD, off = wgid / NXCD; wgid = (xcd < r ? xcd * (q + 1) : r * (q + 1) + (xcd - r) * q) + off; }
        const int nig = WGM * nN, gid = wgid / nig, fm = gid * WGM, gsz = (nM - fm) < WGM ? (nM - fm) : WGM;
        u.pm = fm + ((wgid % nig) % gsz); u.pn = (wgid % nig) / gsz; return true;
    }
};
struct BranchOrder {
    int G, c;
    __device__ bool next(int i, Unit& u) const {
        const int L = (i / 3) * G + c, n = i % 3; if (L >= 80 * 8) return false;
        u.pm = n * 80 + (L >> 3); u.pn = n * 8 + (L & 7); return true;
    }
};

template <class Epi, class Sched, bool ALIGN_EPI, bool SP2>
__device__ __forceinline__ void gemm_phase(LAS unsigned char* lds, const Gemm g, const Sched& S, const Epi& E) {
    const int tid = tidx(), wid = __builtin_amdgcn_readfirstlane(tid >> 6), lane = tid & 63, wr = wid >> 2, wc = wid & 3, fr = lane & 15, fq = lane >> 4;
    const int K = g.K, nt = K / BK;
    unsigned voffA[2], voffB[2];
#pragma unroll
    for (int i = 0; i < 2; ++i) { int R, C; stage_rc(tid * 16 + i * 8192, R, C); const int Rb = Epi::PERM ? ((R & ~31) + perm32(R & 31)) : R;
        voffA[i] = (unsigned)(R * K + C) * 2u; voffB[i] = (unsigned)(Rb * K + C) * 2u; }
    const size_t kstep = (size_t)(BK * 2);
    const size_t hstep = (size_t)HALF * K * 2;
    const size_t tstep = 2 * hstep;
    const unsigned ldsw = (unsigned)wid * 1024u;
    const int aoff = lds_byte(wr * 64 + fr, fq * 8), boff = lds_byte(wc * 32 + fr, fq * 8);
#define PG8_SA(b, h) (((b) * 2 + (h)) * HTB)
#define PG8_SB(b, h) ((4 + (b) * 2 + (h)) * HTB)
#define PG8_STAGE(bufoff, gbase, voff) do { _Pragma("unroll") for (int _i = 0; _i < 2; ++_i) \
        __builtin_amdgcn_global_load_lds((const unsigned*)((const char*)(gbase) + (voff)[_i]), (LAS unsigned*)(lds + (bufoff) + ldsw + _i * 8192), 16, 0, 0); } while (0)
#define PG8_LDA(dst, b, h) do { _Pragma("unroll") for (int m = 0; m < 4; ++m) _Pragma("unroll") for (int k = 0; k < 2; ++k) dst[m][k] = *(const LAS bf16x8*)(lds + PG8_SA(b, h) + aoff + m * 2048 + k * 1024); } while (0)
#define PG8_LDB(dst, b, h) do { _Pragma("unroll") for (int n = 0; n < 2; ++n) _Pragma("unroll") for (int k = 0; k < 2; ++k) dst[n][k] = *(const LAS bf16x8*)(lds + PG8_SB(b, h) + boff + n * 2048 + k * 1024); } while (0)
#define PG8_MMA(ai, bj, At, Bt) do { __builtin_amdgcn_s_setprio(1); _Pragma("unroll") for (int m = 0; m < 4; ++m) _Pragma("unroll") for (int n = 0; n < 2; ++n) _Pragma("unroll") for (int k = 0; k < 2; ++k) \
        acc[ai][bj][m][n] = __builtin_amdgcn_mfma_f32_16x16x32_bf16(Bt[n][k], At[m][k], acc[ai][bj][m][n], 0, 0, 0); __builtin_amdgcn_s_setprio(0); } while (0)
#define PG8_WAIT_V(n) asm volatile("s_waitcnt vmcnt(" #n ")" ::: "memory")
#define PG8_WAIT_L(n) asm volatile("s_waitcnt lgkmcnt(" #n ")" ::: "memory")
#define PG8_BAR __builtin_amdgcn_s_barrier()
#define PG8_SCHED __builtin_amdgcn_sched_barrier(0)
    Unit cur, nxt; int ui = 0;
    if (!S.next(0, cur)) return;
    f32x4 acc[2][2][4][2];
#pragma unroll
    for (int a = 0; a < 2; ++a)
#pragma unroll
        for (int b = 0; b < 2; ++b)
#pragma unroll
            for (int m = 0; m < 4; ++m)
#pragma unroll
                for (int n = 0; n < 2; ++n) acc[a][b][m][n] = (f32x4){0.f, 0.f, 0.f, 0.f};
    bf16x8 At[4][2], B0[2][2], B1[2][2];
    const char* cA = (const char*)g.A + (size_t)cur.pm * tstep; const char* cB = (const char*)g.Bt + (size_t)cur.pn * tstep;
    if constexpr (SP2) {
        PG8_STAGE(PG8_SB(0, 0), cB, voffB); PG8_STAGE(PG8_SB(0, 1), cB + hstep, voffB); PG8_STAGE(PG8_SA(0, 0), cA, voffA); PG8_STAGE(PG8_SA(0, 1), cA + hstep, voffA);
        if (wr == 1) PG8_BAR;
        PG8_WAIT_V(2); PG8_BAR;
        PG8_STAGE(PG8_SB(1, 0), cB + kstep, voffB); PG8_STAGE(PG8_SA(1, 0), cA + kstep, voffA); PG8_STAGE(PG8_SB(1, 1), cB + hstep + kstep, voffB);
        PG8_WAIT_V(6); PG8_BAR;
    } else {
        PG8_STAGE(PG8_SB(0, 0), cB, voffB); PG8_STAGE(PG8_SA(0, 0), cA, voffA); PG8_STAGE(PG8_SB(0, 1), cB + hstep, voffB); PG8_STAGE(PG8_SA(0, 1), cA + hstep, voffA);
        if (wr == 1) PG8_BAR;
        PG8_WAIT_V(4); PG8_BAR;
        PG8_STAGE(PG8_SB(1, 0), cB + kstep, voffB); PG8_STAGE(PG8_SA(1, 0), cA + kstep, voffA); PG8_STAGE(PG8_SB(1, 1), cB + hstep + kstep, voffB);
        PG8_WAIT_V(6); PG8_BAR;
    }
    for (;;) {
        const bool has_next = S.next(ui + 1, nxt);
        const char* nA = has_next ? (const char*)g.A + (size_t)nxt.pm * tstep : cA; const char* nB = has_next ? (const char*)g.Bt + (size_t)nxt.pn * tstep : cB;
        for (int t = 0; t < nt; t += 2) {
            const bool last = (t == nt - 2);
            const char* a1 = cA + (size_t)(t + 1) * kstep;
            const char* a2 = last ? nA : cA + (size_t)(t + 2) * kstep; const char* b2 = last ? nB : cB + (size_t)(t + 2) * kstep;
            const char* a3 = a2 + kstep; const char* b3 = b2 + kstep;
            if constexpr (SP2) {
            PG8_LDB(B0, 0, 0); PG8_LDB(B1, 0, 1); PG8_SCHED; PG8_LDA(At, 0, 0); PG8_STAGE(PG8_SA(1, 1), a1 + hstep, voffA);
            PG8_WAIT_V(8); PG8_WAIT_L(0); PG8_BAR; PG8_MMA(0, 0, At, B0); PG8_MMA(0, 1, At, B1); PG8_BAR; PG8_SCHED;
            PG8_LDA(At, 0, 1); PG8_STAGE(PG8_SB(0, 0), b2, voffB); PG8_STAGE(PG8_SB(0, 1), b2 + hstep, voffB); PG8_STAGE(PG8_SA(0, 0), a2, voffA);
            PG8_WAIT_V(8); PG8_WAIT_L(0); PG8_BAR; PG8_MMA(1, 0, At, B0); PG8_MMA(1, 1, At, B1); PG8_BAR; PG8_SCHED;
            PG8_LDB(B0, 1, 0); PG8_LDB(B1, 1, 1); PG8_SCHED; PG8_LDA(At, 1, 0); PG8_STAGE(PG8_SA(0, 1), a2 + hstep, voffA);
            PG8_WAIT_V(8); PG8_WAIT_L(0); PG8_BAR; PG8_MMA(0, 0, At, B0); PG8_MMA(0, 1, At, B1); PG8_BAR; PG8_SCHED;
            PG8_LDA(At, 1, 1); PG8_STAGE(PG8_SB(1, 0), b3, voffB); PG8_STAGE(PG8_SB(1, 1), b3 + hstep, voffB); PG8_STAGE(PG8_SA(1, 0), a3, voffA);
            PG8_WAIT_V(8); PG8_WAIT_L(0); PG8_BAR; PG8_MMA(1, 0, At, B0); PG8_MMA(1, 1, At, B1); PG8_BAR; PG8_SCHED;
            } else {
            PG8_LDB(B0, 0, 0); PG8_SCHED; PG8_LDA(At, 0, 0); PG8_STAGE(PG8_SA(1, 1), a1 + hstep, voffA);
            PG8_WAIT_L(8); PG8_BAR; PG8_WAIT_L(0); PG8_MMA(0, 0, At, B0); PG8_BAR; PG8_SCHED;
            PG8_LDB(B1, 0, 1); PG8_STAGE(PG8_SB(0, 0), b2, voffB);
            PG8_BAR; PG8_WAIT_L(0); PG8_MMA(0, 1, At, B1); PG8_BAR;
            PG8_LDA(At, 0, 1); PG8_STAGE(PG8_SA(0, 0), a2, voffA);
            PG8_BAR; PG8_WAIT_L(0); PG8_MMA(1, 0, At, B0); PG8_BAR; PG8_SCHED;
            PG8_STAGE(PG8_SB(0, 1), b2 + hstep, voffB);
            PG8_WAIT_V(6); PG8_BAR; PG8_MMA(1, 1, At, B1); PG8_BAR;
            PG8_LDB(B0, 1, 0); PG8_SCHED; PG8_LDA(At, 1, 0); PG8_STAGE(PG8_SA(0, 1), a2 + hstep, voffA);
            PG8_WAIT_L(8); PG8_BAR; PG8_WAIT_L(0); PG8_MMA(0, 0, At, B0); PG8_BAR; PG8_SCHED;
            PG8_LDB(B1, 1, 1); PG8_STAGE(PG8_SB(1, 0), b3, voffB);
            PG8_BAR; PG8_WAIT_L(0); PG8_MMA(0, 1, At, B1); PG8_BAR;
            PG8_LDA(At, 1, 1); PG8_STAGE(PG8_SA(1, 0), a3, voffA);
            PG8_BAR; PG8_WAIT_L(0); PG8_MMA(1, 0, At, B0); PG8_BAR; PG8_SCHED;
            PG8_STAGE(PG8_SB(1, 1), b3 + hstep, voffB);
            PG8_WAIT_V(6); PG8_BAR; PG8_MMA(1, 1, At, B1); PG8_BAR;
            }
        }
        if constexpr (ALIGN_EPI) { if (wr == 0) PG8_BAR; }
        E(acc, cur, wr, wc, fr, fq);
        if (!has_next) break;
#pragma unroll
        for (int a = 0; a < 2; ++a)
#pragma unroll
            for (int b = 0; b < 2; ++b)
#pragma unroll
                for (int m = 0; m < 4; ++m)
#pragma unroll
                    for (int n = 0; n < 2; ++n) acc[a][b][m][n] = (f32x4){0.f, 0.f, 0.f, 0.f};
        cur = nxt; cA = nA; cB = nB; ++ui;
        if constexpr (ALIGN_EPI) { if (wr == 1) PG8_BAR; }
    }
    PG8_WAIT_V(0);
    if constexpr (!ALIGN_EPI) { if (wr == 0) PG8_BAR; }
    PG8_BAR;
#undef PG8_SA
#undef PG8_SB
#undef PG8_STAGE
#undef PG8_LDA
#undef PG8_LDB
#undef PG8_MMA
#undef PG8_WAIT_V
#undef PG8_WAIT_L
#undef PG8_BAR
#undef PG8_SCHED
}


struct EpiZ {
    static constexpr bool PERM = true;
    bf16_t* Z; float* SM; const float* b_merge;
    __device__ __forceinline__ void operator()(const f32x4 (&acc)[2][2][4][2], const Unit& u, int wr, int wc, int fr, int fq) const {
        const int row0 = u.pm * BM + wr * 64 + fr;
        if (u.pn < 60) {
            const int col0 = u.pn * BM + wc * 32 + 8 * fq; const bool mg = u.pn >= 36;
            if (!mg) {
#pragma unroll
                for (int ai = 0; ai < 2; ++ai)
#pragma unroll
                    for (int m = 0; m < 4; ++m) { bf16_t* rowp = Z + (size_t)(row0 + ai * HALF + m * 16) * ZLD + col0;
#pragma unroll
                        for (int bj = 0; bj < 2; ++bj) { const f32x4 v0 = acc[ai][bj][m][0], v1 = acc[ai][bj][m][1];
                            u32x4 w; w.x = cvt_pk_bf16(v0[0], v0[1]); w.y = cvt_pk_bf16(v0[2], v0[3]); w.z = cvt_pk_bf16(v1[0], v1[1]); w.w = cvt_pk_bf16(v1[2], v1[3]);
                            *(u32x4*)(rowp + bj * HALF) = w; } }
            } else {
#pragma unroll
                for (int bj = 0; bj < 2; ++bj) {
                    const f32x4 b0 = *(const f32x4*)(b_merge + (col0 - ZC_MG) + bj * HALF), b1 = *(const f32x4*)(b_merge + (col0 - ZC_MG) + bj * HALF + 4);
#pragma unroll
                    for (int ai = 0; ai < 2; ++ai)
#pragma unroll
                        for (int m = 0; m < 4; ++m) { bf16_t* rowp = Z + (size_t)(row0 + ai * HALF + m * 16) * ZLD + col0;
                            f32x4 v0 = acc[ai][bj][m][0] + b0, v1 = acc[ai][bj][m][1] + b1;
#pragma unroll
                            for (int e = 0; e < 4; ++e) { v0[e] = sigmoid_f(v0[e]); v1[e] = sigmoid_f(v1[e]); }
                            u32x4 w; w.x = cvt_pk_bf16(v0[0], v0[1]); w.y = cvt_pk_bf16(v0[2], v0[3]); w.z = cvt_pk_bf16(v1[0], v1[1]); w.w = cvt_pk_bf16(v1[2], v1[3]);
                            *(u32x4*)(rowp + bj * HALF) = w; asm volatile("" ::: "memory"); }
                }
            }
        } else {
            const int lc = wc * 32 + 8 * fq;
            if (lc < 48) {
#pragma unroll
                for (int ai = 0; ai < 2; ++ai)
#pragma unroll
                    for (int m = 0; m < 4; ++m) { float* rowp = SM + (size_t)(row0 + ai * HALF + m * 16) * 64 + lc;
                        *(f32x4*)(rowp) = acc[ai][0][m][0]; *(f32x4*)(rowp + 4) = acc[ai][0][m][1]; }
            }
        }
    }
};
struct EpiBranch {
    static constexpr bool PERM = true;
    const bf16_t* Z; float* slab; bf16_t* MG;
    __device__ __forceinline__ void operator()(const f32x4 (&acc)[2][2][4][2], const Unit& u, int wr, int wc, int fr, int fq) const {
        const int n = u.pn >> 3, pm = u.pm - n * 80, pn = u.pn & 7;
        const int row0 = pm * BM + wr * 64 + fr, col0 = pn * BM + wc * 32 + 8 * fq;
        float* sl = slab + (size_t)(((wr * 4 + wc) * 64 + fq * 16 + fr) * 128);
#pragma unroll
        for (int ai = 0; ai < 2; ++ai)
#pragma unroll
            for (int m = 0; m < 4; ++m) { const size_t row = (size_t)(row0 + ai * HALF + m * 16);
#pragma unroll
                for (int bj = 0; bj < 2; ++bj) {
                    const u32x4 gw = *(const u32x4*)(Z + row * ZLD + ZC_MG + n * D + col0 + bj * HALF);
                    f32x4 v0 = acc[ai][bj][m][0], v1 = acc[ai][bj][m][1];
                    v0[0] *= __uint_as_float(gw.x << 16); v0[1] *= __uint_as_float(gw.x & 0xffff0000u); v0[2] *= __uint_as_float(gw.y << 16); v0[3] *= __uint_as_float(gw.y & 0xffff0000u);
                    v1[0] *= __uint_as_float(gw.z << 16); v1[1] *= __uint_as_float(gw.z & 0xffff0000u); v1[2] *= __uint_as_float(gw.w << 16); v1[3] *= __uint_as_float(gw.w & 0xffff0000u);
                    const int e = ((ai * 4 + m) * 2 + bj) * 2;
                    float* s0 = sl + e * 4, * s1 = sl + (e + 1) * 4;
                    if (n > 0) { v0 += *(const f32x4*)s0; v1 += *(const f32x4*)s1; }
                    if (n < 2) { *(f32x4*)s0 = v0; *(f32x4*)s1 = v1; }
                    else { u32x4 w; w.x = cvt_pk_bf16(v0[0], v0[1]); w.y = cvt_pk_bf16(v0[2], v0[3]); w.z = cvt_pk_bf16(v1[0], v1[1]); w.w = cvt_pk_bf16(v1[2], v1[3]);
                        *(u32x4*)(MG + row * D + col0 + bj * HALF) = w; }
                    asm volatile("" ::: "memory");
                } }
    }
};
struct EpiResid {
    static constexpr bool PERM = false;
    const float* xin_ctx; const float* xin_lat; float* xout; const float* mod_l; int gidx; int row_off;
    __device__ __forceinline__ void operator()(const f32x4 (&acc)[2][2][4][2], const Unit& u, int wr, int wc, int fr, int fq) const {
        const int t0 = row_off + u.pm * BM;
        const int cond = t0 < NCTX ? 8 : (t0 - NCTX) >> 12;
        const float* xin = t0 < NCTX ? xin_ctx : xin_lat;
        const float* gate = mod_l + (size_t)cond * 12288 + gidx * D;
        const int row0 = t0 + wr * 64 + fr, col0 = u.pn * BM + wc * 32 + 4 * fq;
        f32x4 gv[2][2];
#pragma unroll
        for (int bj = 0; bj < 2; ++bj)
#pragma unroll
            for (int n = 0; n < 2; ++n) gv[bj][n] = *(const f32x4*)(gate + col0 + bj * HALF + n * 16);
#pragma unroll
        for (int ai = 0; ai < 2; ++ai)
#pragma unroll
            for (int m = 0; m < 4; ++m) { const size_t off = (size_t)(row0 + ai * HALF + m * 16) * D + col0;
#pragma unroll
                for (int bj = 0; bj < 2; ++bj)
#pragma unroll
                    for (int n = 0; n < 2; ++n) { const f32x4 xi = *(const f32x4*)(xin + off + bj * HALF + n * 16);
                        *(f32x4*)(xout + off + bj * HALF + n * 16) = xi + gv[bj][n] * acc[ai][bj][m][n]; } }
    }
};
struct EpiBf16 {
    static constexpr bool PERM = true;
    bf16_t* O; int ldc;
    __device__ __forceinline__ void operator()(const f32x4 (&acc)[2][2][4][2], const Unit& u, int wr, int wc, int fr, int fq) const {
        const int row0 = u.pm * BM + wr * 64 + fr, col0 = u.pn * BM + wc * 32 + 8 * fq;
#pragma unroll
        for (int ai = 0; ai < 2; ++ai)
#pragma unroll
            for (int m = 0; m < 4; ++m) { bf16_t* rowp = O + (size_t)(row0 + ai * HALF + m * 16) * ldc + col0;
#pragma unroll
                for (int bj = 0; bj < 2; ++bj) { const f32x4 v0 = acc[ai][bj][m][0], v1 = acc[ai][bj][m][1];
                    u32x4 w; w.x = cvt_pk_bf16(v0[0], v0[1]); w.y = cvt_pk_bf16(v0[2], v0[3]); w.z = cvt_pk_bf16(v1[0], v1[1]); w.w = cvt_pk_bf16(v1[2], v1[3]);
                    *(u32x4*)(rowp + bj * HALF) = w; } }
    }
};
}

#define XB_TMO      128
#define XB_XCNT(j)  (256  + 64 * (j))
#define XB_XSUB(j)  (1280 + 64 * (j))
#define XB_XGEN(j)  (2304 + 64 * (j))
#define XB_TOP      3328
#define XB_TOPGEN   3392
#define XCD_BAR_WORDS 3456
#define XB_SPIN_CAP (1u << 18)
__device__ __forceinline__ unsigned xb_ld(unsigned* p)              { return __hip_atomic_load(p, __ATOMIC_RELAXED, __HIP_MEMORY_SCOPE_AGENT); }
__device__ __forceinline__ unsigned xb_add(unsigned* p, unsigned v) { return __hip_atomic_fetch_add(p, v, __ATOMIC_RELAXED, __HIP_MEMORY_SCOPE_AGENT); }
__device__ __forceinline__ unsigned xb_xcc_id() { return (unsigned)__builtin_amdgcn_s_getreg((3 << 11) | 20) & 0xFu; }
#define XB_SPIN(cond, bar) do { unsigned _sp = 0; while (cond) { __builtin_amdgcn_s_sleep(1); \
    if ((++_sp & 255u) == 0u) { if (xb_ld(&(bar)[XB_TMO])) break; if (_sp > XB_SPIN_CAP) { atomicAdd(&(bar)[XB_TMO], 1u); break; } } } } while (0)
struct XcdBarrier { unsigned* bar; unsigned x; volatile LAS unsigned* st; };
__device__ __forceinline__ XcdBarrier xcd_barrier_post(unsigned* bar, volatile LAS unsigned* st) {
    XcdBarrier b; b.bar = bar; b.x = xb_xcc_id(); b.st = st;
    if (threadIdx.x == 0) (void)xb_add(&bar[XB_XCNT(b.x)], 1u);
    return b;
}
__device__ __forceinline__ void xcd_barrier_complete(unsigned* bar, unsigned x, unsigned& nloc, unsigned& nx) {
    const unsigned G = gridDim.x * gridDim.y * gridDim.z;
    unsigned sum, cnt, mine, sp = 0u;
    for (;;) {
        sum = 0u; cnt = 0u; mine = 0u;
#pragma unroll
        for (unsigned j = 0; j < 16; ++j) { const unsigned c = xb_ld(&bar[XB_XCNT(j)]); sum += c; cnt += (c > 0u) ? 1u : 0u; mine = (j == x) ? c : mine; }
        if (sum == G) break;
        __builtin_amdgcn_s_sleep(1);
        if ((++sp & 255u) == 0u) { if (xb_ld(&bar[XB_TMO])) break; if (sp > XB_SPIN_CAP) { atomicAdd(&bar[XB_TMO], 1u); break; } }
    }
    nloc = mine > 0u ? mine : 1u; nx = cnt > 0u ? cnt : 1u;
}
__device__ __forceinline__ void xcd_barrier(const XcdBarrier& b) {
    asm volatile("s_waitcnt vmcnt(0)" ::: "memory");
    __syncthreads();
    if (threadIdx.x == 0) {
        unsigned* bar = b.bar;
        __builtin_amdgcn_s_waitcnt(0);
        unsigned nloc = b.st[0], nx = b.st[1];
        if (nloc == 0u) { xcd_barrier_complete(bar, b.x, nloc, nx); b.st[0] = nloc; b.st[1] = nx; }
        const unsigned old = xb_add(&bar[XB_XSUB(b.x)], 1u);
        const unsigned gen = old / nloc;
        if (old + 1u == (gen + 1u) * nloc) {
            __builtin_amdgcn_fence(__ATOMIC_RELEASE, "agent");
            asm volatile("s_waitcnt vmcnt(0)" ::: "memory");
            const unsigned og = xb_add(&bar[XB_TOP], 1u);
            const unsigned tg = og / nx;
            if (og + 1u == (tg + 1u) * nx) xb_add(&bar[XB_TOPGEN], 1u);
            else XB_SPIN(xb_ld(&bar[XB_TOPGEN]) == tg, bar);
            __builtin_amdgcn_fence(__ATOMIC_ACQUIRE, "agent");
            xb_add(&bar[XB_XGEN(b.x)], 1u);
            asm volatile("s_waitcnt vmcnt(0)" ::: "memory");
        } else {
            XB_SPIN(xb_ld(&bar[XB_XGEN(b.x)]) == gen, bar);
            __builtin_amdgcn_fence(__ATOMIC_ACQUIRE, "agent");
            asm volatile("s_waitcnt vmcnt(0)" ::: "memory");
        }
    }
    __syncthreads();
}

enum { I_XP = 0, I_XS, I_SGLA, I_SMC, I_SMN, I_SMM, I_SLRU, I_C, I_CCTX, I_N1G, I_N2G, I_WMOD, I_BMOD, I_WIN, I_GWA, I_GBA, I_GNG, I_MBIF, I_MNG,
       I_LCW, I_LCB, I_LGW, I_LGB, I_LLAM, I_WBR, I_BMG, I_WOUT, I_FUP, I_FCW, I_FCB, I_FDOWN, I_NFG };
constexpr size_t OUT_X = 0;
constexpr size_t OUT_GLA = (size_t)NTOK * D;
constexpr size_t OUT_MC = OUT_GLA + (size_t)32 * 2 * 2 * 4 * 128 * 256;
constexpr size_t OUT_MN = OUT_MC + (size_t)32 * 2 * 2 * 4 * 256 * 256;
constexpr size_t OUT_MM = OUT_MN + (size_t)32 * 2 * 2 * 4 * 256;
constexpr size_t OUT_LRU = OUT_MM + (size_t)32 * 2 * 2 * 4;
constexpr size_t OUT_END = OUT_LRU + (size_t)32 * 2 * 2 * 1024;

struct Seq { int tl0, len, b, ctx; };
__device__ __forceinline__ Seq seq_of(int g, int s) {
    Seq q;
    if (g == 0) { if (s < 32) { q.tl0 = s * 256; q.len = 256; q.b = s; q.ctx = 1; } else { q.tl0 = NCTX + (s - 32) * 4096; q.len = 4096; q.b = s - 32; q.ctx = 0; } }
    else { q.tl0 = s * 4096; q.len = 4096; q.b = 3 + s; q.ctx = 0; }
    return q;
}
__device__ __forceinline__ int seq_index(int g, int k) { return g == 0 ? (k < 3 ? 32 + k : k - 3) : k; }
__device__ __forceinline__ int nseq_of(int g) { return g == 0 ? 35 : 5; }

__device__ __forceinline__ bf16x8 lds_frag(const LAS bf16_t* base, int ld, int row0, int k0, int lane) {
    return *(const LAS bf16x8*)(base + (row0 + (lane & 15)) * ld + k0 + (lane >> 4) * 8);
}
#define MFMA16(x, y, acc) __builtin_amdgcn_mfma_f32_16x16x32_bf16((x), (y), (acc), 0, 0, 0)

__device__ __forceinline__ void phase_mod(const Params& p, LAS unsigned char* lds) {
    LAS float* sc = (LAS float*)lds;
    LAS float* red = (LAS float*)(lds + 9 * 2048 * 4);
    const int tid = tidx();
    if ((int)blockIdx.x >= 384) return;
    for (int i = tid; i < 9 * 2048; i += NTHREADS) { const int r = i >> 11, k = i & 2047; const float v = r < 8 ? p.in[I_C][r * 2048 + k] : p.in[I_CCTX][k]; sc[i] = silu_f(v); }
    __syncthreads();
    float* mod = (float*)(p.ws + WS_MOD);
    for (int u = blockIdx.x; u < 384; u += gridDim.x) {
        const int l = u / 192, cb = u % 192, col = tid & 63, kp = tid >> 6;
        const float* w = p.in[I_WMOD] + (size_t)l * 2048 * 12288 + cb * 64 + col;
        float a[9];
#pragma unroll
        for (int r = 0; r < 9; ++r) a[r] = 0.f;
        for (int k = kp * 256; k < kp * 256 + 256; ++k) { const float wv = w[(size_t)k * 12288];
#pragma unroll
            for (int r = 0; r < 9; ++r) a[r] += sc[r * 2048 + k] * wv; }
#pragma unroll
        for (int r = 0; r < 9; ++r) red[(kp * 9 + r) * 64 + col] = a[r];
        __syncthreads();
        for (int i = tid; i < 9 * 64; i += NTHREADS) { const int r = i >> 6, c2 = i & 63; float s = 0.f;
#pragma unroll
            for (int q = 0; q < 8; ++q) s += red[(q * 9 + r) * 64 + c2];
            mod[((size_t)l * 9 + r) * 12288 + cb * 64 + c2] = s + p.in[I_BMOD][l * 12288 + cb * 64 + c2]; }
        __syncthreads();
    }
}

__device__ __forceinline__ void transpose_item(const float* W, int K, int Nsrc, int k0, int src_n0, int nvalid, float scale, bf16_t* dst, LAS float* scr, int lane) {
#pragma unroll 8
    for (int i = 0; i < 32; ++i) { const int kk = 2 * i + (lane >> 5), n = lane & 31; scr[kk * 33 + n] = n < nvalid ? W[(size_t)(k0 + kk) * Nsrc + src_n0 + n] * scale : 0.f; }
    LDS_WAIT(); asm volatile("" ::: "memory");
    const int c = lane & 7;
#pragma unroll
    for (int j = 0; j < 4; ++j) { const int n = (lane >> 3) + 8 * j; const LAS float* s = scr + (8 * c) * 33 + n;
        u32x4 o; o.x = cvt_pk_bf16(s[0 * 33], s[1 * 33]); o.y = cvt_pk_bf16(s[2 * 33], s[3 * 33]); o.z = cvt_pk_bf16(s[4 * 33], s[5 * 33]); o.w = cvt_pk_bf16(s[6 * 33], s[7 * 33]);
        *(u32x4*)(dst + (size_t)n * K + k0 + 8 * c) = o; }
    LDS_WAIT(); asm volatile("" ::: "memory");
}
__device__ __forceinline__ void phase_wconv(const Params& p, int l, LAS unsigned char* lds) {
    const int tid_ = tidx(); const int lane = tid_ & 63, wave = tid_ >> 6;
    LAS float* scr = (LAS float*)(lds + wave * 16384);
    const int gw = blockIdx.x * 8 + wave, NGW = gridDim.x * 8;
    constexpr int I_IN = 32 * 488, I_BRn = 16 * 64 * 3, I_OUTn = 32 * 64, I_UPn = 32 * 352, I_DNn = 88 * 64, I_LR = 32 * 8;
    constexpr int NITEMS = I_IN + I_BRn + I_OUTn + I_UPn + I_DNn + I_LR;
    for (int it = gw; it < NITEMS; it += NGW) {
        int r = it;
        if (r < I_IN) {
            const int kb = r / 488, nb = r % 488, d0 = nb * 32; int s0, nv = 32; float sc = 1.f;
            if (d0 < 3072) s0 = d0; else if (d0 < 7168) s0 = d0 + 32; else if (d0 < 15360) s0 = d0 + 48; else if (d0 < 15392) s0 = d0 - 15360 + 3072; else if (d0 < 15424) { s0 = 7200; nv = 16; } else { s0 = 0; nv = 0; }
            if (d0 < 512) sc = 0.08838834764831845f; else if (d0 >= ZC_KB && d0 < ZC_KB + 1024) sc = 0.0625f;
            transpose_item(p.in[I_WIN] + (size_t)l * 2048 * 15408, 2048, 15408, kb * 64, s0, nv, sc, (bf16_t*)(p.ws + W_IN) + (size_t)d0 * 2048, scr, lane); continue; }
        r -= I_IN;
        if (r < I_BRn) { const int n = r / (16 * 64), q = r % (16 * 64), kb = q / 64, nb = q % 64;
            transpose_item(p.in[I_WBR] + ((size_t)l * 3 + n) * 1024 * 2048, 1024, 2048, kb * 64, nb * 32, 32, 1.f, (bf16_t*)(p.ws + W_BR) + ((size_t)n * 2048 + nb * 32) * 1024, scr, lane); continue; }
        r -= I_BRn;
        if (r < I_OUTn) { const int kb = r / 64, nb = r % 64;
            transpose_item(p.in[I_WOUT] + (size_t)l * 2048 * 2048, 2048, 2048, kb * 64, nb * 32, 32, 1.f, (bf16_t*)(p.ws + W_OUT) + (size_t)(nb * 32) * 2048, scr, lane); continue; }
        r -= I_OUTn;
        if (r < I_UPn) { const int kb = r / 352, nb = r % 352;
            transpose_item(p.in[I_FUP] + (size_t)l * 2048 * NUP, 2048, NUP, kb * 64, nb * 32, 32, 1.f, (bf16_t*)(p.ws + W_UP) + (size_t)(nb * 32) * 2048, scr, lane); continue; }
        r -= I_UPn;
        if (r < I_DNn) { const int kb = r / 64, nb = r % 64;
            transpose_item(p.in[I_FDOWN] + (size_t)l * DFF * 2048, DFF, 2048, kb * 64, nb * 32, 32, 1.f, (bf16_t*)(p.ws + W_DOWN) + (size_t)(nb * 32) * DFF, scr, lane); continue; }
        r -= I_DNn;
        { const int mat = r / 8, q = r % 8, kb = q / 4, nb = q % 4;
            transpose_item(p.in[I_LGW] + ((size_t)l * 32 + mat) * 16384, 128, 128, kb * 64, nb * 32, 32, 1.f, (bf16_t*)(p.ws + W_LRU) + (size_t)mat * 16384 + (size_t)(nb * 32) * 128, scr, lane); }
    }
}

__device__ __forceinline__ void phase_norm(const Params& p, int l, int g, int which, bool from_input) {
    const int tid_ = tidx(); const int lane = tid_ & 63, wave = tid_ >> 6;
    const int gw = blockIdx.x * 8 + wave, NGW = gridDim.x * 8;
    const float* ng = p.in[which ? I_N2G : I_N1G] + l * D;
    const float* mod_l = (const float*)(p.ws + WS_MOD) + (size_t)l * 9 * 12288;
    bf16_t* U = (bf16_t*)(p.ws + WS_U);
    for (int tl = gw; tl < TG; tl += NGW) {
        const int t = g * TG + tl;
        const float* xr = from_input ? (t < NCTX ? p.in[I_XP] + (size_t)t * D : p.in[I_XS] + (size_t)(t - NCTX) * D) : p.out + OUT_X + (size_t)t * D;
        const int cond = t < NCTX ? 8 : (t - NCTX) >> 12;
        const float* sh = mod_l + (size_t)cond * 12288 + (which * 3) * D; const float* sc = sh + D;
        f32x4 v[8]; float s = 0.f;
#pragma unroll
        for (int j = 0; j < 8; ++j) { v[j] = *(const f32x4*)(xr + j * 256 + lane * 4); s += (v[j][0] * v[j][0] + v[j][1] * v[j][1]) + (v[j][2] * v[j][2] + v[j][3] * v[j][3]); }
        const float rstd = rsqrtf(wave_sum(s) * (1.f / D) + EPS);
#pragma unroll
        for (int j = 0; j < 8; ++j) { const int c = j * 256 + lane * 4; const f32x4 gv = *(const f32x4*)(ng + c), sv = *(const f32x4*)(sc + c), hv = *(const f32x4*)(sh + c);
            f32x4 o = v[j] * rstd * gv * (sv + 1.f) + hv;
            u32x2 w; w.x = cvt_pk_bf16(o[0], o[1]); w.y = cvt_pk_bf16(o[2], o[3]); *(u32x2*)(U + (size_t)tl * D + c) = w; }
    }
}
__device__ __forceinline__ void phase_final_norm(const Params& p) {
    const int tid_ = tidx(); const int lane = tid_ & 63, wave = tid_ >> 6;
    const int gw = blockIdx.x * 8 + wave, NGW = gridDim.x * 8;
    const float* ng = p.in[I_NFG];
    for (int t = gw; t < NTOK; t += NGW) {
        float* xr = p.out + OUT_X + (size_t)t * D;
        f32x4 v[8]; float s = 0.f;
#pragma unroll
        for (int j = 0; j < 8; ++j) { v[j] = *(const f32x4*)(xr + j * 256 + lane * 4); s += (v[j][0] * v[j][0] + v[j][1] * v[j][1]) + (v[j][2] * v[j][2] + v[j][3] * v[j][3]); }
        const float rstd = rsqrtf(wave_sum(s) * (1.f / D) + EPS);
#pragma unroll
        for (int j = 0; j < 8; ++j) { const int c = j * 256 + lane * 4; const f32x4 gv = *(const f32x4*)(ng + c); *(f32x4*)(xr + c) = v[j] * rstd * gv; }
    }
}

__device__ __forceinline__ bf16_t* o_buf(const Params& p, int dir, int mixer) { return (bf16_t*)(p.ws + WS_O) + ((size_t)(dir * 3 + mixer) * TG) * 1024; }

__device__ __forceinline__ void gla_item(const Params& p, int l, const Seq sq, int h, int dir, int slice, LAS unsigned char* lds) {
    LAS bf16_t* QIN = (LAS bf16_t*)(lds);
    LAS bf16_t* KIN = (LAS bf16_t*)(lds + 17408);
    LAS bf16_t* KET = (LAS bf16_t*)(lds + 34816);
    LAS bf16_t* VT  = (LAS bf16_t*)(lds + 53248);
    LAS bf16_t* ATT = (LAS bf16_t*)(lds + 62464);
    LAS bf16_t* SB  = (LAS bf16_t*)(lds + 71680);
    LAS float*  RA  = (LAS float*)(lds + 89088);
    LAS float*  GT  = (LAS float*)(lds + 93184);
    LAS float*  EL  = (LAS float*)(lds + 95232);
    const int tid = tidx(), lane = tid & 63, w = tid >> 6, q4 = lane >> 4, l15 = lane & 15;
    const bf16_t* Z = (const bf16_t*)(p.ws + WS_Z); const float* SM = (const float*)(p.ws + WS_SM);
    bf16_t* O = o_buf(p, dir, 0);
    const int d = tid & 127, rg = tid >> 7;
    float wal[16];
#pragma unroll
    for (int j = 0; j < 16; ++j) wal[j] = p.in[I_GWA][((size_t)(l * 2 + dir) * 16 + j) * 512 + h * 128 + d];
    const float bal = p.in[I_GBA][(l * 2 + dir) * 512 + h * 128 + d];
    f32x4 S[4];
    {
        const float* s0 = p.in[I_SGLA] + ((((size_t)sq.b * 2 + l) * 2 + dir) * 4 + h) * 128 * 256;
#pragma unroll
        for (int nt = 0; nt < 4; ++nt)
#pragma unroll
            for (int i = 0; i < 4; ++i) S[nt][i] = sq.ctx ? 0.f : s0[(size_t)(16 * w + 4 * q4 + i) * 256 + slice * 64 + nt * 16 + l15];
#pragma unroll
        for (int nt = 0; nt < 4; ++nt) { u32x2 pk; pk.x = cvt_pk_bf16(S[nt][0], S[nt][1]); pk.y = cvt_pk_bf16(S[nt][2], S[nt][3]); *(LAS u32x2*)(SB + (nt * 16 + l15) * 136 + 16 * w + 4 * q4) = pk; }
    }
    const int nch = sq.len >> 6;
    for (int c = 0; c < nch; ++c) {
#define TOK(r) (sq.tl0 + (dir ? sq.len - 1 - (c * 64 + (r)) : c * 64 + (r)))
        if (tid < 256) { const int r = tid >> 2, j4 = (tid & 3) * 4; *(LAS f32x4*)(RA + r * 16 + j4) = *(const f32x4*)(SM + (size_t)TOK(r) * 64 + dir * 16 + j4); }
        {
            const int cc = tid & 63, r8 = tid >> 6; unsigned short vv[8];
#pragma unroll
            for (int i = 0; i < 8; ++i) vv[i] = Z[(size_t)TOK(r8 * 8 + i) * ZLD + ZC_VA + h * 256 + slice * 64 + cc];
            u32x4 pk; pk.x = vv[0] | ((unsigned)vv[1] << 16); pk.y = vv[2] | ((unsigned)vv[3] << 16); pk.z = vv[4] | ((unsigned)vv[5] << 16); pk.w = vv[6] | ((unsigned)vv[7] << 16);
            *(LAS u32x4*)(VT + cc * 72 + r8 * 8) = pk;
        }
        unsigned short qv[16], kv[16];
#pragma unroll
        for (int i = 0; i < 16; ++i) { const size_t ro = (size_t)TOK(rg * 16 + i) * ZLD + h * 128 + d; qv[i] = Z[ro + ZC_QA]; kv[i] = Z[ro + ZC_KA]; }
        __syncthreads();
        float cum[16];
        {
            float run = 0.f;
#pragma unroll
            for (int i = 0; i < 16; ++i) { float pre = bal; const LAS float* rr = RA + (rg * 16 + i) * 16;
#pragma unroll
                for (int j = 0; j < 16; ++j) pre += rr[j] * wal[j];
                run += logsigmoid_f(pre) * 0.0625f; cum[i] = run; }
            GT[rg * 128 + d] = run;
        }
        __syncthreads();
        float pre = 0.f, last = 0.f;
#pragma unroll
        for (int g2 = 0; g2 < 4; ++g2) { const float t = GT[g2 * 128 + d]; last += t; if (g2 < rg) pre += t; }
        unsigned short ke[16];
#pragma unroll
        for (int i = 0; i < 16; ++i) { const float cu = cum[i] + pre; const float e = __expf(cu), ei = __expf(-cu), qf = bf2f(qv[i]), kf = bf2f(kv[i]);
            QIN[(rg * 16 + i) * 136 + d] = f2bf(qf * e); KIN[(rg * 16 + i) * 136 + d] = f2bf(kf * ei); ke[i] = f2bf(kf * __expf(last - cu)); }
        { u32x4 a, b; a.x = ke[0] | ((unsigned)ke[1] << 16); a.y = ke[2] | ((unsigned)ke[3] << 16); a.z = ke[4] | ((unsigned)ke[5] << 16); a.w = ke[6] | ((unsigned)ke[7] << 16);
            b.x = ke[8] | ((unsigned)ke[9] << 16); b.y = ke[10] | ((unsigned)ke[11] << 16); b.z = ke[12] | ((unsigned)ke[13] << 16); b.w = ke[14] | ((unsigned)ke[15] << 16);
            *(LAS u32x4*)(KET + d * 72 + rg * 16) = a; *(LAS u32x4*)(KET + d * 72 + rg * 16 + 8) = b; }
        if (rg == 0) EL[d] = __expf(last);
        const bool dbg_item = DBG_CHECKS && sq.ctx && sq.b == 1 && h == 0 && dir == DBG_DIR && slice == 0 && c == DBG_CHUNK;
        float* dbgp = (float*)(p.ws + WS_DBG);
        if (dbg_item) {
#pragma unroll
            for (int i = 0; i < 16; ++i) dbgp[(rg * 16 + i) * 128 + d] = cum[i] + pre;
        }
        __syncthreads();
        if (dbg_item) {
            for (int i = tid; i < 64 * 128; i += NTHREADS) { dbgp[8192 + i] = bf2f(QIN[(i >> 7) * 136 + (i & 127)]); dbgp[16384 + i] = bf2f(KIN[(i >> 7) * 136 + (i & 127)]); dbgp[24576 + i] = bf2f(KET[(i >> 6) * 72 + (i & 63)]); }
            for (int i = tid; i < 64 * 64; i += NTHREADS) dbgp[32768 + i] = bf2f(VT[(i >> 6) * 72 + (i & 63)]);
        }
        const int mt = w >> 1, nt0 = 2 * (w & 1);
        {
#pragma unroll
            for (int t2 = 0; t2 < 2; ++t2) { const int nt = nt0 + t2; f32x4 a = {0.f, 0.f, 0.f, 0.f};
                if (nt <= mt) {
#pragma unroll
                    for (int ks = 0; ks < 4; ++ks) a = MFMA16(lds_frag(KIN, 136, nt * 16, ks * 32, lane), lds_frag(QIN, 136, mt * 16, ks * 32, lane), a);
                }
                const int i = mt * 16 + l15, j0 = nt * 16 + 4 * q4;
#pragma unroll
                for (int e = 0; e < 4; ++e) if (j0 + e > i) a[e] = 0.f;
                u32x2 pk; pk.x = cvt_pk_bf16(a[0], a[1]); pk.y = cvt_pk_bf16(a[2], a[3]); *(LAS u32x2*)(ATT + i * 72 + j0) = pk; }
        }
        __syncthreads();
        if (dbg_item) { for (int i = tid; i < 64 * 64; i += NTHREADS) dbgp[36864 + i] = bf2f(ATT[(i >> 6) * 72 + (i & 63)]);
            for (int i = tid; i < 64 * 128; i += NTHREADS) dbgp[40960 + i] = bf2f(SB[(i >> 7) * 136 + (i & 127)]); }
        {
#pragma unroll
            for (int t2 = 0; t2 < 2; ++t2) { const int nt = nt0 + t2; f32x4 a = {0.f, 0.f, 0.f, 0.f};
#pragma unroll
                for (int ks = 0; ks < 2; ++ks) a = MFMA16(lds_frag(VT, 72, nt * 16, ks * 32, lane), lds_frag(ATT, 72, mt * 16, ks * 32, lane), a);
#pragma unroll
                for (int ks = 0; ks < 4; ++ks) a = MFMA16(lds_frag(SB, 136, nt * 16, ks * 32, lane), lds_frag(QIN, 136, mt * 16, ks * 32, lane), a);
                u32x2 pk; pk.x = cvt_pk_bf16(a[0], a[1]); pk.y = cvt_pk_bf16(a[2], a[3]);
                if (dbg_item) { for (int e = 0; e < 4; ++e) dbgp[49152 + (mt * 16 + l15) * 64 + nt * 16 + 4 * q4 + e] = a[e]; }
                *(u32x2*)(O + (size_t)TOK(mt * 16 + l15) * 1024 + h * 256 + slice * 64 + nt * 16 + 4 * q4) = pk; }
        }
        __syncthreads();
        {
            const f32x4 el = *(const LAS f32x4*)(EL + 16 * w + 4 * q4);
#pragma unroll
            for (int nt = 0; nt < 4; ++nt) { S[nt] = S[nt] * el;
#pragma unroll
                for (int ks = 0; ks < 2; ++ks) S[nt] = MFMA16(lds_frag(KET, 72, w * 16, ks * 32, lane), lds_frag(VT, 72, nt * 16, ks * 32, lane), S[nt]);
                u32x2 pk; pk.x = cvt_pk_bf16(S[nt][0], S[nt][1]); pk.y = cvt_pk_bf16(S[nt][2], S[nt][3]); *(LAS u32x2*)(SB + (nt * 16 + l15) * 136 + 16 * w + 4 * q4) = pk; }
        }
        __syncthreads();
#undef TOK
    }
    if (sq.ctx) {
        float* so = p.out + OUT_GLA + ((((size_t)sq.b * 2 + l) * 2 + dir) * 4 + h) * 128 * 256;
#pragma unroll
        for (int nt = 0; nt < 4; ++nt)
#pragma unroll
            for (int i = 0; i < 4; ++i) so[(size_t)(16 * w + 4 * q4 + i) * 256 + slice * 64 + nt * 16 + l15] = S[nt][i];
    }
}

__device__ __forceinline__ void mlstm_item(const Params& p, int l, const Seq sq, int h, int dir, int slice, LAS unsigned char* lds) {
    LAS bf16_t* KN  = (LAS bf16_t*)(lds);
    LAS bf16_t* KTW = (LAS bf16_t*)(lds + 33792);
    LAS bf16_t* VT  = (LAS bf16_t*)(lds + 70656);
    LAS bf16_t* SMm = (LAS bf16_t*)(lds + 82176);
    LAS bf16_t* CB  = (LAS bf16_t*)(lds + 91392);
    LAS float*  AA  = (LAS float*)(lds + 133632);
    LAS float*  MX  = AA + 64;
    LAS float*  WP  = AA + 128;
    LAS float*  FL  = AA + 192;
    LAS float*  WL  = AA + 256;
    LAS float*  DEN = AA + 320;
    LAS float*  SC  = AA + 384;
    const int tid = tidx(), lane = tid & 63, w = tid >> 6, q4 = lane >> 4, l15 = lane & 15;
    const bf16_t* Z = (const bf16_t*)(p.ws + WS_Z); const float* SM = (const float*)(p.ws + WS_SM);
    bf16_t* O = o_buf(p, dir, 1);
    const float bi = p.in[I_MBIF][((l * 2 + dir) * 2 + 0) * 4 + h], bfg = p.in[I_MBIF][((l * 2 + dir) * 2 + 1) * 4 + h];
    const size_t sidx = (((size_t)sq.b * 2 + l) * 2 + dir) * 4 + h;
    f32x4 S[2][5];
    {
        const float* c0 = p.in[I_SMC] + sidx * 256 * 256; const float* n0 = p.in[I_SMN] + sidx * 256;
#pragma unroll
        for (int dt = 0; dt < 2; ++dt)
#pragma unroll
            for (int ct = 0; ct < 5; ++ct)
#pragma unroll
                for (int i = 0; i < 4; ++i) { const int dd = 32 * w + 16 * dt + 4 * q4 + i; float v = 0.f;
                    if (!sq.ctx) { if (ct < 4) v = c0[(size_t)dd * 256 + slice * 64 + ct * 16 + l15]; else if (l15 == 0) v = n0[dd]; }
                    S[dt][ct][i] = v; }
#pragma unroll
        for (int dt = 0; dt < 2; ++dt)
#pragma unroll
            for (int ct = 0; ct < 5; ++ct) { u32x2 pk; pk.x = cvt_pk_bf16(S[dt][ct][0], S[dt][ct][1]); pk.y = cvt_pk_bf16(S[dt][ct][2], S[dt][ct][3]);
                *(LAS u32x2*)(CB + (ct * 16 + l15) * 264 + 32 * w + 16 * dt + 4 * q4) = pk; }
        for (int i = tid; i < 16 * 64; i += NTHREADS) { const int rr = i >> 6, cc = i & 63; VT[(64 + rr) * 72 + cc] = rr == 0 ? (bf16_t)0x3F80 : (bf16_t)0; }
        if (tid == 0) SC[1] = sq.ctx ? 0.f : p.in[I_SMM][sidx];
    }
    __syncthreads();
    const int mt = w & 3, hf = w >> 2;
    const int nch = sq.len >> 6;
    for (int c = 0; c < nch; ++c) {
#define TOK(r) (sq.tl0 + (dir ? sq.len - 1 - (c * 64 + (r)) : c * 64 + (r)))
        bf16x8 qf[8];
        { const bf16_t* qrow = Z + (size_t)TOK(mt * 16 + l15) * ZLD + ZC_QB + h * 256 + q4 * 8;
#pragma unroll
            for (int ks = 0; ks < 8; ++ks) qf[ks] = *(const bf16x8*)(qrow + ks * 32); }
        if (w == 0) {
            const float m_prev = SC[1];
            const float* sm = SM + (size_t)TOK(lane) * 64 + 32 + dir * 8 + h;
            const float gi = sm[0] + bi, lf = logsigmoid_f(sm[4] + bfg);
            float fc = lf;
#pragma unroll
            for (int o = 1; o < 64; o <<= 1) { const float t = __shfl_up(fc, o); if (lane >= o) fc += t; }
            const float a = gi - fc; float pm = a;
#pragma unroll
            for (int o = 1; o < 64; o <<= 1) { const float t = __shfl_up(pm, o); if (lane >= o) pm = fmaxf(pm, t); }
            const float mx = fmaxf(m_prev, pm), mj = fc + mx;
            const float mx63 = __shfl(mx, 63), fc63 = __shfl(fc, 63);
            AA[lane] = a; MX[lane] = mx; WP[lane] = __expf(m_prev - mx); FL[lane] = __expf(-mj); WL[lane] = __expf(a - mx63);
            LDS_WAIT();
            if (lane == 63) { SC[0] = __expf(m_prev - mx63); SC[1] = fc63 + mx63; }
        }
        {
            const int cc = tid & 63, r8 = tid >> 6; unsigned short vv[8];
#pragma unroll
            for (int i = 0; i < 8; ++i) vv[i] = Z[(size_t)TOK(r8 * 8 + i) * ZLD + ZC_VB + h * 256 + slice * 64 + cc];
            u32x4 pk; pk.x = vv[0] | ((unsigned)vv[1] << 16); pk.y = vv[2] | ((unsigned)vv[3] << 16); pk.z = vv[4] | ((unsigned)vv[5] << 16); pk.w = vv[6] | ((unsigned)vv[7] << 16);
            *(LAS u32x4*)(VT + cc * 72 + r8 * 8) = pk;
        }
        __syncthreads();
        {
            const int dd = tid & 255, r32 = tid >> 8;
#pragma unroll
            for (int i8 = 0; i8 < 4; ++i8) { unsigned short kk[8], kw[8];
#pragma unroll
                for (int i = 0; i < 8; ++i) { const int r = r32 * 32 + i8 * 8 + i; kk[i] = Z[(size_t)TOK(r) * ZLD + ZC_KB + h * 256 + dd]; KN[r * 264 + dd] = kk[i]; kw[i] = f2bf(bf2f(kk[i]) * WL[r]); }
                u32x4 pk; pk.x = kw[0] | ((unsigned)kw[1] << 16); pk.y = kw[2] | ((unsigned)kw[3] << 16); pk.z = kw[4] | ((unsigned)kw[5] << 16); pk.w = kw[6] | ((unsigned)kw[7] << 16);
                *(LAS u32x4*)(KTW + dd * 72 + r32 * 32 + i8 * 8) = pk; }
        }
        __syncthreads();
        {
            const int j = mt * 16 + l15; const float mxj = MX[j];
#pragma unroll
            for (int t2 = 0; t2 < 2; ++t2) { const int nt = 2 * hf + t2; f32x4 a = {0.f, 0.f, 0.f, 0.f};
                if (nt <= mt) {
#pragma unroll
                    for (int ks = 0; ks < 8; ++ks) a = MFMA16(lds_frag(KN, 264, nt * 16, ks * 32, lane), qf[ks], a);
                }
                const int i0 = nt * 16 + 4 * q4; const f32x4 av = *(const LAS f32x4*)(AA + i0);
#pragma unroll
                for (int e = 0; e < 4; ++e) a[e] = (i0 + e <= j) ? a[e] * __expf(av[e] - mxj) : 0.f;
                u32x2 pk; pk.x = cvt_pk_bf16(a[0], a[1]); pk.y = cvt_pk_bf16(a[2], a[3]); *(LAS u32x2*)(SMm + j * 72 + i0) = pk; }
        }
        __syncthreads();
        {
            const int j = mt * 16 + l15; const float wpj = WP[j];
            f32x4 nm[3];
#pragma unroll
            for (int t3 = 0; t3 < 3; ++t3) { const int ct = hf * 3 + t3; nm[t3] = (f32x4){0.f, 0.f, 0.f, 0.f};
                if (ct < 5) {
#pragma unroll
                    for (int ks = 0; ks < 8; ++ks) nm[t3] = MFMA16(lds_frag(CB, 264, ct * 16, ks * 32, lane), qf[ks], nm[t3]);
                    nm[t3] = nm[t3] * wpj;
#pragma unroll
                    for (int ks = 0; ks < 2; ++ks) nm[t3] = MFMA16(lds_frag(VT, 72, ct * 16, ks * 32, lane), lds_frag(SMm, 72, mt * 16, ks * 32, lane), nm[t3]);
                } }
            if (hf == 1 && q4 == 0) DEN[j] = nm[1][0];
            __syncthreads();
            const float dn = fmaxf(fabsf(DEN[j]), FL[j]), inv = 1.f / dn;
            bf16_t* orow = O + (size_t)TOK(j) * 1024 + h * 256 + slice * 64 + 4 * q4;
#pragma unroll
            for (int t3 = 0; t3 < 3; ++t3) { const int ct = hf * 3 + t3;
                if (ct < 4) { const f32x4 hv = nm[t3] * inv; u32x2 pk; pk.x = cvt_pk_bf16(hv[0], hv[1]); pk.y = cvt_pk_bf16(hv[2], hv[3]); *(u32x2*)(orow + ct * 16) = pk; } }
        }
        {
            const float dec = SC[0];
#pragma unroll
            for (int dt = 0; dt < 2; ++dt) { bf16x8 xa[2];
#pragma unroll
                for (int ks = 0; ks < 2; ++ks) xa[ks] = lds_frag(KTW, 72, 32 * w + 16 * dt, ks * 32, lane);
#pragma unroll
                for (int ct = 0; ct < 5; ++ct) { S[dt][ct] = S[dt][ct] * dec;
#pragma unroll
                    for (int ks = 0; ks < 2; ++ks) S[dt][ct] = MFMA16(xa[ks], lds_frag(VT, 72, ct * 16, ks * 32, lane), S[dt][ct]);
                    u32x2 pk; pk.x = cvt_pk_bf16(S[dt][ct][0], S[dt][ct][1]); pk.y = cvt_pk_bf16(S[dt][ct][2], S[dt][ct][3]);
                    *(LAS u32x2*)(CB + (ct * 16 + l15) * 264 + 32 * w + 16 * dt + 4 * q4) = pk; } }
        }
        __syncthreads();
#undef TOK
    }
    if (sq.ctx) {
        float* co = p.out + OUT_MC + sidx * 256 * 256; float* no = p.out + OUT_MN + sidx * 256;
#pragma unroll
        for (int dt = 0; dt < 2; ++dt)
#pragma unroll
            for (int ct = 0; ct < 5; ++ct)
#pragma unroll
                for (int i = 0; i < 4; ++i) { const int dd = 32 * w + 16 * dt + 4 * q4 + i;
                    if (ct < 4) co[(size_t)dd * 256 + slice * 64 + ct * 16 + l15] = S[dt][ct][i];
                    else if (slice == 0 && l15 == 0) no[dd] = S[dt][ct][i]; }
        if (slice == 0 && tid == 0) p.out[OUT_MM + sidx] = SC[1];
    }
    __syncthreads();
}

__device__ __forceinline__ void lru_item(const Params& p, int l, const Seq sq, int dir, int nb, LAS unsigned char* lds) {
    LAS bf16_t* XC = (LAS bf16_t*)(lds);
    LAS float*  XF = (LAS float*)(lds + 17408);
    LAS f32x2*  AI = (LAS f32x2*)(lds + 50176);
    const int tid = tidx(), lane = tid & 63, w = tid >> 6, q4 = lane >> 4, l15 = lane & 15;
    const bf16_t* Z = (const bf16_t*)(p.ws + WS_Z);
    bf16_t* O = o_buf(p, dir, 2);
    const int ch = tid & 127, rg = tid >> 7;
    float cw[4];
#pragma unroll
    for (int j = 0; j < 4; ++j) cw[j] = p.in[I_LCW][((size_t)l * 4 + j) * 1024 + nb * 128 + ch];
    const float cb = p.in[I_LCB][l * 1024 + nb * 128 + ch];
    bf16x8 wf[2][4];
#pragma unroll
    for (int gt = 0; gt < 2; ++gt) { const bf16_t* wt = (const bf16_t*)(p.ws + W_LRU) + (size_t)((dir * 2 + gt) * 8 + nb) * 16384 + (size_t)(16 * w + l15) * 128 + q4 * 8;
#pragma unroll
        for (int ks = 0; ks < 4; ++ks) wf[gt][ks] = *(const bf16x8*)(wt + ks * 32); }
    const int jc = nb * 128 + 16 * w + l15;
    const float gb0 = p.in[I_LGB][((size_t)(l * 2 + dir) * 2 + 0) * 1024 + jc], gb1 = p.in[I_LGB][((size_t)(l * 2 + dir) * 2 + 1) * 1024 + jc];
    const float c8 = 8.f * softplus_f(-p.in[I_LLAM][(size_t)(l * 2 + dir) * 1024 + jc]);
    float hst = 0.f;
    if (tid < 128 && !sq.ctx) hst = p.in[I_SLRU][(((size_t)sq.b * 2 + l) * 2 + dir) * 1024 + nb * 128 + tid];
    const int nch = sq.len >> 6;
    for (int c = 0; c < nch; ++c) {
        const int t0 = dir ? sq.len - 64 * (c + 1) : 64 * c;
        {
            float xv[19];
#pragma unroll
            for (int i = 0; i < 19; ++i) { const int pos = t0 + 16 * rg - 2 + i; xv[i] = (pos >= 0 && pos < sq.len) ? bf2f(Z[(size_t)(sq.tl0 + pos) * ZLD + ZC_XR + nb * 128 + ch]) : 0.f; }
#pragma unroll
            for (int i = 0; i < 16; ++i) { const float o = cb + cw[0] * xv[i] + cw[1] * xv[i + 1] + cw[2] * xv[i + 2] + cw[3] * xv[i + 3];
                const int tt = 16 * rg + i, r = dir ? 63 - tt : tt; XC[r * 136 + ch] = f2bf(o); XF[r * 128 + ch] = o; }
        }
        __syncthreads();
        {
#pragma unroll
            for (int mt = 0; mt < 4; ++mt) { f32x4 a0 = {0.f, 0.f, 0.f, 0.f}, a1 = {0.f, 0.f, 0.f, 0.f};
#pragma unroll
                for (int ks = 0; ks < 4; ++ks) { const bf16x8 xa = lds_frag(XC, 136, mt * 16, ks * 32, lane); a0 = MFMA16(xa, wf[0][ks], a0); a1 = MFMA16(xa, wf[1][ks], a1); }
#pragma unroll
                for (int i = 0; i < 4; ++i) { const int r = mt * 16 + 4 * q4 + i, jl = 16 * w + l15;
                    const float rgate = sigmoid_f(a0[i] + gb0), igate = sigmoid_f(a1[i] + gb1);
                    const float la = -c8 * rgate, av = __expf(la), mult = sqrtf(fmaxf(-expm1f(2.f * la), 0.f));
                    AI[r * 128 + jl] = (f32x2){av, mult * igate * XF[r * 128 + jl]}; } }
        }
        __syncthreads();
        if (tid < 128) {
#pragma unroll 8
            for (int r = 0; r < 64; ++r) { const f32x2 ai = AI[r * 128 + tid]; hst = ai.x * hst + ai.y;
                const int pos = dir ? sq.len - 1 - (c * 64 + r) : c * 64 + r;
                O[(size_t)(sq.tl0 + pos) * 1024 + nb * 128 + tid] = f2bf(hst); }
        }
    }
    if (sq.ctx && tid < 128) p.out[OUT_LRU + (((size_t)sq.b * 2 + l) * 2 + dir) * 1024 + nb * 128 + tid] = hst;
    __syncthreads();
}

__device__ __forceinline__ int queue_pop(unsigned* ctr, volatile LAS unsigned* slot) {
    __syncthreads();
    if (threadIdx.x == 0) *slot = __hip_atomic_fetch_add(ctr, 1u, __ATOMIC_RELAXED, __HIP_MEMORY_SCOPE_AGENT);
    __syncthreads();
    return (int)*slot;
}
__device__ __forceinline__ void phase_scan(const Params& p, int l, int g, LAS unsigned char* lds) {
    unsigned* ctl = (unsigned*)(p.ws + WS_CTL);
    unsigned* q0 = ctl + CW_Q + 64 * ((l * 2 + g) * 3);
    volatile LAS unsigned* slot = (volatile LAS unsigned*)(lds + LDS_MISC + 64);
    const int ns = nseq_of(g);
#if DBG_STATIC_Q
    for (int it = blockIdx.x; it < ns * 32; it += gridDim.x) { __syncthreads();
        const Seq sq = seq_of(g, seq_index(g, it >> 5)); const int sub = it & 31; mlstm_item(p, l, sq, sub >> 3, (sub >> 2) & 1, sub & 3, lds); }
    for (int it = blockIdx.x; it < ns * 32; it += gridDim.x) { __syncthreads();
        const Seq sq = seq_of(g, seq_index(g, it >> 5)); const int sub = it & 31; gla_item(p, l, sq, sub >> 3, (sub >> 2) & 1, sub & 3, lds); }
    for (int it = blockIdx.x; it < ns * 16; it += gridDim.x) { __syncthreads();
        const Seq sq = seq_of(g, seq_index(g, it >> 4)); const int sub = it & 15; lru_item(p, l, sq, sub >> 3, sub & 7, lds); }
#else
    for (;;) { const int it = queue_pop(q0, slot); if (it >= ns * 32) break;
        const Seq sq = seq_of(g, seq_index(g, it >> 5)); const int sub = it & 31; mlstm_item(p, l, sq, sub >> 3, (sub >> 2) & 1, sub & 3, lds); }
    for (;;) { const int it = queue_pop(q0 + 64, slot); if (it >= ns * 32) break;
        const Seq sq = seq_of(g, seq_index(g, it >> 5)); const int sub = it & 31; gla_item(p, l, sq, sub >> 3, (sub >> 2) & 1, sub & 3, lds); }
    for (;;) { const int it = queue_pop(q0 + 128, slot); if (it >= ns * 16) break;
        const Seq sq = seq_of(g, seq_index(g, it >> 4)); const int sub = it & 15; lru_item(p, l, sq, sub >> 3, sub & 7, lds); }
#endif
}

__device__ __forceinline__ void phase_combine(const Params& p, int l) {
    const int tid_ = tidx(); const int lane = tid_ & 63, wave = tid_ >> 6;
    const int gw = blockIdx.x * 8 + wave, NGW = gridDim.x * 8;
    const bf16_t* Z = (const bf16_t*)(p.ws + WS_Z);
    for (int tl = gw; tl < TG; tl += NGW) {
#pragma unroll
        for (int mx = 0; mx < 2; ++mx) {
            bf16_t* o0 = o_buf(p, 0, mx) + (size_t)tl * 1024; const bf16_t* o1 = o_buf(p, 1, mx) + (size_t)tl * 1024;
            const float* gain = p.in[mx ? I_MNG : I_GNG] + l * 1024;
            const bf16_t* gz = Z + (size_t)tl * ZLD + (mx ? ZC_OB : ZC_GA);
#pragma unroll
            for (int hh = 0; hh < 4; ++hh) { const int c = hh * 256 + lane * 4;
                const u32x2 a = *(const u32x2*)(o0 + c), b = *(const u32x2*)(o1 + c), gq = *(const u32x2*)(gz + c);
                f32x4 v; v[0] = __uint_as_float(a.x << 16) + __uint_as_float(b.x << 16); v[1] = __uint_as_float(a.x & 0xffff0000u) + __uint_as_float(b.x & 0xffff0000u);
                v[2] = __uint_as_float(a.y << 16) + __uint_as_float(b.y << 16); v[3] = __uint_as_float(a.y & 0xffff0000u) + __uint_as_float(b.y & 0xffff0000u);
                const float ss = wave_sum((v[0] * v[0] + v[1] * v[1]) + (v[2] * v[2] + v[3] * v[3]));
                const float rstd = rsqrtf(ss * (1.f / 256.f) + EPS);
                const f32x4 gn = *(const f32x4*)(gain + c);
                f32x4 gt; gt[0] = __uint_as_float(gq.x << 16); gt[1] = __uint_as_float(gq.x & 0xffff0000u); gt[2] = __uint_as_float(gq.y << 16); gt[3] = __uint_as_float(gq.y & 0xffff0000u);
                f32x4 o;
#pragma unroll
                for (int e = 0; e < 4; ++e) o[e] = v[e] * rstd * gn[e] * (mx ? sigmoid_f(gt[e]) : silu_f(gt[e]));
                u32x2 wv; wv.x = cvt_pk_bf16(o[0], o[1]); wv.y = cvt_pk_bf16(o[2], o[3]); *(u32x2*)(o0 + c) = wv; }
        }
        {
            bf16_t* o0 = o_buf(p, 0, 2) + (size_t)tl * 1024; const bf16_t* o1 = o_buf(p, 1, 2) + (size_t)tl * 1024; const bf16_t* gz = Z + (size_t)tl * ZLD + ZC_YR;
#pragma unroll
            for (int hh = 0; hh < 4; ++hh) { const int c = hh * 256 + lane * 4;
                const u32x2 a = *(const u32x2*)(o0 + c), b = *(const u32x2*)(o1 + c), gq = *(const u32x2*)(gz + c);
                f32x4 v; v[0] = __uint_as_float(a.x << 16) + __uint_as_float(b.x << 16); v[1] = __uint_as_float(a.x & 0xffff0000u) + __uint_as_float(b.x & 0xffff0000u);
                v[2] = __uint_as_float(a.y << 16) + __uint_as_float(b.y << 16); v[3] = __uint_as_float(a.y & 0xffff0000u) + __uint_as_float(b.y & 0xffff0000u);
                f32x4 gt; gt[0] = __uint_as_float(gq.x << 16); gt[1] = __uint_as_float(gq.x & 0xffff0000u); gt[2] = __uint_as_float(gq.y << 16); gt[3] = __uint_as_float(gq.y & 0xffff0000u);
                f32x4 o;
#pragma unroll
                for (int e = 0; e < 4; ++e) o[e] = v[e] * gelu_tanh_f(gt[e]);
                u32x2 wv; wv.x = cvt_pk_bf16(o[0], o[1]); wv.y = cvt_pk_bf16(o[2], o[3]); *(u32x2*)(o0 + c) = wv; }
        }
    }
}

__device__ __forceinline__ void phase_convact(const Params& p, int l, int g) {
    const int tid_ = tidx(); const int lane = tid_ & 63, wave = tid_ >> 6;
    const int gw = blockIdx.x * 8 + wave, NGW = gridDim.x * 8;
    const bf16_t* H = (const bf16_t*)(p.ws + WS_Z); bf16_t* ACT = (bf16_t*)(p.ws + WS_O);
    const float* cwp = p.in[I_FCW] + (size_t)l * 9 * DFF; const float* cbp = p.in[I_FCB] + (size_t)l * DFF;
    for (int u = gw; u < (TG / 64) * 11; u += NGW) {
        const int cc = u % 11, trow = u / 11, f0 = cc * 512 + lane * 8;
        const int tl0 = trow * 64, t0 = g * TG + tl0;
        const bool ctx = t0 < NCTX;
        float wgt[9][8], bias[8];
#pragma unroll
        for (int k = 0; k < 9; ++k) { const f32x4 a = *(const f32x4*)(cwp + (size_t)k * DFF + f0), b = *(const f32x4*)(cwp + (size_t)k * DFF + f0 + 4);
#pragma unroll
            for (int e = 0; e < 4; ++e) { wgt[k][e] = a[e]; wgt[k][4 + e] = b[e]; } }
        { const f32x4 a = *(const f32x4*)(cbp + f0), b = *(const f32x4*)(cbp + f0 + 4);
#pragma unroll
            for (int e = 0; e < 4; ++e) { bias[e] = a[e]; bias[4 + e] = b[e]; } }
        int seq_l0, pos0, len;
        if (ctx) { seq_l0 = (tl0 >> 8) << 8; pos0 = tl0 & 255; len = 256; }
        else { const int lt = t0 - NCTX; const int sl = (lt >> 12) << 12; seq_l0 = sl + NCTX - g * TG; pos0 = lt & 4095; len = 4096; }
        for (int x = 0; x < 64; ++x) {
            const int pos = pos0 + x;
            float acc[8];
#pragma unroll
            for (int e = 0; e < 8; ++e) acc[e] = bias[e];
#pragma unroll
            for (int dy = 0; dy < 3; ++dy) {
                if (ctx && dy != 1) continue;
#pragma unroll
                for (int dx = 0; dx < 3; ++dx) {
                    bool ok; int np;
                    if (ctx) { np = pos + dx - 1; ok = np >= 0 && np < len; }
                    else { const int ry = (pos >> 6) + dy - 1, cx = (pos & 63) + dx - 1; ok = ry >= 0 && ry < 64 && cx >= 0 && cx < 64; np = ry * 64 + cx; }
                    if (ok) { const u32x4 hv = *(const u32x4*)(H + (size_t)(seq_l0 + np) * NUP + f0); const int k = dy * 3 + dx;
                        acc[0] += wgt[k][0] * __uint_as_float(hv.x << 16); acc[1] += wgt[k][1] * __uint_as_float(hv.x & 0xffff0000u);
                        acc[2] += wgt[k][2] * __uint_as_float(hv.y << 16); acc[3] += wgt[k][3] * __uint_as_float(hv.y & 0xffff0000u);
                        acc[4] += wgt[k][4] * __uint_as_float(hv.z << 16); acc[5] += wgt[k][5] * __uint_as_float(hv.z & 0xffff0000u);
                        acc[6] += wgt[k][6] * __uint_as_float(hv.w << 16); acc[7] += wgt[k][7] * __uint_as_float(hv.w & 0xffff0000u); }
                }
            }
            const u32x4 uv = *(const u32x4*)(H + (size_t)(tl0 + x) * NUP + DFF + f0);
            float hu[8]; hu[0] = __uint_as_float(uv.x << 16); hu[1] = __uint_as_float(uv.x & 0xffff0000u); hu[2] = __uint_as_float(uv.y << 16); hu[3] = __uint_as_float(uv.y & 0xffff0000u);
            hu[4] = __uint_as_float(uv.z << 16); hu[5] = __uint_as_float(uv.z & 0xffff0000u); hu[6] = __uint_as_float(uv.w << 16); hu[7] = __uint_as_float(uv.w & 0xffff0000u);
            float o[8];
#pragma unroll
            for (int e = 0; e < 8; ++e) o[e] = silu_f(acc[e]) * hu[e];
            u32x4 wv; wv.x = cvt_pk_bf16(o[0], o[1]); wv.y = cvt_pk_bf16(o[2], o[3]); wv.z = cvt_pk_bf16(o[4], o[5]); wv.w = cvt_pk_bf16(o[6], o[7]);
            *(u32x4*)(ACT + (size_t)(tl0 + x) * DFF + f0) = wv;
        }
    }
}


#ifndef DBG_NPH
#define DBG_NPH 44
#endif
#ifndef DBG_WHICH
#define DBG_WHICH 2
#endif
__device__ __forceinline__ void phase_dump(const Params& p, int which) {
    const size_t gid = (size_t)blockIdx.x * NTHREADS + threadIdx.x, gsz = (size_t)gridDim.x * NTHREADS;
    if (which == 1) { const bf16_t* Z = (const bf16_t*)(p.ws + WS_Z); for (size_t i = gid; i < (size_t)TG * 4096; i += gsz) p.out[i] = bf2f(Z[(i >> 12) * ZLD + (i & 4095)]); }
    if (which == 2) { const bf16_t* O = (const bf16_t*)(p.ws + WS_O); for (size_t i = gid; i < (size_t)6 * 13632 * 1024; i += gsz) { const size_t b = i / ((size_t)13632 * 1024), r = i % ((size_t)13632 * 1024); const float v = bf2f(O[b * TG * 1024 + r]); p.out[i] = (v - v == 0.f) ? v : 12345.f; }
        for (size_t i = OUT_GLA + gid; i < OUT_END; i += gsz) { const float v = p.out[i]; if (!(v - v == 0.f)) p.out[i] = 777.f; } }
    if (which == 3) { const bf16_t* U = (const bf16_t*)(p.ws + WS_U); for (size_t i = gid; i < (size_t)TG * 2048; i += gsz) p.out[i] = bf2f(U[i]); }
    if (which == 4) { const float* SMp = (const float*)(p.ws + WS_SM); for (size_t i = gid; i < (size_t)TG * 48; i += gsz) p.out[i] = SMp[(i / 48) * 64 + (i % 48)]; }
}

#ifndef DBG_CHECKS
#define DBG_CHECKS 1
#endif
#if DBG_CHECKS
constexpr int CW_DBG = 32768;
__device__ __forceinline__ void dbg_report(unsigned* ctl, int k, float e) { if (!(e - e == 0.f)) e = 700.f; else if (e > 500.f) e = 500.f; atomicMax(ctl + CW_DBG + 64 * k, __float_as_uint(e)); }
__device__ __forceinline__ void dbg_slot(unsigned* ctl, int s_, float e) { if (!(e - e == 0.f)) e = 94.9f; else if (e > 90.f) e = 90.f; atomicMax(ctl + CW_DBG + 64 * (8 + s_), __float_as_uint(e)); }
__device__ __forceinline__ void dbg_rms(unsigned* ctl, int cat, float diff, float ref) { if (!(diff - diff == 0.f)) { atomicAdd(ctl + CW_DBG + 64 * 25, 1u); return; } atomicAdd((float*)(ctl + CW_DBG + 64 * (30 + 2 * cat)), diff * diff); atomicAdd((float*)(ctl + CW_DBG + 64 * (31 + 2 * cat)), ref * ref); }
__global__ void chk_mod(Params p, int l) {
    unsigned* ctl = (unsigned*)(p.ws + WS_CTL); const float* mod = (const float*)(p.ws + WS_MOD);
    for (int idx = blockIdx.x * blockDim.x + threadIdx.x; idx < 9 * 2458; idx += gridDim.x * blockDim.x) { const int r = idx / 2458, j = (idx % 2458) * 5;
        float s = 0.f; for (int k = 0; k < 2048; ++k) { const float c = r < 8 ? p.in[I_C][r * 2048 + k] : p.in[I_CCTX][k]; s += silu_f(c) * p.in[I_WMOD][((size_t)l * 2048 + k) * 12288 + j]; }
        s += p.in[I_BMOD][l * 12288 + j];
        dbg_report(ctl, 5, fabsf(s - mod[((size_t)l * 9 + r) * 12288 + j]) / (2e-3f * (fabsf(s) + 0.1f))); }
}
__global__ void chk_norm(Params p, int l, int g) {
    unsigned* ctl = (unsigned*)(p.ws + WS_CTL); const float* mod_l = (const float*)(p.ws + WS_MOD) + (size_t)l * 9 * 12288; const bf16_t* U = (const bf16_t*)(p.ws + WS_U);
    __shared__ float red[256];
    for (int sidx = blockIdx.x; sidx < 160; sidx += gridDim.x) { const int tl = sidx * 127 + 5, t = g * TG + tl;
        const float* xr = t < NCTX ? p.in[I_XP] + (size_t)t * D : p.in[I_XS] + (size_t)(t - NCTX) * D;
        float s = 0.f; for (int j = threadIdx.x; j < D; j += 256) s += xr[j] * xr[j];
        red[threadIdx.x] = s; __syncthreads(); for (int o = 128; o > 0; o >>= 1) { if ((int)threadIdx.x < o) red[threadIdx.x] += red[threadIdx.x + o]; __syncthreads(); }
        const float rstd = 1.f / sqrtf(red[0] / D + EPS); __syncthreads();
        const int cond = t < NCTX ? 8 : (t - NCTX) >> 12; const float* sh = mod_l + (size_t)cond * 12288; const float* sc = sh + D;
        for (int j = threadIdx.x; j < D; j += 256) { const float ref = xr[j] * rstd * p.in[I_N1G][l * D + j] * (1.f + sc[j]) + sh[j];
            dbg_report(ctl, 4, fabsf(ref - bf2f(U[(size_t)tl * D + j])) / (0.01f * (fabsf(ref) + 0.1f))); } }
}
__global__ void chk_z(Params p, int l) {
    unsigned* ctl = (unsigned*)(p.ws + WS_CTL); const bf16_t* U = (const bf16_t*)(p.ws + WS_U); const bf16_t* Z = (const bf16_t*)(p.ws + WS_Z); const float* SM = (const float*)(p.ws + WS_SM);
    __shared__ float us[2048];
    for (int sidx = blockIdx.x; sidx < 96; sidx += gridDim.x) { const int tl = sidx * 211 + 3;
        for (int j = threadIdx.x; j < D; j += 256) us[j] = bf2f(U[(size_t)tl * D + j]); __syncthreads();
        for (int d = threadIdx.x; d < 15408; d += 256) { int sc_; if (d < 3072) sc_ = d; else if (d < 7168) sc_ = d + 32; else if (d < 15360) sc_ = d + 48; else if (d < 15392) sc_ = d - 15360 + 3072; else sc_ = d - 15392 + 7200;
            float s = 0.f; for (int k = 0; k < D; ++k) s += us[k] * p.in[I_WIN][((size_t)l * D + k) * 15408 + sc_];
            if (d < 512) s *= 0.08838834764831845f; else if (d >= ZC_KB && d < ZC_KB + 1024) s *= 0.0625f;
            float got; if (d >= ZC_MG && d < 15360) s = sigmoid_f(s + p.in[I_BMG][l * 3 * D + d - ZC_MG]);
            if (d < 15360) got = bf2f(Z[(size_t)tl * ZLD + d]); else got = SM[(size_t)tl * 64 + d - 15360];
            dbg_report(ctl, 3, fabsf(s - got) / (0.02f * (fabsf(s) + 0.5f))); }
        __syncthreads(); }
}
__global__ void chk_gla(Params p, int l, int g) {
    unsigned* ctl = (unsigned*)(p.ws + WS_CTL); const bf16_t* Z = (const bf16_t*)(p.ws + WS_Z); const float* SM = (const float*)(p.ws + WS_SM);
    __shared__ float S[128 * 64]; __shared__ float al[128], qv[128], kv[128], vv[64], ra[16];
    const int tid = threadIdx.x;
    for (int ch = blockIdx.x; ch < 24 * 4; ch += gridDim.x) { const int slice = ch & 3, c3 = ch >> 2, dir = c3 & 1, h = (c3 >> 1) & 3, si = c3 >> 3;
        const int s_id = g == 0 ? (si == 0 ? 1 : si == 1 ? 30 : 32) : si * 2; const Seq sq = seq_of(g, s_id);
        const float* s0 = p.in[I_SGLA] + ((((size_t)sq.b * 2 + l) * 2 + dir) * 4 + h) * 128 * 256;
        for (int i = tid; i < 128 * 64; i += 512) S[i] = sq.ctx ? 0.f : s0[(size_t)(i >> 6) * 256 + slice * 64 + (i & 63)];
        __syncthreads();
        const bf16_t* O = o_buf(p, dir, 0);
        const int nsteps = sq.len < 1024 ? sq.len : 1024;
        for (int st = 0; st < nsteps; ++st) { const int tl = sq.tl0 + (dir ? sq.len - 1 - st : st);
            if (tid < 16) ra[tid] = SM[(size_t)tl * 64 + dir * 16 + tid];
            if (tid < 128) { qv[tid] = bf2f(Z[(size_t)tl * ZLD + ZC_QA + h * 128 + tid]); kv[tid] = bf2f(Z[(size_t)tl * ZLD + ZC_KA + h * 128 + tid]); }
            if (tid >= 128 && tid < 192) vv[tid - 128] = bf2f(Z[(size_t)tl * ZLD + ZC_VA + h * 256 + slice * 64 + tid - 128]);
            __syncthreads();
            if (tid < 128) { float pre = p.in[I_GBA][(l * 2 + dir) * 512 + h * 128 + tid]; for (int j = 0; j < 16; ++j) pre += ra[j] * p.in[I_GWA][((size_t)(l * 2 + dir) * 16 + j) * 512 + h * 128 + tid]; al[tid] = __expf(logsigmoid_f(pre) * 0.0625f); }
            __syncthreads();
            for (int i = tid; i < 128 * 64; i += 512) { const int dd = i >> 6, cc = i & 63; S[i] = al[dd] * S[i] + kv[dd] * vv[cc]; }
            __syncthreads();
            if (tid < 64) { float o = 0.f; for (int dd = 0; dd < 128; ++dd) o += qv[dd] * S[dd * 64 + tid];
                const float e = fabsf(o - bf2f(O[(size_t)tl * 1024 + h * 256 + slice * 64 + tid])) / (0.03f * (fabsf(o) + 0.3f));
                dbg_report(ctl, 2, e); dbg_slot(ctl, 6, e);
                dbg_rms(ctl, (sq.ctx ? 0 : 2) + dir, o - bf2f(O[(size_t)tl * 1024 + h * 256 + slice * 64 + tid]), o); }
            __syncthreads(); }
        if (sq.ctx) { const float* so = p.out + OUT_GLA + ((((size_t)sq.b * 2 + l) * 2 + dir) * 4 + h) * 128 * 256;
            for (int i = tid; i < 128 * 64; i += 512) { const float e = fabsf(S[i] - so[(size_t)(i >> 6) * 256 + slice * 64 + (i & 63)]) / (0.03f * (fabsf(S[i]) + 0.3f)); dbg_report(ctl, 2, e); dbg_rms(ctl, 4, S[i] - so[(size_t)(i >> 6) * 256 + slice * 64 + (i & 63)], S[i]); } }
        __syncthreads(); }
}
__global__ void chk_mlstm(Params p, int l, int g) {
    unsigned* ctl = (unsigned*)(p.ws + WS_CTL); const bf16_t* Z = (const bf16_t*)(p.ws + WS_Z); const float* SM = (const float*)(p.ws + WS_SM);
    __shared__ float C[256 * 32]; __shared__ float nn[256], qv[256], kv[256], vv[32], red[512]; __shared__ float sc[4];
    const int tid = threadIdx.x;
    for (int ch = blockIdx.x; ch < 24 * 2; ch += gridDim.x) { const int sl = (ch & 1) * 5, c3 = ch >> 1, dir = c3 & 1, h = (c3 >> 1) & 3, si = c3 >> 3;
        const int s_id = g == 0 ? (si == 0 ? 2 : si == 1 ? 29 : 33) : si * 2; const Seq sq = seq_of(g, s_id);
        const size_t sidx = (((size_t)sq.b * 2 + l) * 2 + dir) * 4 + h;
        for (int i = tid; i < 256 * 32; i += 512) C[i] = sq.ctx ? 0.f : p.in[I_SMC][sidx * 65536 + (size_t)(i >> 5) * 256 + sl * 32 + (i & 31)];
        if (tid < 256) nn[tid] = sq.ctx ? 0.f : p.in[I_SMN][sidx * 256 + tid];
        float m = sq.ctx ? 0.f : p.in[I_SMM][sidx];
        __syncthreads();
        const bf16_t* O = o_buf(p, dir, 1);
        const float bi = p.in[I_MBIF][((l * 2 + dir) * 2 + 0) * 4 + h], bfg = p.in[I_MBIF][((l * 2 + dir) * 2 + 1) * 4 + h];
        const int nsteps = sq.len < 1024 ? sq.len : 1024;
        for (int st = 0; st < nsteps; ++st) { const int tl = sq.tl0 + (dir ? sq.len - 1 - st : st);
            if (tid < 256) { qv[tid] = bf2f(Z[(size_t)tl * ZLD + ZC_QB + h * 256 + tid]); kv[tid] = bf2f(Z[(size_t)tl * ZLD + ZC_KB + h * 256 + tid]); }
            if (tid >= 256 && tid < 288) vv[tid - 256] = bf2f(Z[(size_t)tl * ZLD + ZC_VB + h * 256 + sl * 32 + tid - 256]);
            const float gi = SM[(size_t)tl * 64 + 32 + dir * 8 + h] + bi, lf = logsigmoid_f(SM[(size_t)tl * 64 + 32 + dir * 8 + 4 + h] + bfg);
            const float mn = fmaxf(lf + m, gi), fp = __expf(lf + m - mn), ip = __expf(gi - mn); m = mn;
            __syncthreads();
            for (int i = tid; i < 256 * 32; i += 512) { const int dd = i >> 5, cc = i & 31; C[i] = fp * C[i] + ip * kv[dd] * vv[cc]; }
            if (tid < 256) nn[tid] = fp * nn[tid] + ip * kv[tid];
            __syncthreads();
            red[tid] = tid < 256 ? qv[tid] * nn[tid] : 0.f; __syncthreads();
            for (int o = 256; o > 0; o >>= 1) { if (tid < o) red[tid] += red[tid + o]; __syncthreads(); }
            const float den = fmaxf(fabsf(red[0]), __expf(-m));
            if (tid < 32) { float o = 0.f; for (int dd = 0; dd < 256; ++dd) o += qv[dd] * C[dd * 32 + tid]; o /= den;
                const float e = fabsf(o - bf2f(O[(size_t)tl * 1024 + h * 256 + sl * 32 + tid])) / (0.03f * (fabsf(o) + 0.05f));
                dbg_report(ctl, 1, e); dbg_slot(ctl, 6, e);
                dbg_rms(ctl, (sq.ctx ? 0 : 2) + dir, o - bf2f(O[(size_t)tl * 1024 + h * 256 + sl * 32 + tid]), o); }
            __syncthreads(); }
        if (sq.ctx) { for (int i = tid; i < 256 * 32; i += 512) { const float e = fabsf(C[i] - p.out[OUT_MC + sidx * 65536 + (size_t)(i >> 5) * 256 + sl * 32 + (i & 31)]) / (0.03f * (fabsf(C[i]) + 0.05f)); dbg_report(ctl, 1, e); dbg_rms(ctl, 4, C[i] - p.out[OUT_MC + sidx * 65536 + (size_t)(i >> 5) * 256 + sl * 32 + (i & 31)], C[i]); }
            if (tid < 256) dbg_report(ctl, 1, fabsf(nn[tid] - p.out[OUT_MN + sidx * 256 + tid]) / (0.03f * (fabsf(nn[tid]) + 0.05f)));
            if (tid == 0) dbg_report(ctl, 1, fabsf(m - p.out[OUT_MM + sidx]) / 0.02f); }
        __syncthreads(); }
}
__global__ void chk_lru(Params p, int l, int g) {
    unsigned* ctl = (unsigned*)(p.ws + WS_CTL); const bf16_t* Z = (const bf16_t*)(p.ws + WS_Z);
    __shared__ float xc[128];
    const int tid = threadIdx.x;
    for (int ch = blockIdx.x; ch < 3 * 2 * 8; ch += gridDim.x) { const int nb = ch & 7, dir = (ch >> 3) & 1, si = ch >> 4;
        const int s_id = g == 0 ? (si == 0 ? 3 : si == 1 ? 31 : 34) : si * 2; const Seq sq = seq_of(g, s_id);
        const int chn = nb * 128 + tid;
        float hst = sq.ctx ? 0.f : p.in[I_SLRU][(((size_t)sq.b * 2 + l) * 2 + dir) * 1024 + chn];
        const float c8 = 8.f * softplus_f(-p.in[I_LLAM][(size_t)(l * 2 + dir) * 1024 + chn]);
        const bf16_t* O = o_buf(p, dir, 2);
        const int nsteps = sq.len < 1024 ? sq.len : 1024;
        for (int st = 0; st < nsteps; ++st) { const int pos = dir ? sq.len - 1 - st : st;
            float x = p.in[I_LCB][l * 1024 + chn];
            for (int j = 0; j < 4; ++j) { const int pp = pos + j - 2; if (pp >= 0 && pp < sq.len) x += p.in[I_LCW][((size_t)l * 4 + j) * 1024 + chn] * bf2f(Z[(size_t)(sq.tl0 + pp) * ZLD + ZC_XR + chn]); }
            __syncthreads(); xc[tid] = x; __syncthreads();
            float p0 = p.in[I_LGB][((size_t)(l * 2 + dir) * 2 + 0) * 1024 + chn], p1 = p.in[I_LGB][((size_t)(l * 2 + dir) * 2 + 1) * 1024 + chn];
            const float* w0 = p.in[I_LGW] + ((((size_t)l * 2 + dir) * 2 + 0) * 8 + nb) * 16384; const float* w1 = w0 + 8 * 16384;
            for (int k = 0; k < 128; ++k) { p0 += xc[k] * w0[k * 128 + tid]; p1 += xc[k] * w1[k * 128 + tid]; }
            const float la = -c8 * sigmoid_f(p0), a = __expf(la); hst = a * hst + sqrtf(fmaxf(1.f - a * a, 0.f)) * sigmoid_f(p1) * x;
            dbg_report(ctl, 0, fabsf(hst - bf2f(O[(size_t)(sq.tl0 + pos) * 1024 + chn])) / (0.03f * (fabsf(hst) + 0.1f)));
            dbg_rms(ctl, (sq.ctx ? 0 : 2) + dir, hst - bf2f(O[(size_t)(sq.tl0 + pos) * 1024 + chn]), hst); }
        if (sq.ctx) dbg_report(ctl, 0, fabsf(hst - p.out[OUT_LRU + (((size_t)sq.b * 2 + l) * 2 + dir) * 1024 + chn]) / (0.03f * (fabsf(hst) + 0.1f)));
        if (sq.ctx) dbg_rms(ctl, 4, hst - p.out[OUT_LRU + (((size_t)sq.b * 2 + l) * 2 + dir) * 1024 + chn], hst);
        __syncthreads(); }
}

__global__ void chk_gla_lds(Params p, int l) {
    unsigned* ctl = (unsigned*)(p.ws + WS_CTL); const bf16_t* Z = (const bf16_t*)(p.ws + WS_Z); const float* SM = (const float*)(p.ws + WS_SM); const float* dbgp = (const float*)(p.ws + WS_DBG);
    __shared__ float cu[64 * 128]; __shared__ float qi[64 * 128 / 2];
    const int tid = threadIdx.x, h = 0, dir = DBG_DIR, c = DBG_CHUNK; const Seq sq = seq_of(0, 1);
    if (tid < 128) { float run = 0.f; for (int r = 0; r < 64; ++r) { const int tl = sq.tl0 + (dir ? sq.len - 1 - (c * 64 + r) : c * 64 + r);
            float pre = p.in[I_GBA][(l * 2 + dir) * 512 + h * 128 + tid]; for (int j = 0; j < 16; ++j) pre += SM[(size_t)tl * 64 + dir * 16 + j] * p.in[I_GWA][((size_t)(l * 2 + dir) * 16 + j) * 512 + h * 128 + tid];
            run += logsigmoid_f(pre) * 0.0625f; cu[r * 128 + tid] = run; } }
    __syncthreads();
    for (int i = tid; i < 64 * 128; i += blockDim.x) { const int r = i >> 7, d = i & 127; const int tl = sq.tl0 + (dir ? sq.len - 1 - (c * 64 + r) : c * 64 + r);
        const float cv = cu[i], last = cu[63 * 128 + d], q = bf2f(Z[(size_t)tl * ZLD + ZC_QA + h * 128 + d]), k = bf2f(Z[(size_t)tl * ZLD + ZC_KA + h * 128 + d]);
        const float qr = q * __expf(cv), kr = k * __expf(-cv), ker = k * __expf(last - cv);
        dbg_slot(ctl, 2, fabsf(kr - dbgp[16384 + i]) / (0.01f * (fabsf(kr) + 0.05f)));
        dbg_slot(ctl, 3, fabsf(ker - dbgp[24576 + d * 64 + r]) / (0.01f * (fabsf(ker) + 0.05f))); }
    for (int i = tid; i < 64 * 64; i += blockDim.x) { const int cc = i >> 6, r = i & 63; const int tl = sq.tl0 + (dir ? sq.len - 1 - (c * 64 + r) : c * 64 + r);
        const float v = bf2f(Z[(size_t)tl * ZLD + ZC_VA + h * 256 + cc]); dbg_slot(ctl, 4, fabsf(v - dbgp[32768 + i]) / (0.01f * (fabsf(v) + 0.05f))); }
    for (int i = tid; i < 64 * 64; i += blockDim.x) { const int ii = i >> 6, jj = i & 63; float a = 0.f;
        if (jj <= ii) for (int d = 0; d < 128; ++d) a += dbgp[8192 + ii * 128 + d] * dbgp[16384 + jj * 128 + d];
        dbg_slot(ctl, 6, fabsf(a - dbgp[36864 + i]) / (0.02f * (fabsf(a) + 0.1f))); }
    const bf16_t* Og = o_buf(p, dir, 0);
    for (int i = tid; i < 64 * 64; i += blockDim.x) { const int ii = i >> 6, cc = i & 63; float o = 0.f;
        for (int j = 0; j < 64; ++j) o += dbgp[36864 + ii * 64 + j] * dbgp[32768 + cc * 64 + j];
        for (int d = 0; d < 128; ++d) o += dbgp[8192 + ii * 128 + d] * dbgp[40960 + cc * 128 + d];
        const float od = dbgp[49152 + i]; const int tl = sq.tl0 + (dir ? sq.len - 1 - (c * 64 + ii) : c * 64 + ii);
        dbg_slot(ctl, 0, 10.f + fabsf(o - od) / (0.01f * (fabsf(o) + 0.1f)));
        dbg_slot(ctl, 1, 10.f + fabsf(bf2f(Og[(size_t)tl * 1024 + h * 256 + cc]) - od) / (0.01f * (fabsf(od) + 0.1f)));
        if (!(od - od == 0.f)) atomicAdd(ctl + CW_DBG + 64 * 18, 1u); }
    float mx = 0.f; for (int i = tid; i < 64 * 128; i += blockDim.x) mx = fmaxf(mx, fabsf(dbgp[40960 + i]));
    atomicMax(ctl + CW_DBG + 64 * 17, __float_as_uint(mx - mx == 0.f ? mx : 39.9f));
}
__global__ void chk_fin(Params p, int mask) {
    unsigned* ctl = (unsigned*)(p.ws + WS_CTL);
    const size_t offs[8] = {OUT_X, OUT_X + (size_t)NCTX * D, OUT_GLA, OUT_MC, OUT_MN, OUT_MM, OUT_LRU, OUT_END};
    for (int k = 0; k < 7; ++k) {
        int N;
        if (k < 5 && (mask & 7)) { const float a = *(float*)(ctl + CW_DBG + 64 * (30 + 2 * k)), b = *(float*)(ctl + CW_DBG + 64 * (31 + 2 * k)); const float r = b > 0.f ? sqrtf(a / b) : 0.9f; N = 1 + (int)(fminf(r, 0.9f) * 1000.f); }
        else if (k == 5 && (mask & 7)) { N = 1 + (int)ctl[CW_DBG + 64 * 25]; if (N > 400) N = 400; }
        else if (k < 6 && (mask & 6)) { N = 1 + (int)ctl[CW_DBG + 64 * (20 + k)]; if (N > (k == 5 ? 400 : 999)) N = (k == 5 ? 400 : 999); }
        else if (k == 4 && (mask & 64)) { N = 1 + (int)ctl[CW_DBG + 64 * 18]; if (N > 999) N = 999; }
        else if (k == 5 && (mask & 64)) { const float e = __uint_as_float(ctl[CW_DBG + 64 * 17]); N = 1 + (int)(fminf(e, 39.9f) * 10.f); }
        else if (k == 5) { const unsigned v = ctl[CW_DBG + 64 * 16]; N = v == 0u ? 1 : 2 + (int)((100000u - v) >> 6); if (N > 400) N = 400; }
        else { const int s_ = k == 6 ? 6 : k; const float e = __uint_as_float(ctl[CW_DBG + 64 * (8 + s_)]); N = 1 + (int)(e * 10.f); }
        for (size_t i = offs[k] + (size_t)blockIdx.x * blockDim.x + threadIdx.x; i < offs[k + 1]; i += (size_t)gridDim.x * blockDim.x) p.out[i] = (i - offs[k] < (size_t)N) ? __uint_as_float(0xAAAAAAAAu) : 0.f;
    }
}
#endif

#ifndef SKIPMASK
#define SKIPMASK 0
#endif
#define PH_SEL(bit, ...) { if constexpr (!((SKIPMASK >> (bit)) & 1)) { __VA_ARGS__ } }
#define PH_A(...) PH_SEL(0, __VA_ARGS__)
#define PH_B(...) PH_SEL(1, __VA_ARGS__)
#define PH_C(...) PH_SEL(2, __VA_ARGS__)
#define PH_D(...) PH_SEL(3, __VA_ARGS__)
#define PH_E(...) PH_SEL(4, __VA_ARGS__)
#define PH_G1(...) PH_SEL(5, __VA_ARGS__)
#define PH_G2(...) PH_SEL(6, __VA_ARGS__)
#define PH_G3(...) PH_SEL(7, __VA_ARGS__)
#define PH_G4(...) PH_SEL(8, __VA_ARGS__)
#define PH_G5(...) PH_SEL(9, __VA_ARGS__)
constexpr int N_PHASES = 44;
__global__ void __launch_bounds__(NTHREADS, 2) fwd_kernel(Params p) {
    extern __shared__ __attribute__((aligned(16))) unsigned char lds_raw[];
    LAS unsigned char* lds = (LAS unsigned char*)lds_raw;
    const int tid = threadIdx.x;
    volatile LAS unsigned* MISC = (volatile LAS unsigned*)(lds + LDS_MISC);
    if (tid < 32) MISC[tid] = 0u;
    __syncthreads();
    unsigned* ctl = (unsigned*)(p.ws + WS_CTL);
#if MK_PER_PHASE
#define GRID_BAR() do { } while (0)
#else
    XcdBarrier bar = xcd_barrier_post(ctl + CW_BAR, MISC + 8);
#define GRID_BAR() xcd_barrier(bar)
#endif
    const int lo = p.ph_lo, hi = p.ph_hi;
    const int G = gridDim.x, bx = blockIdx.x;
    const int vcu = (G % 8 == 0) ? (bx % 8) * (G / 8) + bx / 8 : bx;
#define IN(k) (lo <= (k) && (k) < hi)
#define SEAM(k) do { if (IN(k) && IN((k) + 1)) GRID_BAR(); } while (0)

    if (IN(0)) { if (bx == 0 && tid < 12) ctl[CW_Q + 64 * tid] = 0u;
        PH_A(phase_mod(p, lds); __syncthreads(); phase_wconv(p, 0, lds);) }
    SEAM(0);
    for (int l = 0; l < 2; ++l) {
        const int base = 1 + 21 * l;
        if (IN(base)) { PH_A(if (l > 0) phase_wconv(p, l, lds);) }
        SEAM(base);
        const float* mod_l = (const float*)(p.ws + WS_MOD) + (size_t)l * 9 * 12288;
        for (int g = 0; g < 2; ++g) {
            const int pb = base + 1 + 10 * g;
            if (IN(pb + 0)) { PH_B(phase_norm(p, l, g, 0, l == 0);) }
            SEAM(pb + 0);
            if (IN(pb + 1)) {
                pg8::Gemm gm{(const bf16_t*)(p.ws + WS_U), (const bf16_t*)(p.ws + W_IN), TG, NZ, D}; pg8::StaticOrder S; S.init(TG, NZ, G, bx);
                pg8::EpiZ E{(bf16_t*)(p.ws + WS_Z), (float*)(p.ws + WS_SM), p.in[I_BMG] + (size_t)l * 3 * D};
                PH_G1(pg8::gemm_phase<pg8::EpiZ, pg8::StaticOrder, true, true>(lds, gm, S, E);)
            }
            SEAM(pb + 1);
            if (IN(pb + 2)) { PH_C(phase_scan(p, l, g, lds);) }
            SEAM(pb + 2);
            if (IN(pb + 3)) { PH_D(phase_combine(p, l);) }
            SEAM(pb + 3);
            if (IN(pb + 4)) {
                pg8::Gemm gm{o_buf(p, 0, 0), (const bf16_t*)(p.ws + W_BR), 3 * TG, 3 * D, 1024}; pg8::BranchOrder S{G, vcu};
                pg8::EpiBranch E{(const bf16_t*)(p.ws + WS_Z), (float*)(p.ws + WS_SLAB) + (size_t)bx * 65536, (bf16_t*)(p.ws + WS_U)};
                PH_G2(pg8::gemm_phase<pg8::EpiBranch, pg8::BranchOrder, true, true>(lds, gm, S, E);)
            }
            SEAM(pb + 4);
            if (IN(pb + 5)) {
                pg8::Gemm gm{(const bf16_t*)(p.ws + WS_U), (const bf16_t*)(p.ws + W_OUT), TG, D, D}; pg8::StaticOrder S; S.init(TG, D, G, bx);
                const float* xc = l == 0 ? p.in[I_XP] : p.out + OUT_X; const float* xl = l == 0 ? p.in[I_XS] - (size_t)NCTX * D : p.out + OUT_X;
                pg8::EpiResid E{xc, xl, p.out + OUT_X, mod_l, 2, g * TG};
                PH_G3(pg8::gemm_phase<pg8::EpiResid, pg8::StaticOrder, true, true>(lds, gm, S, E);)
            }
            SEAM(pb + 5);
            if (IN(pb + 6)) { PH_B(phase_norm(p, l, g, 1, false);) }
            SEAM(pb + 6);
            if (IN(pb + 7)) {
                pg8::Gemm gm{(const bf16_t*)(p.ws + WS_U), (const bf16_t*)(p.ws + W_UP), TG, NUP, D}; pg8::StaticOrder S; S.init(TG, NUP, G, bx);
                pg8::EpiBf16 E{(bf16_t*)(p.ws + WS_Z), NUP};
                PH_G4(pg8::gemm_phase<pg8::EpiBf16, pg8::StaticOrder, true, true>(lds, gm, S, E);)
            }
            SEAM(pb + 7);
            if (IN(pb + 8)) { PH_E(phase_convact(p, l, g);) }
            SEAM(pb + 8);
            if (IN(pb + 9)) {
                pg8::Gemm gm{(const bf16_t*)(p.ws + WS_O), (const bf16_t*)(p.ws + W_DOWN), TG, D, DFF}; pg8::StaticOrder S; S.init(TG, D, G, bx);
                pg8::EpiResid E{p.out + OUT_X, p.out + OUT_X, p.out + OUT_X, mod_l, 5, g * TG};
                PH_G5(pg8::gemm_phase<pg8::EpiResid, pg8::StaticOrder, true, true>(lds, gm, S, E);)
            }
            SEAM(pb + 9);
        }
    }
    if (IN(43)) { PH_B(phase_final_norm(p);) }
    if (lo >= 100) phase_dump(p, lo - 100);
#undef IN
#undef SEAM
}

extern "C" void kernel_launch(void* const* d_in, const int* in_sizes, int n_in, void* d_out, int out_size, void* d_ws, size_t ws_size, hipStream_t stream) {
    static int grid = 0;
    if (grid == 0) {
        if (ws_size < WS_DBG + MiB) { fprintf(stderr, "kernel_launch: unexpected shapes (n_in %d out %d ws %zu)\n", n_in, out_size, ws_size); grid = -1; return; }
        int dev = 0, cus = 0;
        if (hipGetDevice(&dev) != hipSuccess || hipDeviceGetAttribute(&cus, hipDeviceAttributeMultiprocessorCount, dev) != hipSuccess) { grid = -1; return; }
        if (hipFuncSetAttribute((const void*)fwd_kernel, hipFuncAttributeMaxDynamicSharedMemorySize, LDS_BYTES) != hipSuccess) { fprintf(stderr, "kernel_launch: hipFuncSetAttribute failed\n"); grid = -1; return; }
        int per_cu = 0;
        if (hipOccupancyMaxActiveBlocksPerMultiprocessor(&per_cu, (const void*)fwd_kernel, NTHREADS, LDS_BYTES) != hipSuccess || per_cu < 1) { fprintf(stderr, "kernel_launch: occupancy query says %d\n", per_cu); (void)hipGetLastError(); grid = -1; return; }
        grid = cus;
    }
    if (grid < 0) return;
    (void)hipMemsetAsync((char*)d_ws + WS_CTL, 0, CTL_BYTES, stream);
    Params p{};
    for (int i = 0; i < 32; ++i) p.in[i] = (const float*)d_in[i];
    p.out = (float*)d_out; p.ws = (unsigned char*)d_ws;
#if MK_PER_PHASE
    for (int ph = 0; ph < DBG_NPH; ++ph) { if (ph == 1) continue; p.ph_lo = ph; p.ph_hi = ph + 1; hipLaunchKernelGGL(fwd_kernel, dim3(grid), dim3(NTHREADS), LDS_BYTES, stream, p); }
#if DBG_CHECKS
    { const int mask = DBG_MASK;
      if (mask & 32) hipLaunchKernelGGL(chk_mod, dim3(87), dim3(256), 0, stream, p, 0);
      if (mask & 16) hipLaunchKernelGGL(chk_norm, dim3(160), dim3(256), 0, stream, p, 0, 0);
      if (mask & 8) hipLaunchKernelGGL(chk_z, dim3(96), dim3(256), 0, stream, p, 0);
      if (mask & 4) hipLaunchKernelGGL(chk_gla, dim3(96), dim3(512), 0, stream, p, 0, 0);
      if (mask & 64) hipLaunchKernelGGL(chk_gla_lds, dim3(1), dim3(512), 0, stream, p, 0);
      if (mask & 2) hipLaunchKernelGGL(chk_mlstm, dim3(48), dim3(512), 0, stream, p, 0, 0);
      if (mask & 1) hipLaunchKernelGGL(chk_lru, dim3(48), dim3(128), 0, stream, p, 0, 0);
      hipLaunchKernelGGL(chk_fin, dim3(1024), dim3(256), 0, stream, p, mask); }
#endif
#else
    p.ph_lo = 0; p.ph_hi = N_PHASES;
    hipLaunchKernelGGL(fwd_kernel, dim3(grid), dim3(NTHREADS), LDS_BYTES, stream, p);
#endif
}
```

```cpp
#include <hip/hip_runtime.h>
#include <cstdio>
#include <cstdint>

#ifndef MK_PER_PHASE
#define MK_PER_PHASE 0
#endif

#ifndef DBG_DIR
#define DBG_DIR 0
#endif
#ifndef DBG_CHUNK
#define DBG_CHUNK 0
#endif
#ifndef DBG_CHECKS
#define DBG_CHECKS 0
#endif
#ifndef DBG_TIMING
#define DBG_TIMING 0
#endif
#ifndef DBG_TUNIT
#define DBG_TUNIT 10000u
#endif
#ifndef DBG_MASK
#define DBG_MASK 1
#endif
#ifndef DBG_STATIC_Q
#define DBG_STATIC_Q 0
#endif
#define LAS __attribute__((address_space(3)))
typedef unsigned short bf16_t;
typedef short bf16x8 __attribute__((ext_vector_type(8)));
typedef float f32x4 __attribute__((ext_vector_type(4)));
typedef float f32x2 __attribute__((ext_vector_type(2)));
typedef unsigned u32x4 __attribute__((ext_vector_type(4)));
typedef unsigned u32x2 __attribute__((ext_vector_type(2)));

constexpr int D = 2048, NCTX = 8192, NTOK = 40960, TMAX = 24576;
__host__ __device__ __forceinline__ int tg_of(int g) { return g == 0 ? 24576 : 16384; }
__host__ __device__ __forceinline__ int gctx_of(int g) { return g == 0 ? NCTX : 0; }
__host__ __device__ __forceinline__ int glob_tok(int g, int tl) { return g * TMAX + tl; }
__host__ __device__ __forceinline__ size_t zoff(int t, int c) { return ((size_t)((c >> 8) * TMAX + t) << 8) + (size_t)(c & 255); }
__host__ __device__ __forceinline__ size_t xfin_off(int t);
__host__ __device__ __forceinline__ size_t goff8(int t, int c) { return (size_t)(c >> 8) * TMAX * 512 + ((size_t)t << 8) + (size_t)(c & 255); }
constexpr int ZLD = 11264, NZ1 = 9472, NZ = 15616, DFF = 5632, NUP = 11264;
constexpr int NTHREADS = 512;
constexpr float EPS = 1e-6f;

constexpr size_t MiB = 1u << 20;
constexpr size_t WS_CTL = 0, CTL_BYTES = 1 * MiB;
constexpr size_t WS_MOD = 1 * MiB;
constexpr size_t WS_W = 2 * MiB;
constexpr size_t W_IN = WS_W;
constexpr size_t W_BR = W_IN + (size_t)NZ * D * 2;
constexpr size_t W_OUT = W_BR + (size_t)3 * D * 1024 * 2;
constexpr size_t W_UP = W_OUT + (size_t)D * D * 2;
constexpr size_t W_DOWN = W_UP + (size_t)NUP * D * 2;
constexpr size_t W_LRU = W_DOWN + (size_t)D * DFF * 2;
constexpr size_t W_END = W_LRU + (size_t)32 * 128 * 128 * 2;
static_assert(W_END == 150 * MiB, "weight block");
constexpr size_t WS_U = 150 * MiB;
constexpr size_t WS_SM = 246 * MiB;
constexpr size_t WS_Z = 252 * MiB;
constexpr size_t WS_O = 780 * MiB;
constexpr size_t WS_SLAB = WS_O + 144 * MiB;
constexpr size_t WS_U8 = 1068 * MiB;
constexpr size_t WS_WMG8 = 1116 * MiB;
constexpr size_t WS_END = 1128 * MiB;
__host__ __device__ __forceinline__ size_t xfin_off(int t) {
    return t < TMAX ? WS_Z + ((((size_t)(t >> 10) * TMAX + 16384) << 9) + ((size_t)(t & 1023) << 12)) : WS_U + ((size_t)(t - TMAX) << 12);
}
constexpr size_t WS_DBG = 1076 * MiB;
constexpr int CW_BAR = 4096;
constexpr int CW_DBG = 32768;
constexpr int CW_Q = 16384;

constexpr int ZC_QA = 0, ZC_KA = 512, ZC_VA = 1024, ZC_QB = 2048, ZC_KB = 3072, ZC_VB = 4096, ZC_XR = 5120, ZC_GA = 6144, ZC_OB = 7168, ZC_YR = 8192;

constexpr int LDS_BYTES = 155648;
constexpr int LDS_MISC = 153600;

struct Params {
    const float* in[32];
    float* out;
    unsigned char* ws;
    int ph_lo, ph_hi;
};

__device__ __forceinline__ float bf2f(unsigned short h) { return __uint_as_float(((unsigned)h) << 16); }
__device__ __forceinline__ unsigned short f2bf(float f) { return __builtin_bit_cast(unsigned short, (__bf16)f); }
typedef __bf16 bf16x2_t __attribute__((ext_vector_type(2)));
__device__ __forceinline__ unsigned cvt_pk_bf16(float lo, float hi) { const f32x2 f = {lo, hi}; const bf16x2_t v = __builtin_convertvector(f, bf16x2_t); return __builtin_bit_cast(unsigned, v); }
__device__ __forceinline__ float sigmoid_f(float x) { return __builtin_amdgcn_rcpf(1.f + __expf(-x)); }
__device__ __forceinline__ float silu_f(float x) { return x * sigmoid_f(x); }
__device__ __forceinline__ float logsigmoid_f(float x) { return fminf(x, 0.f) - log1pf(__expf(-fabsf(x))); }
__device__ __forceinline__ float logsigmoid_fast(float x) { return fminf(x, 0.f) - __logf(1.f + __expf(-fabsf(x))); }
__device__ __forceinline__ float softplus_f(float x) { return fmaxf(x, 0.f) + log1pf(__expf(-fabsf(x))); }
__device__ __forceinline__ float gelu_tanh_f(float x) { const float u = 0.7978845608028654f * (x + 0.044715f * x * x * x); const float t = 1.f - 2.f * __builtin_amdgcn_rcpf(1.f + __expf(2.f * u)); return 0.5f * x * (1.f + t); }
__device__ __forceinline__ float wave_sum(float v) {
#pragma unroll
    for (int o = 1; o < 64; o <<= 1) v += __shfl_xor(v, o);
    return v;
}
__device__ __forceinline__ int tidx() { int t = threadIdx.x; asm volatile("" : "+v"(t)); return t; }
#define DPP_F(old_, src_, ctrl_, rmask_) __uint_as_float((unsigned)__builtin_amdgcn_update_dpp((int)__float_as_uint(old_), (int)__float_as_uint(src_), ctrl_, rmask_, 0xf, false))
__device__ __forceinline__ float wave_scan_add(float v) {
    v += DPP_F(0.f, v, 0x111, 0xf); v += DPP_F(0.f, v, 0x112, 0xf); v += DPP_F(0.f, v, 0x114, 0xf); v += DPP_F(0.f, v, 0x118, 0xf);
    v += DPP_F(0.f, v, 0x142, 0xa); v += DPP_F(0.f, v, 0x143, 0xc);
    return v;
}
__device__ __forceinline__ float wave_scan_max(float v) {
    const float ninf = -__builtin_inff();
    v = fmaxf(v, DPP_F(ninf, v, 0x111, 0xf)); v = fmaxf(v, DPP_F(ninf, v, 0x112, 0xf)); v = fmaxf(v, DPP_F(ninf, v, 0x114, 0xf)); v = fmaxf(v, DPP_F(ninf, v, 0x118, 0xf));
    v = fmaxf(v, DPP_F(ninf, v, 0x142, 0xa)); v = fmaxf(v, DPP_F(ninf, v, 0x143, 0xc));
    return v;
}
#define LDS_WAIT() asm volatile("s_waitcnt lgkmcnt(0)" ::: "memory")
#define VM_WAIT() asm volatile("s_waitcnt vmcnt(0)" ::: "memory")
#define SYNC_LDS() do { asm volatile("s_waitcnt lgkmcnt(0)" ::: "memory"); __builtin_amdgcn_s_barrier(); asm volatile("" ::: "memory"); } while (0)

namespace pg8 {
constexpr int BM = 256, BK = 64, HALF = 128, HTB = HALF * BK * 2, STAGE_BYTES = 8 * HTB, NXCD = 8, WGM = 8;
__host__ __device__ __forceinline__ int lds_byte(int r, int c) { const int st = (r >> 4) * 2 + (c >> 5), rr = r & 15, cc = c & 31, ob = rr * 64 + cc * 2; return st * 1024 + (ob ^ (((ob >> 9) & 1) << 5)); }
__host__ __device__ __forceinline__ void stage_rc(int b, int& R, int& C) { const int st = b / 1024, sb = b % 1024, swz = sb ^ (((sb >> 9) & 1) << 5); R = (st >> 1) * 16 + swz / 64; C = (st & 1) * 32 + (swz % 64) / 2; }
__host__ __device__ __forceinline__ int perm32(int rho) { const int n = rho >> 4, i = rho & 15; return 8 * (i >> 2) + 4 * n + (i & 3); }
struct Unit { int pm, pn; };
struct Gemm { const bf16_t* A; const bf16_t* Bt; int M, N, K; };
struct StaticOrder {
    int nM, nN, nwg, G, c;
    __device__ void init(int M, int N, int G_, int c_) { nM = M / BM; nN = N / BM; nwg = nM * nN; G = G_; c = c_; }
    __device__ bool next(int i, Unit& u) const {
        const long L = (long)i * G + c; if (L >= nwg) return false;
        int wgid = (int)L; { const int q = nwg / NXCD, r = nwg % NXCD, xcd = wgid % NXCD, off = wgid / NXCD; wgid = (xcd < r ? xcd * (q + 1) : r * (q + 1) + (xcd - r) * q) + off; }
        const int nig = WGM * nN, gid = wgid / nig, fm = gid * WGM, gsz = (nM - fm) < WGM ? (nM - fm) : WGM;
        u.pm = fm + ((wgid % nig) % gsz); u.pn = (wgid % nig) / gsz; return true;
    }
};
struct BranchOrder {
    int G, c, np;
    __device__ bool next(int i, Unit& u) const {
        const int L = (i / 3) * G + c, n = i % 3; if (L >= np * 8) return false;
        u.pm = n * (TMAX / 256) + (L >> 3); u.pn = n * 8 + (L & 7); return true;
    }
};

typedef int i32x4_t __attribute__((ext_vector_type(4)));
typedef int i32x8_t __attribute__((ext_vector_type(8)));
__device__ __forceinline__ i32x8_t cat16(const bf16x8 lo, const bf16x8 hi) { return __builtin_shufflevector(__builtin_bit_cast(i32x4_t, lo), __builtin_bit_cast(i32x4_t, hi), 0, 1, 2, 3, 4, 5, 6, 7); }
__device__ __forceinline__ void mfma_f8_acc(f32x4& c, const i32x8_t a, const i32x8_t b) { asm volatile("v_mfma_f32_16x16x128_f8f6f4 %0, %1, %2, %0" : "+v"(c) : "v"(a), "v"(b)); }
#define F8_DRAIN() asm volatile("s_nop 15\n\ts_nop 15" ::: "memory")
template <class Epi, class Sched, bool ALIGN_EPI, bool SP2, bool F8 = false>
__device__ __forceinline__ void gemm_phase(LAS unsigned char* lds, const Gemm g, const Sched& S, const Epi& E) {
    const int tid = tidx(), wid = __builtin_amdgcn_readfirstlane(tid >> 6), lane = tid & 63, wr = wid >> 2, wc = wid & 3, fr = lane & 15, fq = lane >> 4;
    static_assert(!F8 || SP2, "the fp8 body is written for the two-group schedule");
    const int K = g.K, nt = K / BK;
    unsigned voffA[2], voffB[2];
#pragma unroll
    for (int i = 0; i < 2; ++i) { int R, C; stage_rc(tid * 16 + i * 8192, R, C); const int Rb = Epi::PERM ? ((R & ~31) + perm32(R & 31)) : R;
        voffA[i] = (unsigned)(R * K + C) * 2u; voffB[i] = (unsigned)(Rb * K + C) * 2u; }
    const size_t kstep = (size_t)(BK * 2);
    const size_t hstep = (size_t)HALF * K * 2;
    const size_t tstep = 2 * hstep;
    const unsigned ldsw = (unsigned)wid * 1024u;
    const int aoff = lds_byte(wr * 64 + fr, fq * 8), boff = lds_byte(wc * 32 + fr, fq * 8);
#define PG8_SA(b, h) (((b) * 2 + (h)) * HTB)
#define PG8_SB(b, h) ((4 + (b) * 2 + (h)) * HTB)
#define PG8_STAGE(bufoff, gbase, voff) do { _Pragma("unroll") for (int _i = 0; _i < 2; ++_i) \
        __builtin_amdgcn_global_load_lds((const unsigned*)((const char*)(gbase) + (voff)[_i]), (LAS unsigned*)(lds + (bufoff) + ldsw + _i * 8192), 16, 0, 0); } while (0)
#define PG8_LDA(dst, b, h) do { _Pragma("unroll") for (int m = 0; m < (F8 ? 2 : 4); ++m) _Pragma("unroll") for (int k = 0; k < 2; ++k) dst[m][k] = *(const LAS bf16x8*)(lds + PG8_SA(b, h) + aoff + m * 2048 + k * 1024); } while (0)
#define PG8_LDB(dst, b, h) do { _Pragma("unroll") for (int n = 0; n < 2; ++n) _Pragma("unroll") for (int k = 0; k < 2; ++k) dst[n][k] = *(const LAS bf16x8*)(lds + PG8_SB(b, h) + boff + n * 2048 + k * 1024); } while (0)
#define PG8_MMA(ai, bj, At, Bt) do { __builtin_amdgcn_s_setprio(1); \
        _Pragma("unroll") for (int m = 0; m < 4; ++m) _Pragma("unroll") for (int n = 0; n < 2; ++n) _Pragma("unroll") for (int k = 0; k < 2; ++k) \
            acc[ai][bj][m][n] = __builtin_amdgcn_mfma_f32_16x16x32_bf16(Bt[n][k], At[m][k], acc[ai][bj][m][n], 0, 0, 0); \
        __builtin_amdgcn_s_setprio(0); } while (0)
#define PG8_F8ROW(ai, m, s) do { _Pragma("unroll") for (int bj = 0; bj < 2; ++bj) _Pragma("unroll") for (int n = 0; n < 2; ++n) \
        mfma_f8_acc(acc[ai][bj][m][n], cat16(bj ? B1[n][0] : B0[n][0], bj ? B1[n][1] : B0[n][1]), cat16(At[s][0], At[s][1])); } while (0)
#define PG8_F8LD(s, m, b, h) do { _Pragma("unroll") for (int k = 0; k < 2; ++k) At[s][k] = *(const LAS bf16x8*)(lds + PG8_SA(b, h) + aoff + (m) * 2048 + k * 1024); } while (0)
#define PG8_MM2(ai, b, h) do { if constexpr (F8) { __builtin_amdgcn_s_setprio(1); \
        PG8_F8ROW(ai, 0, 0); PG8_SCHED; PG8_F8LD(0, 2, b, h); PG8_SCHED; PG8_F8ROW(ai, 1, 1); PG8_SCHED; PG8_F8LD(1, 3, b, h); PG8_SCHED; PG8_WAIT_L(2); PG8_F8ROW(ai, 2, 0); PG8_SCHED; PG8_WAIT_L(0); PG8_F8ROW(ai, 3, 1); \
        __builtin_amdgcn_s_setprio(0); } else { PG8_MMA(ai, 0, At, B0); PG8_MMA(ai, 1, At, B1); } } while (0)
#define PG8_WAIT_V(n) asm volatile("s_waitcnt vmcnt(" #n ")" ::: "memory")
#define PG8_WAIT_L(n) asm volatile("s_waitcnt lgkmcnt(" #n ")" ::: "memory")
#define PG8_BAR __builtin_amdgcn_s_barrier()
#define PG8_SCHED __builtin_amdgcn_sched_barrier(0)
    Unit cur, nxt; int ui = 0;
    if (!S.next(0, cur)) return;
    f32x4 acc[2][2][4][2];
#pragma unroll
    for (int a = 0; a < 2; ++a)
#pragma unroll
        for (int b = 0; b < 2; ++b)
#pragma unroll
            for (int m = 0; m < 4; ++m)
#pragma unroll
                for (int n = 0; n < 2; ++n) acc[a][b][m][n] = (f32x4){0.f, 0.f, 0.f, 0.f};
    bf16x8 At[4][2], B0[2][2], B1[2][2];
    const char* cA = (const char*)g.A + (size_t)cur.pm * tstep; const char* cB = (const char*)g.Bt + (size_t)cur.pn * tstep;
    if constexpr (SP2) {
        PG8_STAGE(PG8_SB(0, 0), cB, voffB); PG8_STAGE(PG8_SB(0, 1), cB + hstep, voffB); PG8_STAGE(PG8_SA(0, 0), cA, voffA); PG8_STAGE(PG8_SA(0, 1), cA + hstep, voffA);
        if (wr == 1) PG8_BAR;
        PG8_WAIT_V(2); PG8_BAR;
        PG8_STAGE(PG8_SB(1, 0), cB + kstep, voffB); PG8_STAGE(PG8_SA(1, 0), cA + kstep, voffA); PG8_STAGE(PG8_SB(1, 1), cB + hstep + kstep, voffB);
        PG8_WAIT_V(6); PG8_BAR;
    } else {
        PG8_STAGE(PG8_SB(0, 0), cB, voffB); PG8_STAGE(PG8_SA(0, 0), cA, voffA); PG8_STAGE(PG8_SB(0, 1), cB + hstep, voffB); PG8_STAGE(PG8_SA(0, 1), cA + hstep, voffA);
        if (wr == 1) PG8_BAR;
        PG8_WAIT_V(4); PG8_BAR;
        PG8_STAGE(PG8_SB(1, 0), cB + kstep, voffB); PG8_STAGE(PG8_SA(1, 0), cA + kstep, voffA); PG8_STAGE(PG8_SB(1, 1), cB + hstep + kstep, voffB);
        PG8_WAIT_V(6); PG8_BAR;
    }
    for (;;) {
        const bool has_next = S.next(ui + 1, nxt);
        const char* nA = has_next ? (const char*)g.A + (size_t)nxt.pm * tstep : cA; const char* nB = has_next ? (const char*)g.Bt + (size_t)nxt.pn * tstep : cB;
        for (int t = 0; t < nt; t += 2) {
            const bool last = (t == nt - 2);
            const char* a1 = cA + (size_t)(t + 1) * kstep;
            const char* a2 = last ? nA : cA + (size_t)(t + 2) * kstep; const char* b2 = last ? nB : cB + (size_t)(t + 2) * kstep;
            const char* a3 = a2 + kstep; const char* b3 = b2 + kstep;
            if constexpr (SP2) {
            PG8_LDB(B0, 0, 0); PG8_LDB(B1, 0, 1); PG8_SCHED; PG8_LDA(At, 0, 0); PG8_STAGE(PG8_SA(1, 1), a1 + hstep, voffA);
            PG8_WAIT_V(8); PG8_WAIT_L(0); PG8_BAR; PG8_MM2(0, 0, 0); PG8_BAR; PG8_SCHED;
            PG8_LDA(At, 0, 1); PG8_STAGE(PG8_SB(0, 0), b2, voffB); PG8_STAGE(PG8_SB(0, 1), b2 + hstep, voffB); PG8_STAGE(PG8_SA(0, 0), a2, voffA);
            PG8_WAIT_V(8); PG8_WAIT_L(0); PG8_BAR; PG8_MM2(1, 0, 1); PG8_BAR; PG8_SCHED;
            PG8_LDB(B0, 1, 0); PG8_LDB(B1, 1, 1); PG8_SCHED; PG8_LDA(At, 1, 0); PG8_STAGE(PG8_SA(0, 1), a2 + hstep, voffA);
            PG8_WAIT_V(8); PG8_WAIT_L(0); PG8_BAR; PG8_MM2(0, 1, 0); PG8_BAR; PG8_SCHED;
            PG8_LDA(At, 1, 1); PG8_STAGE(PG8_SB(1, 0), b3, voffB); PG8_STAGE(PG8_SB(1, 1), b3 + hstep, voffB); PG8_STAGE(PG8_SA(1, 0), a3, voffA);
            PG8_WAIT_V(8); PG8_WAIT_L(0); PG8_BAR; PG8_MM2(1, 1, 1); PG8_BAR; PG8_SCHED;
            } else {
            PG8_LDB(B0, 0, 0); PG8_SCHED; PG8_LDA(At, 0, 0); PG8_STAGE(PG8_SA(1, 1), a1 + hstep, voffA);
            PG8_WAIT_L(8); PG8_BAR; PG8_WAIT_L(0); PG8_MMA(0, 0, At, B0); PG8_BAR; PG8_SCHED;
            PG8_LDB(B1, 0, 1); PG8_STAGE(PG8_SB(0, 0), b2, voffB);
            PG8_BAR; PG8_WAIT_L(0); PG8_MMA(0, 1, At, B1); PG8_BAR;
            PG8_LDA(At, 0, 1); PG8_STAGE(PG8_SA(0, 0), a2, voffA);
            PG8_BAR; PG8_WAIT_L(0); PG8_MMA(1, 0, At, B0); PG8_BAR; PG8_SCHED;
            PG8_STAGE(PG8_SB(0, 1), b2 + hstep, voffB);
            PG8_WAIT_V(6); PG8_BAR; PG8_MMA(1, 1, At, B1); PG8_BAR;
            PG8_LDB(B0, 1, 0); PG8_SCHED; PG8_LDA(At, 1, 0); PG8_STAGE(PG8_SA(0, 1), a2 + hstep, voffA);
            PG8_WAIT_L(8); PG8_BAR; PG8_WAIT_L(0); PG8_MMA(0, 0, At, B0); PG8_BAR; PG8_SCHED;
            PG8_LDB(B1, 1, 1); PG8_STAGE(PG8_SB(1, 0), b3, voffB);
            PG8_BAR; PG8_WAIT_L(0); PG8_MMA(0, 1, At, B1); PG8_BAR;
            PG8_LDA(At, 1, 1); PG8_STAGE(PG8_SA(1, 0), a3, voffA);
            PG8_BAR; PG8_WAIT_L(0); PG8_MMA(1, 0, At, B0); PG8_BAR; PG8_SCHED;
            PG8_STAGE(PG8_SB(1, 1), b3 + hstep, voffB);
            PG8_WAIT_V(6); PG8_BAR; PG8_MMA(1, 1, At, B1); PG8_BAR;
            }
        }
        if constexpr (ALIGN_EPI) { if (wr == 0) PG8_BAR; }
        if constexpr (F8) F8_DRAIN();
        E(acc, cur, wr, wc, fr, fq);
        if (!has_next) break;
#pragma unroll
        for (int a = 0; a < 2; ++a)
#pragma unroll
            for (int b = 0; b < 2; ++b)
#pragma unroll
                for (int m = 0; m < 4; ++m)
#pragma unroll
                    for (int n = 0; n < 2; ++n) acc[a][b][m][n] = (f32x4){0.f, 0.f, 0.f, 0.f};
        cur = nxt; cA = nA; cB = nB; ++ui;
        if constexpr (ALIGN_EPI) { if (wr == 1) PG8_BAR; }
    }
    PG8_WAIT_V(0);
    if constexpr (!ALIGN_EPI) { if (wr == 0) PG8_BAR; }
    PG8_BAR;
#undef PG8_SA
#undef PG8_SB
#undef PG8_STAGE
#undef PG8_LDA
#undef PG8_LDB
#undef PG8_MMA
#undef PG8_F8ROW
#undef PG8_F8LD
#undef PG8_MM2
#undef PG8_WAIT_V
#undef PG8_WAIT_L
#undef PG8_BAR
#undef PG8_SCHED
}


struct EpiZ {
    static constexpr bool PERM = true;
    bf16_t* Z; float* SM;
    __device__ __forceinline__ void operator()(const f32x4 (&acc)[2][2][4][2], const Unit& u, int wr, int wc, int fr, int fq) const {
        const int row0 = u.pm * BM + wr * 64 + fr;
        if (u.pn < 36) {
            const int col0 = u.pn * BM + wc * 32 + 8 * fq;
#pragma unroll
            for (int ai = 0; ai < 2; ++ai)
#pragma unroll
                for (int m = 0; m < 4; ++m) { bf16_t* rowp = Z + zoff(row0 + ai * HALF + m * 16, col0);
#pragma unroll
                    for (int bj = 0; bj < 2; ++bj) { const f32x4 v0 = acc[ai][bj][m][0], v1 = acc[ai][bj][m][1];
                        u32x4 w; w.x = cvt_pk_bf16(v0[0], v0[1]); w.y = cvt_pk_bf16(v0[2], v0[3]); w.z = cvt_pk_bf16(v1[0], v1[1]); w.w = cvt_pk_bf16(v1[2], v1[3]);
                        *(u32x4*)(rowp + bj * HALF) = w; } }
        } else {
            const int lc = wc * 32 + 8 * fq;
            if (lc < 48) {
#pragma unroll
                for (int ai = 0; ai < 2; ++ai)
#pragma unroll
                    for (int m = 0; m < 4; ++m) { float* rowp = SM + (size_t)(row0 + ai * HALF + m * 16) * 64 + lc;
                        *(f32x4*)(rowp) = acc[ai][0][m][0]; *(f32x4*)(rowp + 4) = acc[ai][0][m][1]; }
            }
        }
    }
};
struct EpiMG {
    static constexpr bool PERM = true;
    bf16_t* Z; const float* b_merge; float wscale;
    __device__ __forceinline__ void operator()(const f32x4 (&acc)[2][2][4][2], const Unit& u, int wr, int wc, int fr, int fq) const {
        const int row0 = u.pm * BM + wr * 64 + fr, col0 = u.pn * BM + wc * 32 + 8 * fq;
        unsigned char* Zg = (unsigned char*)Z;
#pragma unroll
        for (int bj = 0; bj < 2; ++bj) {
            const f32x4 b0 = *(const f32x4*)(b_merge + col0 + bj * HALF), b1 = *(const f32x4*)(b_merge + col0 + bj * HALF + 4);
#pragma unroll
            for (int ai = 0; ai < 2; ++ai)
#pragma unroll
                for (int m = 0; m < 4; ++m) { unsigned char* rowp = Zg + goff8(row0 + ai * HALF + m * 16, col0);
                    f32x4 v0 = acc[ai][bj][m][0] * wscale + b0, v1 = acc[ai][bj][m][1] * wscale + b1;
                    unsigned q0[4], q1[4];
#pragma unroll
                    for (int e = 0; e < 4; ++e) { q0[e] = __float_as_uint(__builtin_fmaf(sigmoid_f(v0[e]), 255.f, 8388608.f)); q1[e] = __float_as_uint(__builtin_fmaf(sigmoid_f(v1[e]), 255.f, 8388608.f)); }
                    u32x2 w;
                    w.x = __builtin_amdgcn_perm(q0[1], q0[0], 0x0c0c0400u) | __builtin_amdgcn_perm(q0[3], q0[2], 0x04000c0cu);
                    w.y = __builtin_amdgcn_perm(q1[1], q1[0], 0x0c0c0400u) | __builtin_amdgcn_perm(q1[3], q1[2], 0x04000c0cu);
                    *(u32x2*)(rowp + bj * HALF) = w; }
        }
    }
};
struct EpiBranch {
    static constexpr bool PERM = true;
    const bf16_t* Z; float* slab; bf16_t* MG;
    __device__ __forceinline__ void operator()(const f32x4 (&acc)[2][2][4][2], const Unit& u, int wr, int wc, int fr, int fq) const {
        const int n = u.pn >> 3, pm = u.pm - n * (TMAX / 256), pn = u.pn & 7;
        const int row0 = pm * BM + wr * 64 + fr, col0 = pn * BM + wc * 32 + 8 * fq;
#pragma unroll
        for (int ai = 0; ai < 2; ++ai)
#pragma unroll
            for (int m = 0; m < 4; ++m) { const int row = row0 + ai * HALF + m * 16;
                u32x2 gw[2]; u32x4 pv[2];
#pragma unroll
                for (int bj = 0; bj < 2; ++bj) { gw[bj] = *(const u32x2*)((const unsigned char*)Z + goff8(row, n * D + col0) + bj * HALF);
                    if (n > 0) pv[bj] = *(const u32x4*)(MG + (size_t)row * D + col0 + bj * HALF); }
#pragma unroll
                for (int bj = 0; bj < 2; ++bj) { const u32x2 g = gw[bj]; const float k255 = 1.f / 255.f;
                    f32x4 v0 = acc[ai][bj][m][0] * k255, v1 = acc[ai][bj][m][1] * k255;
                    v0[0] *= (float)(g.x & 0xffu); v0[1] *= (float)((g.x >> 8) & 0xffu); v0[2] *= (float)((g.x >> 16) & 0xffu); v0[3] *= (float)((g.x >> 24) & 0xffu);
                    v1[0] *= (float)(g.y & 0xffu); v1[1] *= (float)((g.y >> 8) & 0xffu); v1[2] *= (float)((g.y >> 16) & 0xffu); v1[3] *= (float)((g.y >> 24) & 0xffu);
                    if (n > 0) { const u32x4 q = pv[bj];
                        v0[0] += __uint_as_float(q.x << 16); v0[1] += __uint_as_float(q.x & 0xffff0000u); v0[2] += __uint_as_float(q.y << 16); v0[3] += __uint_as_float(q.y & 0xffff0000u);
                        v1[0] += __uint_as_float(q.z << 16); v1[1] += __uint_as_float(q.z & 0xffff0000u); v1[2] += __uint_as_float(q.w << 16); v1[3] += __uint_as_float(q.w & 0xffff0000u); }
                    u32x4 w; w.x = cvt_pk_bf16(v0[0], v0[1]); w.y = cvt_pk_bf16(v0[2], v0[3]); w.z = cvt_pk_bf16(v1[0], v1[1]); w.w = cvt_pk_bf16(v1[2], v1[3]);
                    *(u32x4*)(MG + (size_t)row * D + col0 + bj * HALF) = w; }
            }
    }
};
struct EpiResid {
    static constexpr bool PERM = true;
    const float* xin_ctx; const float* xin_lat; bf16_t* XB; const float* mod_l; int gidx; int grp; int in_f32;
    unsigned char* wsb = nullptr; int fin = 0;
    __device__ __forceinline__ void operator()(const f32x4 (&acc)[2][2][4][2], const Unit& u, int wr, int wc, int fr, int fq) const {
        const int t0 = glob_tok(grp, u.pm * BM);
        const int cond = t0 < NCTX ? 8 : (t0 - NCTX) >> 12;
        const float* xin = t0 < NCTX ? xin_ctx : xin_lat;
        const float* gate = mod_l + (size_t)cond * 12288 + gidx * D;
        const int row0 = t0 + wr * 64 + fr, col0 = u.pn * BM + wc * 32 + 8 * fq;
        bf16_t* XO = fin ? (bf16_t*)((uintptr_t)wsb + xfin_off(t0) - (size_t)t0 * D * 2) : XB;
        f32x4 gv[2][2];
#pragma unroll
        for (int bj = 0; bj < 2; ++bj)
#pragma unroll
            for (int n = 0; n < 2; ++n) gv[bj][n] = *(const f32x4*)(gate + col0 + bj * HALF + 4 * n);
#pragma unroll
        for (int ai = 0; ai < 2; ++ai)
#pragma unroll
            for (int m = 0; m < 4; ++m) { const size_t off = (size_t)(row0 + ai * HALF + m * 16) * D + col0;
#pragma unroll
                for (int bj = 0; bj < 2; ++bj) { f32x4 x0, x1;
                    if (in_f32) { x0 = *(const f32x4*)(xin + off + bj * HALF); x1 = *(const f32x4*)(xin + off + bj * HALF + 4); }
                    else { const u32x4 q = *(const u32x4*)(XB + off + bj * HALF);
                        x0[0] = __uint_as_float(q.x << 16); x0[1] = __uint_as_float(q.x & 0xffff0000u); x0[2] = __uint_as_float(q.y << 16); x0[3] = __uint_as_float(q.y & 0xffff0000u);
                        x1[0] = __uint_as_float(q.z << 16); x1[1] = __uint_as_float(q.z & 0xffff0000u); x1[2] = __uint_as_float(q.w << 16); x1[3] = __uint_as_float(q.w & 0xffff0000u); }
                    x0 += gv[bj][0] * acc[ai][bj][m][0]; x1 += gv[bj][1] * acc[ai][bj][m][1];
                    u32x4 w; w.x = cvt_pk_bf16(x0[0], x0[1]); w.y = cvt_pk_bf16(x0[2], x0[3]); w.z = cvt_pk_bf16(x1[0], x1[1]); w.w = cvt_pk_bf16(x1[2], x1[3]);
                    *(u32x4*)(XO + off + bj * HALF) = w; } }
    }
};
struct EpiBf16 {
    static constexpr bool PERM = true;
    bf16_t* O; int ldc;
    __device__ __forceinline__ void operator()(const f32x4 (&acc)[2][2][4][2], const Unit& u, int wr, int wc, int fr, int fq) const {
        const int row0 = u.pm * BM + wr * 64 + fr, col0 = u.pn * BM + wc * 32 + 8 * fq;
#pragma unroll
        for (int ai = 0; ai < 2; ++ai)
#pragma unroll
            for (int m = 0; m < 4; ++m) { bf16_t* rowp = O + zoff(row0 + ai * HALF + m * 16, col0);
#pragma unroll
                for (int bj = 0; bj < 2; ++bj) { const f32x4 v0 = acc[ai][bj][m][0], v1 = acc[ai][bj][m][1];
                    u32x4 w; w.x = cvt_pk_bf16(v0[0], v0[1]); w.y = cvt_pk_bf16(v0[2], v0[3]); w.z = cvt_pk_bf16(v1[0], v1[1]); w.w = cvt_pk_bf16(v1[2], v1[3]);
                    *(u32x4*)(rowp + bj * HALF) = w; } }
    }
};
}

#define XB_TMO      128
#define XB_XCNT(j)  (256  + 64 * (j))
#define XB_XSUB(j)  (1280 + 64 * (j))
#define XB_XGEN(j)  (2304 + 64 * (j))
#define XB_TOP      3328
#define XB_TOPGEN   3392
#define XCD_BAR_WORDS 3456
#define XB_SPIN_CAP (1u << 18)
__device__ __forceinline__ unsigned xb_ld(unsigned* p)              { return __hip_atomic_load(p, __ATOMIC_RELAXED, __HIP_MEMORY_SCOPE_AGENT); }
__device__ __forceinline__ unsigned xb_add(unsigned* p, unsigned v) { return __hip_atomic_fetch_add(p, v, __ATOMIC_RELAXED, __HIP_MEMORY_SCOPE_AGENT); }
__device__ __forceinline__ unsigned xb_xcc_id() { return (unsigned)__builtin_amdgcn_s_getreg((3 << 11) | 20) & 0xFu; }
#define XB_SPIN(cond, bar) do { unsigned _sp = 0; while (cond) { __builtin_amdgcn_s_sleep(1); \
    if ((++_sp & 255u) == 0u) { if (xb_ld(&(bar)[XB_TMO])) break; if (_sp > XB_SPIN_CAP) { atomicAdd(&(bar)[XB_TMO], 1u); break; } } } } while (0)
struct XcdBarrier { unsigned* bar; unsigned x; volatile LAS unsigned* st; };
__device__ __forceinline__ XcdBarrier xcd_barrier_post(unsigned* bar, volatile LAS unsigned* st) {
    XcdBarrier b; b.bar = bar; b.x = xb_xcc_id(); b.st = st;
    if (threadIdx.x == 0) (void)xb_add(&bar[XB_XCNT(b.x)], 1u);
    return b;
}
__device__ __forceinline__ void xcd_barrier_complete(unsigned* bar, unsigned x, unsigned& nloc, unsigned& nx) {
    const unsigned G = gridDim.x * gridDim.y * gridDim.z;
    unsigned sum, cnt, mine, sp = 0u;
    for (;;) {
        sum = 0u; cnt = 0u; mine = 0u;
#pragma unroll
        for (unsigned j = 0; j < 16; ++j) { const unsigned c = xb_ld(&bar[XB_XCNT(j)]); sum += c; cnt += (c > 0u) ? 1u : 0u; mine = (j == x) ? c : mine; }
        if (sum == G) break;
        __builtin_amdgcn_s_sleep(1);
        if ((++sp & 255u) == 0u) { if (xb_ld(&bar[XB_TMO])) break; if (sp > XB_SPIN_CAP) { atomicAdd(&bar[XB_TMO], 1u); break; } }
    }
    nloc = mine > 0u ? mine : 1u; nx = cnt > 0u ? cnt : 1u;
}
__device__ __forceinline__ void xcd_barrier(const XcdBarrier& b) {
    asm volatile("s_waitcnt vmcnt(0)" ::: "memory");
    __syncthreads();
    if (threadIdx.x == 0) {
        unsigned* bar = b.bar;
        __builtin_amdgcn_s_waitcnt(0);
        unsigned nloc = b.st[0], nx = b.st[1];
        if (nloc == 0u) { xcd_barrier_complete(bar, b.x, nloc, nx); b.st[0] = nloc; b.st[1] = nx; }
        const unsigned old = xb_add(&bar[XB_XSUB(b.x)], 1u);
        const unsigned gen = old / nloc;
        if (old + 1u == (gen + 1u) * nloc) {
            __builtin_amdgcn_fence(__ATOMIC_RELEASE, "agent");
            asm volatile("s_waitcnt vmcnt(0)" ::: "memory");
            const unsigned og = xb_add(&bar[XB_TOP], 1u);
            const unsigned tg = og / nx;
            if (og + 1u == (tg + 1u) * nx) xb_add(&bar[XB_TOPGEN], 1u);
            else XB_SPIN(xb_ld(&bar[XB_TOPGEN]) == tg, bar);
            __builtin_amdgcn_fence(__ATOMIC_ACQUIRE, "agent");
            xb_add(&bar[XB_XGEN(b.x)], 1u);
            asm volatile("s_waitcnt vmcnt(0)" ::: "memory");
        } else {
            XB_SPIN(xb_ld(&bar[XB_XGEN(b.x)]) == gen, bar);
            __builtin_amdgcn_fence(__ATOMIC_ACQUIRE, "agent");
            asm volatile("s_waitcnt vmcnt(0)" ::: "memory");
        }
    }
    __syncthreads();
}

enum { I_XP = 0, I_XS, I_SGLA, I_SMC, I_SMN, I_SMM, I_SLRU, I_C, I_CCTX, I_N1G, I_N2G, I_WMOD, I_BMOD, I_WIN, I_GWA, I_GBA, I_GNG, I_MBIF, I_MNG,
       I_LCW, I_LCB, I_LGW, I_LGB, I_LLAM, I_WBR, I_BMG, I_WOUT, I_FUP, I_FCW, I_FCB, I_FDOWN, I_NFG };
constexpr size_t OUT_X = 0;
constexpr size_t OUT_GLA = (size_t)NTOK * D;
constexpr size_t OUT_MC = OUT_GLA + (size_t)32 * 2 * 2 * 4 * 128 * 256;
constexpr size_t OUT_MN = OUT_MC + (size_t)32 * 2 * 2 * 4 * 256 * 256;
constexpr size_t OUT_MM = OUT_MN + (size_t)32 * 2 * 2 * 4 * 256;
constexpr size_t OUT_LRU = OUT_MM + (size_t)32 * 2 * 2 * 4;
constexpr size_t OUT_END = OUT_LRU + (size_t)32 * 2 * 2 * 1024;

struct Seq { int tl0, len, b, ctx; };
__device__ __forceinline__ Seq seq_of(int g, int s) {
    Seq q;
    if (g == 0) { if (s < 32) { q.tl0 = s * 256; q.len = 256; q.b = s; q.ctx = 1; } else { q.tl0 = NCTX + (s - 32) * 4096; q.len = 4096; q.b = s - 32; q.ctx = 0; } }
    else { q.tl0 = s * 4096; q.len = 4096; q.b = 4 + s; q.ctx = 0; }
    return q;
}
__device__ __forceinline__ int seq_index(int g, int k) { return g == 0 ? (k < 4 ? 32 + k : k - 4) : k; }
__device__ __forceinline__ int nseq_of(int g) { return g == 0 ? 36 : 4; }

__device__ __forceinline__ bf16x8 lds_frag(const LAS bf16_t* base, int ld, int row0, int k0, int lane) {
    return *(const LAS bf16x8*)(base + (row0 + (lane & 15)) * ld + k0 + (lane >> 4) * 8);
}
#define MFMA16(x, y, acc) __builtin_amdgcn_mfma_f32_16x16x32_bf16((x), (y), (acc), 0, 0, 0)

__device__ __forceinline__ void phase_mod(const Params& p, LAS unsigned char* lds) {
    LAS float* sc = (LAS float*)lds;
    LAS float* red = (LAS float*)(lds + 9 * 2048 * 4);
    const int tid = tidx();
    if ((int)blockIdx.x >= 384) return;
    for (int i = tid; i < 9 * 2048; i += NTHREADS) { const int r = i >> 11, k = i & 2047; const float v = r < 8 ? p.in[I_C][r * 2048 + k] : p.in[I_CCTX][k]; sc[i] = silu_f(v); }
    __syncthreads();
    float* mod = (float*)(p.ws + WS_MOD);
    for (int u = blockIdx.x; u < 384; u += gridDim.x) {
        const int l = u / 192, cb = u % 192, col = tid & 63, kp = tid >> 6;
        const float* w = p.in[I_WMOD] + (size_t)l * 2048 * 12288 + cb * 64 + col;
        float a[9];
#pragma unroll
        for (int r = 0; r < 9; ++r) a[r] = 0.f;
        for (int k0 = kp * 256; k0 < kp * 256 + 256; k0 += 16) { float wv[16];
#pragma unroll
            for (int kk = 0; kk < 16; ++kk) wv[kk] = w[(size_t)(k0 + kk) * 12288];
#pragma unroll
            for (int kk = 0; kk < 16; ++kk)
#pragma unroll
                for (int r = 0; r < 9; ++r) a[r] += sc[r * 2048 + k0 + kk] * wv[kk]; }
#pragma unroll
        for (int r = 0; r < 9; ++r) red[(kp * 9 + r) * 64 + col] = a[r];
        __syncthreads();
        for (int i = tid; i < 9 * 64; i += NTHREADS) { const int r = i >> 6, c2 = i & 63; float s = 0.f;
#pragma unroll
            for (int q = 0; q < 8; ++q) s += red[(q * 9 + r) * 64 + c2];
            mod[((size_t)l * 9 + r) * 12288 + cb * 64 + c2] = s + p.in[I_BMOD][l * 12288 + cb * 64 + c2]; }
        __syncthreads();
    }
}

__device__ __forceinline__ void transpose_item(const float* W, int K, int Nsrc, int k0, int src_n0, int nvalid, float scale, bf16_t* dst, LAS float* scr, int lane) {
    f32x4 wv[8];
#pragma unroll
    for (int i = 0; i < 8; ++i) { const int v = lane + 64 * i, kk = v >> 3, c4 = (v & 7) * 4; wv[i] = *(const f32x4*)(W + (size_t)(k0 + kk) * Nsrc + src_n0 + c4); }
#pragma unroll
    for (int i = 0; i < 8; ++i) { const int v = lane + 64 * i, kk = v >> 3, c4 = (v & 7) * 4; const float sc_ = c4 < nvalid ? scale : 0.f; LAS float* d_ = scr + kk * 33 + c4;
        d_[0] = wv[i][0] * sc_; d_[1] = wv[i][1] * sc_; d_[2] = wv[i][2] * sc_; d_[3] = wv[i][3] * sc_; }
    LDS_WAIT(); asm volatile("" ::: "memory");
    const int c = lane & 7;
#pragma unroll
    for (int j = 0; j < 4; ++j) { const int n = (lane >> 3) + 8 * j; const LAS float* s = scr + (8 * c) * 33 + n;
        u32x4 o; o.x = cvt_pk_bf16(s[0 * 33], s[1 * 33]); o.y = cvt_pk_bf16(s[2 * 33], s[3 * 33]); o.z = cvt_pk_bf16(s[4 * 33], s[5 * 33]); o.w = cvt_pk_bf16(s[6 * 33], s[7 * 33]);
        *(u32x4*)(dst + (size_t)n * K + k0 + 8 * c) = o; }
    LDS_WAIT(); asm volatile("" ::: "memory");
}
__device__ __forceinline__ void transpose_item_f8(const float* W, int K, int Nsrc, int k0, int src_n0, float scale, unsigned char* dst8, LAS float* scr, int lane) {
    f32x4 wv[8];
#pragma unroll
    for (int i = 0; i < 8; ++i) { const int v = lane + 64 * i, kk = v >> 3, c4 = (v & 7) * 4; wv[i] = *(const f32x4*)(W + (size_t)(k0 + kk) * Nsrc + src_n0 + c4); }
#pragma unroll
    for (int i = 0; i < 8; ++i) { const int v = lane + 64 * i, kk = v >> 3, c4 = (v & 7) * 4; LAS float* d_ = scr + kk * 33 + c4;
        d_[0] = wv[i][0] * scale; d_[1] = wv[i][1] * scale; d_[2] = wv[i][2] * scale; d_[3] = wv[i][3] * scale; }
    LDS_WAIT(); asm volatile("" ::: "memory");
    const int c = lane & 7;
#pragma unroll
    for (int j = 0; j < 4; ++j) { const int n = (lane >> 3) + 8 * j; const LAS float* s = scr + (8 * c) * 33 + n;
        int w0 = 0, w1 = 0;
        w0 = __builtin_amdgcn_cvt_pk_fp8_f32(s[0 * 33], s[1 * 33], w0, false); w0 = __builtin_amdgcn_cvt_pk_fp8_f32(s[2 * 33], s[3 * 33], w0, true);
        w1 = __builtin_amdgcn_cvt_pk_fp8_f32(s[4 * 33], s[5 * 33], w1, false); w1 = __builtin_amdgcn_cvt_pk_fp8_f32(s[6 * 33], s[7 * 33], w1, true);
        u32x2 o; o.x = (unsigned)w0; o.y = (unsigned)w1; *(u32x2*)(dst8 + (size_t)n * K + k0 + 8 * c) = o; }
    LDS_WAIT(); asm volatile("" ::: "memory");
}
__device__ __forceinline__ void phase_wconv(const Params& p, int l, LAS unsigned char* lds) {
    const int tid_ = tidx(); const int lane = tid_ & 63, wave = tid_ >> 6;
    LAS float* scr = (LAS float*)(lds + wave * 16384);
    const int gw = blockIdx.x * 8 + wave, NGW = gridDim.x * 8;
    constexpr int I_IN = 32 * 488, I_BRn = 16 * 64 * 3, I_OUTn = 32 * 64, I_UPn = 32 * 352, I_DNn = 88 * 64, I_LR = 32 * 8;
    constexpr int NITEMS = I_IN + I_BRn + I_OUTn + I_UPn + I_DNn + I_LR;
    for (int it = gw; it < NITEMS; it += NGW) {
        int r = it;
        if (r < I_IN) {
            const int kb = r / 488, nb = r % 488, d0 = nb * 32; int s0, nv = 32; float sc = 1.f;
            if (d0 < 2048) s0 = d0; else if (d0 < 5120) s0 = 3104 + (d0 - 2048); else if (d0 < 6144) s0 = 7216 + (d0 - 5120); else if (d0 < 7168) s0 = 2048 + (d0 - 6144); else if (d0 < 8192) s0 = 6176 + (d0 - 7168); else if (d0 < 9216) s0 = 8240 + (d0 - 8192); else if (d0 < 9248) s0 = 3072; else if (d0 < 9280) { s0 = 7200; nv = 16; } else if (d0 < NZ1) { s0 = 0; nv = 0; } else s0 = d0 - NZ1 + 9264;
            if (d0 < 512) sc = 0.08838834764831845f; else if (d0 >= ZC_KB && d0 < ZC_KB + 1024) sc = 0.0625f;
            if (d0 >= NZ1) { transpose_item_f8(p.in[I_WIN] + (size_t)l * 2048 * 15408, 2048, 15408, kb * 64, s0, 64.f, p.ws + WS_WMG8 + (size_t)(d0 - NZ1) * 2048, scr, lane); continue; }
            transpose_item(p.in[I_WIN] + (size_t)l * 2048 * 15408, 2048, 15408, kb * 64, s0, nv, sc, (bf16_t*)(p.ws + W_IN) + (size_t)d0 * 2048, scr, lane); continue; }
        r -= I_IN;
        if (r < I_BRn) { const int n = r / (16 * 64), q = r % (16 * 64), kb = q / 64, nb = q % 64;
            transpose_item(p.in[I_WBR] + ((size_t)l * 3 + n) * 1024 * 2048, 1024, 2048, kb * 64, nb * 32, 32, 1.f, (bf16_t*)(p.ws + W_BR) + ((size_t)n * 2048 + nb * 32) * 1024, scr, lane); continue; }
        r -= I_BRn;
        if (r < I_OUTn) { const int kb = r / 64, nb = r % 64;
            transpose_item(p.in[I_WOUT] + (size_t)l * 2048 * 2048, 2048, 2048, kb * 64, nb * 32, 32, 1.f, (bf16_t*)(p.ws + W_OUT) + (size_t)(nb * 32) * 2048, scr, lane); continue; }
        r -= I_OUTn;
        if (r < I_UPn) { const int kb = r / 352, nb = r % 352;
            transpose_item(p.in[I_FUP] + (size_t)l * 2048 * NUP, 2048, NUP, kb * 64, nb * 32, 32, 1.f, (bf16_t*)(p.ws + W_UP) + (size_t)(nb * 32) * 2048, scr, lane); continue; }
        r -= I_UPn;
        if (r < I_DNn) { const int kb = r / 64, nb = r % 64;
            transpose_item(p.in[I_FDOWN] + (size_t)l * DFF * 2048, DFF, 2048, kb * 64, nb * 32, 32, 1.f, (bf16_t*)(p.ws + W_DOWN) + (size_t)(nb * 32) * DFF, scr, lane); continue; }
        r -= I_DNn;
        { const int mat = r / 8, q = r % 8, kb = q / 4, nb = q % 4;
            transpose_item(p.in[I_LGW] + ((size_t)l * 32 + mat) * 16384, 128, 128, kb * 64, nb * 32, 32, 1.f, (bf16_t*)(p.ws + W_LRU) + (size_t)mat * 16384 + (size_t)(nb * 32) * 128, scr, lane); }
    }
}

__device__ __forceinline__ void phase_norm(const Params& p, int l, int g, int which, bool from_input) {
    const int tid_ = tidx(); const int lane = tid_ & 63, wave = tid_ >> 6;
    const int gw = blockIdx.x * 8 + wave, NGW = gridDim.x * 8;
    const float* ng = p.in[which ? I_N2G : I_N1G] + l * D;
    const float* mod_l = (const float*)(p.ws + WS_MOD) + (size_t)l * 9 * 12288;
    bf16_t* U = (bf16_t*)(p.ws + WS_U);
    const int tg = tg_of(g), R = (tg + NGW - 1) / NGW;
    f32x4 ga[8], hv[8]; int cond_have = -1;
    for (int tl = gw * R; tl < gw * R + R && tl < tg; ++tl) {
        const int t = glob_tok(g, tl);
        const float* xr = t < NCTX ? p.in[I_XP] + (size_t)t * D : p.in[I_XS] + (size_t)(t - NCTX) * D;
        const bf16_t* xb = (const bf16_t*)(p.out + OUT_X) + (size_t)t * D;
        const int cond = t < NCTX ? 8 : (t - NCTX) >> 12;
        if (cond != cond_have) { cond_have = cond;
            const float* sh = mod_l + (size_t)cond * 12288 + (which * 3) * D; const float* sc = sh + D;
#pragma unroll
            for (int j = 0; j < 4; ++j)
#pragma unroll
                for (int e = 0; e < 2; ++e) { const int c = j * 512 + lane * 8 + 4 * e; ga[2 * j + e] = *(const f32x4*)(ng + c) * (*(const f32x4*)(sc + c) + 1.f); hv[2 * j + e] = *(const f32x4*)(sh + c); } }
        f32x4 v[8]; float s = 0.f;
#pragma unroll
        for (int j = 0; j < 4; ++j) { const int c = j * 512 + lane * 8;
            if (from_input) { v[2 * j] = *(const f32x4*)(xr + c); v[2 * j + 1] = *(const f32x4*)(xr + c + 4); }
            else { const u32x4 q = *(const u32x4*)(xb + c);
                v[2 * j][0] = __uint_as_float(q.x << 16); v[2 * j][1] = __uint_as_float(q.x & 0xffff0000u); v[2 * j][2] = __uint_as_float(q.y << 16); v[2 * j][3] = __uint_as_float(q.y & 0xffff0000u);
                v[2 * j + 1][0] = __uint_as_float(q.z << 16); v[2 * j + 1][1] = __uint_as_float(q.z & 0xffff0000u); v[2 * j + 1][2] = __uint_as_float(q.w << 16); v[2 * j + 1][3] = __uint_as_float(q.w & 0xffff0000u); } }
#pragma unroll
        for (int j = 0; j < 8; ++j) s += (v[j][0] * v[j][0] + v[j][1] * v[j][1]) + (v[j][2] * v[j][2] + v[j][3] * v[j][3]);
        const float rstd = rsqrtf(wave_sum(s) * (1.f / D) + EPS);
#pragma unroll
        for (int j = 0; j < 4; ++j) { const int c = j * 512 + lane * 8;
            const f32x4 o0 = v[2 * j] * rstd * ga[2 * j] + hv[2 * j], o1 = v[2 * j + 1] * rstd * ga[2 * j + 1] + hv[2 * j + 1];
            u32x4 w; w.x = cvt_pk_bf16(o0[0], o0[1]); w.y = cvt_pk_bf16(o0[2], o0[3]); w.z = cvt_pk_bf16(o1[0], o1[1]); w.w = cvt_pk_bf16(o1[2], o1[3]); *(u32x4*)(U + (size_t)tl * D + c) = w;
            if (which == 0) { int w0 = 0, w1 = 0;
                w0 = __builtin_amdgcn_cvt_pk_fp8_f32(o0[0], o0[1], w0, false); w0 = __builtin_amdgcn_cvt_pk_fp8_f32(o0[2], o0[3], w0, true);
                w1 = __builtin_amdgcn_cvt_pk_fp8_f32(o1[0], o1[1], w1, false); w1 = __builtin_amdgcn_cvt_pk_fp8_f32(o1[2], o1[3], w1, true);
                u32x2 q8; q8.x = (unsigned)w0; q8.y = (unsigned)w1; *(u32x2*)(p.ws + WS_U8 + (size_t)tl * D + c) = q8; } }
    }
}
__device__ __forceinline__ void phase_final_norm(const Params& p) {
    const int tid_ = tidx(); const int lane = tid_ & 63, wave = tid_ >> 6;
    const int gw = blockIdx.x * 8 + wave, NGW = gridDim.x * 8;
    f32x4 gn[8];
#pragma unroll
    for (int j = 0; j < 4; ++j)
#pragma unroll
        for (int e = 0; e < 2; ++e) gn[2 * j + e] = *(const f32x4*)(p.in[I_NFG] + j * 512 + lane * 8 + 4 * e);
    for (int t = gw; t < NTOK; t += NGW) {
        const bf16_t* xb = (const bf16_t*)(p.ws + xfin_off(t)); float* xr = p.out + OUT_X + (size_t)t * D;
        f32x4 v[8]; float s = 0.f;
#pragma unroll
        for (int j = 0; j < 4; ++j) { const u32x4 q = *(const u32x4*)(xb + j * 512 + lane * 8);
            v[2 * j][0] = __uint_as_float(q.x << 16); v[2 * j][1] = __uint_as_float(q.x & 0xffff0000u); v[2 * j][2] = __uint_as_float(q.y << 16); v[2 * j][3] = __uint_as_float(q.y & 0xffff0000u);
            v[2 * j + 1][0] = __uint_as_float(q.z << 16); v[2 * j + 1][1] = __uint_as_float(q.z & 0xffff0000u); v[2 * j + 1][2] = __uint_as_float(q.w << 16); v[2 * j + 1][3] = __uint_as_float(q.w & 0xffff0000u); }
#pragma unroll
        for (int j = 0; j < 8; ++j) s += (v[j][0] * v[j][0] + v[j][1] * v[j][1]) + (v[j][2] * v[j][2] + v[j][3] * v[j][3]);
        const float rstd = rsqrtf(wave_sum(s) * (1.f / D) + EPS);
#pragma unroll
        for (int j = 0; j < 4; ++j)
#pragma unroll
            for (int e = 0; e < 2; ++e) *(f32x4*)(xr + j * 512 + lane * 8 + 4 * e) = v[2 * j + e] * rstd * gn[2 * j + e];
    }
}

__device__ __forceinline__ bf16_t* o_buf(const Params& p, int dir, int mixer) { return (bf16_t*)(p.ws + WS_O) + ((size_t)(dir * 3 + mixer) * TMAX) * 1024; }

typedef short s16x4_t __attribute__((ext_vector_type(4)));
__device__ __forceinline__ bf16x8 lds_frag_tr(const LAS bf16_t* base, int ld, int k0, int col0, int lane) {
    const LAS bf16_t* a = base + (k0 + 8 * (lane >> 4) + ((lane & 15) >> 2)) * ld + col0 + 4 * (lane & 3);
    const s16x4_t lo = __builtin_amdgcn_ds_read_tr16_b64_v4i16((LAS s16x4_t*)a), hi = __builtin_amdgcn_ds_read_tr16_b64_v4i16((LAS s16x4_t*)(a + 4 * ld));
    return __builtin_shufflevector(lo, hi, 0, 1, 2, 3, 4, 5, 6, 7);
}
__device__ __forceinline__ void gla_item(const Params& p, int l, const Seq sq, int h, int dir, int slice, LAS unsigned char* lds) {
    LAS bf16_t* QIN = (LAS bf16_t*)(lds);
    LAS bf16_t* KIN = (LAS bf16_t*)(lds + 17408);
    LAS bf16_t* VRAW = (LAS bf16_t*)(lds + 34816);
    LAS bf16_t* ATT = (LAS bf16_t*)(lds + 52224);
    LAS bf16_t* SB0 = (LAS bf16_t*)(lds + 61440);
    LAS bf16_t* RAB = (LAS bf16_t*)(lds + 131072);
    LAS float*  EL  = (LAS float*)(lds + 136192);
    const int tid = tidx(), lane = tid & 63, w = tid >> 6, q4 = lane >> 4, l15 = lane & 15;
    const bf16_t* Z = (const bf16_t*)(p.ws + WS_Z); const float* SM = (const float*)(p.ws + WS_SM);
    bf16_t* O = o_buf(p, dir, 0);
    const int d = tid & 127, rg = tid >> 7;
    const int dq = 16 * w + l15;
    bf16x8 wb1, wb2;
    {
        LAS bf16_t* W1 = (LAS bf16_t*)(lds); LAS bf16_t* W2 = (LAS bf16_t*)(lds + 10240);
        const int jq = tid >> 7; float wv[4];
#pragma unroll
        for (int j = 0; j < 4; ++j) wv[j] = p.in[I_GWA][((size_t)(l * 2 + dir) * 16 + jq * 4 + j) * 512 + h * 128 + d];
        unsigned short hi[4], lo[4];
#pragma unroll
        for (int j = 0; j < 4; ++j) { hi[j] = f2bf(wv[j]); lo[j] = f2bf(wv[j] - bf2f(hi[j])); }
        u32x2 ph, pl; ph.x = hi[0] | ((unsigned)hi[1] << 16); ph.y = hi[2] | ((unsigned)hi[3] << 16); pl.x = lo[0] | ((unsigned)lo[1] << 16); pl.y = lo[2] | ((unsigned)lo[3] << 16);
        *(LAS u32x2*)(W1 + d * 40 + jq * 4) = ph; *(LAS u32x2*)(W1 + d * 40 + 16 + jq * 4) = ph;
        *(LAS u32x2*)(W2 + d * 40 + jq * 4) = pl; *(LAS u32x2*)(W2 + d * 40 + 16 + jq * 4) = (u32x2){0u, 0u};
        SYNC_LDS();
        wb1 = lds_frag(W1, 40, 16 * w, 0, lane); wb2 = lds_frag(W2, 40, 16 * w, 0, lane);
        SYNC_LDS();
    }
    const float bal = p.in[I_GBA][(l * 2 + dir) * 512 + h * 128 + dq];
    f32x4 S[8];
    {
        const float* s0 = p.in[I_SGLA] + ((((size_t)(sq.ctx ? 0 : sq.b) * 2 + l) * 2 + dir) * 4 + h) * 128 * 256; const float zf = sq.ctx ? 0.f : 1.f;
#pragma unroll
        for (int nt = 0; nt < 8; ++nt)
#pragma unroll
            for (int i = 0; i < 4; ++i) S[nt][i] = s0[(size_t)(16 * w + 4 * q4 + i) * 256 + slice * 128 + nt * 16 + l15] * zf;
#pragma unroll
        for (int nt = 0; nt < 8; ++nt) { u32x2 pk; pk.x = cvt_pk_bf16(S[nt][0], S[nt][1]); pk.y = cvt_pk_bf16(S[nt][2], S[nt][3]); *(LAS u32x2*)(SB0 + (nt * 16 + l15) * 136 + 16 * w + 4 * q4) = pk; }
    }
    const int nch = sq.len >> 6;
#define TOKC(cc_, r) (sq.tl0 + (dir ? sq.len - 1 - ((cc_) * 64 + (r)) : (cc_) * 64 + (r)))
    u32x4 qr_[2], kr_[2], vr_[2]; f32x4 ra4 = {0.f, 0.f, 0.f, 0.f};
#define GLA_LOADS(cc_) do { \
        _Pragma("unroll") for (int i = 0; i < 2; ++i) { const int v_ = tid + 512 * i, row_ = v_ >> 4, c8_ = (v_ & 15) * 8; const int tk_ = TOKC(cc_, row_); \
            qr_[i] = *(const u32x4*)(Z + zoff(tk_, ZC_QA + h * 128 + c8_)); kr_[i] = *(const u32x4*)(Z + zoff(tk_, ZC_KA + h * 128 + c8_)); vr_[i] = *(const u32x4*)(Z + zoff(tk_, ZC_VA + h * 256 + slice * 128 + c8_)); } \
        ra4 = *(const f32x4*)(SM + (size_t)TOKC(cc_, (tid >> 2) & 63) * 64 + dir * 16 + (tid & 3) * 4); } while (0)
    GLA_LOADS(0);
    for (int c = 0; c < nch; ++c) {
        LAS bf16_t* SB = SB0 + (c & 1) * (128 * 136); LAS bf16_t* SBN = SB0 + ((c + 1) & 1) * (128 * 136);
        if (tid < 256) { unsigned short hi[4], lo[4];
#pragma unroll
            for (int j = 0; j < 4; ++j) { hi[j] = f2bf(ra4[j]); lo[j] = f2bf(ra4[j] - bf2f(hi[j])); }
            u32x2 ph, pl; ph.x = hi[0] | ((unsigned)hi[1] << 16); ph.y = hi[2] | ((unsigned)hi[3] << 16); pl.x = lo[0] | ((unsigned)lo[1] << 16); pl.y = lo[2] | ((unsigned)lo[3] << 16);
            *(LAS u32x2*)(RAB + (tid >> 2) * 40 + (tid & 3) * 4) = ph; *(LAS u32x2*)(RAB + (tid >> 2) * 40 + 16 + (tid & 3) * 4) = pl; }
#pragma unroll
        for (int i = 0; i < 2; ++i) { const int v_ = tid + 512 * i, row_ = v_ >> 4, c8_ = (v_ & 15) * 8;
            *(LAS u32x4*)(QIN + row_ * 136 + c8_) = qr_[i]; *(LAS u32x4*)(KIN + row_ * 136 + c8_) = kr_[i]; *(LAS u32x4*)(VRAW + row_ * 136 + c8_) = vr_[i]; }
        if (c + 1 < nch) GLA_LOADS(c + 1);
        SYNC_LDS();
        float cumv[4][4], last;
        {
            bf16x8 af[4];
#pragma unroll
            for (int mt2 = 0; mt2 < 4; ++mt2) af[mt2] = lds_frag(RAB, 40, mt2 * 16, 0, lane);
            asm volatile("" ::: "memory");
            float tot[4];
#pragma unroll
            for (int mt2 = 0; mt2 < 4; ++mt2) { f32x4 a = {bal, bal, bal, bal}; a = MFMA16(af[mt2], wb1, a); a = MFMA16(af[mt2], wb2, a);
                float r = 0.f;
#pragma unroll
                for (int e = 0; e < 4; ++e) { r += logsigmoid_fast(a[e]) * 0.0625f; cumv[mt2][e] = r; }
                float t = r;
                const float s1 = __shfl_up(t, 16); if (q4 >= 1) t += s1;
                const float s2 = __shfl_up(t, 32); if (q4 >= 2) t += s2;
                const float excl = t - r;
#pragma unroll
                for (int e = 0; e < 4; ++e) cumv[mt2][e] += excl;
                tot[mt2] = __shfl(t, 48 + l15); }
            float base = 0.f;
#pragma unroll
            for (int mt2 = 0; mt2 < 4; ++mt2) {
#pragma unroll
                for (int e = 0; e < 4; ++e) cumv[mt2][e] += base;
                base += tot[mt2]; }
            last = base;
        }
        const float elast = __expf(last);
        unsigned qraw[16], kraw[16];
        {
            s16x4_t qv[4], kv[4]; const int toff = (4 * q4 + (l15 >> 2)) * 136 + 16 * w + 4 * (l15 & 3);
#pragma unroll
            for (int mt2 = 0; mt2 < 4; ++mt2) { qv[mt2] = __builtin_amdgcn_ds_read_tr16_b64_v4i16((LAS s16x4_t*)(QIN + mt2 * 16 * 136 + toff)); kv[mt2] = __builtin_amdgcn_ds_read_tr16_b64_v4i16((LAS s16x4_t*)(KIN + mt2 * 16 * 136 + toff)); }
#pragma unroll
            for (int i = 0; i < 16; ++i) { qraw[i] = (unsigned short)qv[i >> 2][i & 3]; kraw[i] = (unsigned short)kv[i >> 2][i & 3]; }
        }
        asm volatile("" ::: "memory");
#pragma unroll
        for (int mt2 = 0; mt2 < 4; ++mt2) {
#pragma unroll
            for (int e = 0; e < 4; ++e) { const int i = mt2 * 4 + e, row = mt2 * 16 + 4 * q4 + e; const float cu = cumv[mt2][e];
                const float ex = __expf(cu), ei = __expf(-cu), qf = __uint_as_float(qraw[i] << 16), kf = __uint_as_float(kraw[i] << 16);
                QIN[row * 136 + dq] = f2bf(qf * ex); KIN[row * 136 + dq] = f2bf(kf * ei); } }
        if (q4 == 0) EL[dq] = elast;
        SYNC_LDS();
        const int mt = w >> 1;
        {
            const int nt0 = 2 * (w & 1);
#pragma unroll
            for (int t2 = 0; t2 < 2; ++t2) { const int nt = nt0 + t2; f32x4 a = {0.f, 0.f, 0.f, 0.f};
                if (nt <= mt) { bf16x8 xk[4], yq2[4];
#pragma unroll
                    for (int ks = 0; ks < 4; ++ks) { xk[ks] = lds_frag(KIN, 136, nt * 16, ks * 32, lane); yq2[ks] = lds_frag(QIN, 136, mt * 16, ks * 32, lane); }
                    asm volatile("" ::: "memory");
#pragma unroll
                    for (int ks = 0; ks < 4; ++ks) a = MFMA16(xk[ks], yq2[ks], a);
                }
                const int i = mt * 16 + l15, j0 = nt * 16 + 4 * q4;
#pragma unroll
                for (int e = 0; e < 4; ++e) if (j0 + e > i) a[e] = 0.f;
                u32x2 pk; pk.x = cvt_pk_bf16(a[0], a[1]); pk.y = cvt_pk_bf16(a[2], a[3]); *(LAS u32x2*)(ATT + i * 72 + j0) = pk; }
        }
        SYNC_LDS();
        {
            bf16x8 ya[2], yq[4];
#pragma unroll
            for (int ks = 0; ks < 2; ++ks) ya[ks] = lds_frag(ATT, 72, mt * 16, ks * 32, lane);
#pragma unroll
            for (int ks = 0; ks < 4; ++ks) yq[ks] = lds_frag(QIN, 136, mt * 16, ks * 32, lane);
            bf16_t* orow = O + (size_t)TOKC(c, mt * 16 + l15) * 1024 + h * 256 + slice * 128 + 4 * q4;
#pragma unroll
            for (int t4 = 0; t4 < 4; ++t4) { const int nt = 4 * (w & 1) + t4; f32x4 a = {0.f, 0.f, 0.f, 0.f};
                bf16x8 xv[2], xs[4];
#pragma unroll
                for (int ks = 0; ks < 2; ++ks) xv[ks] = lds_frag_tr(VRAW, 136, ks * 32, nt * 16, lane);
#pragma unroll
                for (int ks = 0; ks < 4; ++ks) xs[ks] = lds_frag(SB, 136, nt * 16, ks * 32, lane);
                asm volatile("" ::: "memory");
#pragma unroll
                for (int ks = 0; ks < 2; ++ks) a = MFMA16(xv[ks], ya[ks], a);
#pragma unroll
                for (int ks = 0; ks < 4; ++ks) a = MFMA16(xs[ks], yq[ks], a);
                u32x2 pk; pk.x = cvt_pk_bf16(a[0], a[1]); pk.y = cvt_pk_bf16(a[2], a[3]);
                *(u32x2*)(orow + nt * 16) = pk; }
        }
        {
            const f32x4 el = *(const LAS f32x4*)(EL + 16 * w + 4 * q4);
            bf16x8 xk[2];
#pragma unroll
            for (int ks = 0; ks < 2; ++ks) xk[ks] = lds_frag_tr(KIN, 136, ks * 32, w * 16, lane);
            bf16x8 yv[8][2];
#pragma unroll
            for (int nt = 0; nt < 8; ++nt)
#pragma unroll
                for (int ks = 0; ks < 2; ++ks) yv[nt][ks] = lds_frag_tr(VRAW, 136, ks * 32, nt * 16, lane);
#pragma unroll
            for (int nt = 0; nt < 8; ++nt) {
#pragma unroll
                for (int ks = 0; ks < 2; ++ks) S[nt] = MFMA16(xk[ks], yv[nt][ks], S[nt]);
                S[nt] = S[nt] * el;
                u32x2 pk; pk.x = cvt_pk_bf16(S[nt][0], S[nt][1]); pk.y = cvt_pk_bf16(S[nt][2], S[nt][3]); *(LAS u32x2*)(SBN + (nt * 16 + l15) * 136 + 16 * w + 4 * q4) = pk; }
        }
        SYNC_LDS();
    }
#undef GLA_LOADS
#undef TOKC
    if (sq.ctx) {
        float* so = p.out + OUT_GLA + ((((size_t)sq.b * 2 + l) * 2 + dir) * 4 + h) * 128 * 256;
#pragma unroll
        for (int nt = 0; nt < 8; ++nt)
#pragma unroll
            for (int i = 0; i < 4; ++i) so[(size_t)(16 * w + 4 * q4 + i) * 256 + slice * 128 + nt * 16 + l15] = S[nt][i];
    }
}

__device__ __forceinline__ void mlstm_item(const Params& p, int l, const Seq sq, int h, int dir, int slice, LAS unsigned char* lds) {
    LAS bf16_t* KN  = (LAS bf16_t*)(lds);
    LAS bf16_t* VRAW = (LAS bf16_t*)(lds + 33792);
    LAS bf16_t* VW   = (LAS bf16_t*)(lds + 45056);
    LAS bf16_t* SMm = (LAS bf16_t*)(lds + 56320);
    LAS bf16_t* CB0 = (LAS bf16_t*)(lds + 65536);
    LAS float*  AA  = (LAS float*)(lds + 150016);
    LAS float*  MX  = AA + 64;
    LAS float*  WP  = AA + 128;
    LAS float*  FL  = AA + 192;
    LAS float*  WL  = AA + 256;
    LAS float*  DEN = AA + 320;
    LAS float*  SC  = AA + 384;
    const int tid = tidx(), lane = tid & 63, w = tid >> 6, q4 = lane >> 4, l15 = lane & 15;
    const bf16_t* Z = (const bf16_t*)(p.ws + WS_Z); const float* SM = (const float*)(p.ws + WS_SM);
    bf16_t* O = o_buf(p, dir, 1);
    const float bi = p.in[I_MBIF][((l * 2 + dir) * 2 + 0) * 4 + h], bfg = p.in[I_MBIF][((l * 2 + dir) * 2 + 1) * 4 + h];
    const size_t sidx = (((size_t)sq.b * 2 + l) * 2 + dir) * 4 + h;
    f32x4 S[2][5];
    {
        const size_t sidx0 = (((size_t)(sq.ctx ? 0 : sq.b) * 2 + l) * 2 + dir) * 4 + h; const float zf = sq.ctx ? 0.f : 1.f;
        const float* c0 = p.in[I_SMC] + sidx0 * 256 * 256; const float* n0 = p.in[I_SMN] + sidx0 * 256;
#pragma unroll
        for (int dt = 0; dt < 2; ++dt)
#pragma unroll
            for (int ct = 0; ct < 5; ++ct)
#pragma unroll
                for (int i = 0; i < 4; ++i) { const int dd = 32 * w + 16 * dt + 4 * q4 + i;
                    if (ct < 4) S[dt][ct][i] = c0[(size_t)dd * 256 + slice * 64 + ct * 16 + l15] * zf; else S[dt][ct][i] = n0[dd] * (l15 == 0 ? zf : 0.f); }
#pragma unroll
        for (int dt = 0; dt < 2; ++dt)
#pragma unroll
            for (int ct = 0; ct < 5; ++ct) { u32x2 pk; pk.x = cvt_pk_bf16(S[dt][ct][0], S[dt][ct][1]); pk.y = cvt_pk_bf16(S[dt][ct][2], S[dt][ct][3]);
                *(LAS u32x2*)(CB0 + (ct * 16 + l15) * 264 + 32 * w + 16 * dt + 4 * q4) = pk; }
        for (int i = tid; i < 64 * 24; i += NTHREADS) { const int rr = i / 24, cc = i % 24; VRAW[rr * 88 + 64 + cc] = cc == 0 ? (bf16_t)0x3F80 : (bf16_t)0; }
        if (tid == 0) SC[1] = sq.ctx ? 0.f : p.in[I_SMM][sidx];
    }
    SYNC_LDS();
    const int mt = w & 3, hf = w >> 2;
    const int nch = sq.len >> 6;
#define TOKC(cc_, r) (sq.tl0 + (dir ? sq.len - 1 - ((cc_) * 64 + (r)) : (cc_) * 64 + (r)))
    u32x4 pkr[4], pvr; float pg_i = 0.f, pg_f = 0.f;
#define MLSTM_LOADS(cc_) do { \
        _Pragma("unroll") for (int i = 0; i < 4; ++i) { const int v_ = tid + 512 * i, row_ = v_ >> 5, c8_ = (v_ & 31) * 8; pkr[i] = *(const u32x4*)(Z + zoff(TOKC(cc_, row_), ZC_KB + h * 256 + c8_)); } \
        { const int row_ = tid >> 3, c8_ = (tid & 7) * 8; pvr = *(const u32x4*)(Z + zoff(TOKC(cc_, row_), ZC_VB + h * 256 + slice * 64 + c8_)); } \
        { const float* sm_ = SM + (size_t)TOKC(cc_, lane) * 64 + 32 + dir * 8 + h; pg_i = sm_[0]; pg_f = sm_[4]; } } while (0)
    MLSTM_LOADS(0);
    for (int c = 0; c < nch; ++c) {
#define TOK(r) (sq.tl0 + (dir ? sq.len - 1 - (c * 64 + (r)) : c * 64 + (r)))
        LAS bf16_t* CB = CB0 + (c & 1) * (80 * 264); LAS bf16_t* CBN = CB0 + ((c + 1) & 1) * (80 * 264);
        bf16x8 qf[8];
        { const bf16_t* qrow = Z + zoff(TOK(mt * 16 + l15), ZC_QB + h * 256) + q4 * 8;
#pragma unroll
            for (int ks = 0; ks < 8; ++ks) qf[ks] = *(const bf16x8*)(qrow + ks * 32); }
        if (w == 0) {
            const float m_prev = SC[1];
            const float gi = pg_i + bi, lf = logsigmoid_fast(pg_f + bfg);
            const float fc = wave_scan_add(lf);
            const float a = gi - fc; const float pm = wave_scan_max(a);
            const float mx = fmaxf(m_prev, pm), mj = fc + mx;
            const float mx63 = __shfl(mx, 63), fc63 = __shfl(fc, 63);
            AA[lane] = a; MX[lane] = mx; WP[lane] = __expf(m_prev - mx); FL[lane] = __expf(-mj); WL[lane] = __expf(a - mx63);
            LDS_WAIT();
            if (lane == 63) { SC[0] = __expf(m_prev - mx63); SC[1] = fc63 + mx63; }
        }
        {
#pragma unroll
            for (int i = 0; i < 4; ++i) { const int v_ = tid + 512 * i, row_ = v_ >> 5, c8_ = (v_ & 31) * 8; *(LAS u32x4*)(KN + row_ * 264 + c8_) = pkr[i]; }
            *(LAS u32x4*)(VRAW + (tid >> 3) * 88 + (tid & 7) * 8) = pvr;
        }
        if (c + 1 < nch) { MLSTM_LOADS(c + 1); }
        SYNC_LDS();
        {
            const int row = tid >> 3, c0 = (tid & 7) * 10; const float wl = WL[row];
            unsigned vr[5];
#pragma unroll
            for (int i = 0; i < 5; ++i) vr[i] = *(const LAS unsigned*)(VRAW + row * 88 + c0 + 2 * i);
            asm volatile("" ::: "memory");
#pragma unroll
            for (int i = 0; i < 5; ++i) *(LAS unsigned*)(VW + row * 88 + c0 + 2 * i) = cvt_pk_bf16(__uint_as_float(vr[i] << 16) * wl, __uint_as_float(vr[i] & 0xffff0000u) * wl);
        }
        {
            const int j = mt * 16 + l15; const float mxj = MX[j];
#pragma unroll
            for (int t2 = 0; t2 < 2; ++t2) { const int nt = 2 * hf + t2; f32x4 a = {0.f, 0.f, 0.f, 0.f};
                if (nt <= mt) { bf16x8 xk[8];
#pragma unroll
                    for (int ks = 0; ks < 8; ++ks) xk[ks] = lds_frag(KN, 264, nt * 16, ks * 32, lane);
                    asm volatile("" ::: "memory");
#pragma unroll
                    for (int ks = 0; ks < 8; ++ks) a = MFMA16(xk[ks], qf[ks], a);
                }
                const int i0 = nt * 16 + 4 * q4; const f32x4 av = *(const LAS f32x4*)(AA + i0);
#pragma unroll
                for (int e = 0; e < 4; ++e) a[e] = (i0 + e <= j) ? a[e] * __expf(av[e] - mxj) : 0.f;
                u32x2 pk; pk.x = cvt_pk_bf16(a[0], a[1]); pk.y = cvt_pk_bf16(a[2], a[3]); *(LAS u32x2*)(SMm + j * 72 + i0) = pk; }
        }
        SYNC_LDS();
        {
            const int j = mt * 16 + l15; const float wpj = WP[j];
            f32x4 nm[3]; bf16x8 ys[2];
#pragma unroll
            for (int ks = 0; ks < 2; ++ks) ys[ks] = lds_frag(SMm, 72, mt * 16, ks * 32, lane);
#pragma unroll
            for (int t3 = 0; t3 < 3; ++t3) { const int ct = t3 < 2 ? hf * 2 + t3 : 4; nm[t3] = (f32x4){0.f, 0.f, 0.f, 0.f};
                bf16x8 xc[8], xv[2];
#pragma unroll
                for (int ks = 0; ks < 8; ++ks) xc[ks] = lds_frag(CB, 264, ct * 16, ks * 32, lane);
#pragma unroll
                for (int ks = 0; ks < 2; ++ks) xv[ks] = lds_frag_tr(VRAW, 88, ks * 32, ct * 16, lane);
                asm volatile("" ::: "memory");
#pragma unroll
                for (int ks = 0; ks < 8; ++ks) nm[t3] = MFMA16(xc[ks], qf[ks], nm[t3]);
                nm[t3] = nm[t3] * wpj;
#pragma unroll
                for (int ks = 0; ks < 2; ++ks) nm[t3] = MFMA16(xv[ks], ys[ks], nm[t3]);
            }
            const float den = __shfl(nm[2][0], l15);
            const float dn = fmaxf(fabsf(den), FL[j]), inv = __builtin_amdgcn_rcpf(dn);
            bf16_t* orow = O + (size_t)TOK(j) * 1024 + h * 256 + slice * 64 + 4 * q4;
#pragma unroll
            for (int t3 = 0; t3 < 2; ++t3) { const int ct = hf * 2 + t3;
                const f32x4 hv = nm[t3] * inv; u32x2 pk; pk.x = cvt_pk_bf16(hv[0], hv[1]); pk.y = cvt_pk_bf16(hv[2], hv[3]); *(u32x2*)(orow + ct * 16) = pk; }
        }
        {
            const float dec = SC[0];
            bf16x8 yv[5][2];
#pragma unroll
            for (int ct = 0; ct < 5; ++ct)
#pragma unroll
                for (int ks = 0; ks < 2; ++ks) yv[ct][ks] = lds_frag_tr(VW, 88, ks * 32, ct * 16, lane);
#pragma unroll
            for (int dt = 0; dt < 2; ++dt) { bf16x8 xa[2];
#pragma unroll
                for (int ks = 0; ks < 2; ++ks) xa[ks] = lds_frag_tr(KN, 264, ks * 32, 32 * w + 16 * dt, lane);
#pragma unroll
                for (int ct = 0; ct < 5; ++ct) { S[dt][ct] = S[dt][ct] * dec;
#pragma unroll
                    for (int ks = 0; ks < 2; ++ks) S[dt][ct] = MFMA16(xa[ks], yv[ct][ks], S[dt][ct]);
                    u32x2 pk; pk.x = cvt_pk_bf16(S[dt][ct][0], S[dt][ct][1]); pk.y = cvt_pk_bf16(S[dt][ct][2], S[dt][ct][3]);
                    *(LAS u32x2*)(CBN + (ct * 16 + l15) * 264 + 32 * w + 16 * dt + 4 * q4) = pk; } }
        }
        SYNC_LDS();
#undef TOK
    }
#undef MLSTM_LOADS
#undef TOKC
    if (sq.ctx) {
        float* co = p.out + OUT_MC + sidx * 256 * 256; float* no = p.out + OUT_MN + sidx * 256;
#pragma unroll
        for (int dt = 0; dt < 2; ++dt)
#pragma unroll
            for (int ct = 0; ct < 5; ++ct)
#pragma unroll
                for (int i = 0; i < 4; ++i) { const int dd = 32 * w + 16 * dt + 4 * q4 + i;
                    if (ct < 4) co[(size_t)dd * 256 + slice * 64 + ct * 16 + l15] = S[dt][ct][i];
                    else if (slice == 0 && l15 == 0) no[dd] = S[dt][ct][i]; }
        if (slice == 0 && tid == 0) p.out[OUT_MM + sidx] = SC[1];
    }
    SYNC_LDS();
}

__device__ __forceinline__ void lru_item(const Params& p, int l, const Seq sq, int dir, int nb, LAS unsigned char* lds) {
    LAS bf16_t* XC = (LAS bf16_t*)(lds);
    LAS float*  XF = (LAS float*)(lds + 17408);
    LAS f32x2*  AI = (LAS f32x2*)(lds + 50176);
    LAS f32x2*  SEG = (LAS f32x2*)(lds + 115712);
    const int tid = tidx(), lane = tid & 63, w = tid >> 6, q4 = lane >> 4, l15 = lane & 15;
    const bf16_t* Z = (const bf16_t*)(p.ws + WS_Z);
    bf16_t* O = o_buf(p, dir, 2);
    const int ch = tid & 127, rg = tid >> 7;
    float cw[4];
#pragma unroll
    for (int j = 0; j < 4; ++j) cw[j] = p.in[I_LCW][((size_t)l * 4 + j) * 1024 + nb * 128 + ch];
    const float cb = p.in[I_LCB][l * 1024 + nb * 128 + ch];
    bf16x8 wf[2][4];
#pragma unroll
    for (int gt = 0; gt < 2; ++gt) { const bf16_t* wt = (const bf16_t*)(p.ws + W_LRU) + (size_t)((dir * 2 + gt) * 8 + nb) * 16384 + (size_t)(16 * w + l15) * 128 + q4 * 8;
#pragma unroll
        for (int ks = 0; ks < 4; ++ks) wf[gt][ks] = *(const bf16x8*)(wt + ks * 32); }
    const int jc = nb * 128 + 16 * w + l15;
    const float gb0 = p.in[I_LGB][((size_t)(l * 2 + dir) * 2 + 0) * 1024 + jc], gb1 = p.in[I_LGB][((size_t)(l * 2 + dir) * 2 + 1) * 1024 + jc];
    const float c8 = 8.f * softplus_f(-p.in[I_LLAM][(size_t)(l * 2 + dir) * 1024 + jc]);
    float hst = sq.ctx ? 0.f : p.in[I_SLRU][(((size_t)sq.b * 2 + l) * 2 + dir) * 1024 + jc];
    const int nch = sq.len >> 6;
    LAS bf16_t* XRAW = (LAS bf16_t*)(lds + 50176);
    LAS bf16_t* HO = (LAS bf16_t*)(lds + 67584);
    u32x4 xr_[3];
#define LRU_LOADS(cc_) do { const int t0_ = dir ? sq.len - 64 * ((cc_) + 1) : 64 * (cc_); \
        _Pragma("unroll") for (int i = 0; i < 3; ++i) { const int v_ = tid + 512 * i, row_ = v_ >> 4, c8_ = (v_ & 15) * 8; const int pos = t0_ - 2 + row_; \
            const bool ok_ = row_ < 67 && pos >= 0 && pos < sq.len; const int pc = ok_ ? pos : 0; const unsigned m_ = ok_ ? 0xffffffffu : 0u; \
            u32x4 q_ = *(const u32x4*)(Z + zoff(sq.tl0 + pc, ZC_XR + nb * 128 + c8_)); q_.x &= m_; q_.y &= m_; q_.z &= m_; q_.w &= m_; xr_[i] = q_; } } while (0)
    LRU_LOADS(0);
#define LRU_FLUSH(cc_) do { _Pragma("unroll") for (int i = 0; i < 2; ++i) { const int v_ = tid + 512 * i, r_ = v_ >> 4, c8_ = (v_ & 15) * 8; const int pos_ = dir ? sq.len - 1 - ((cc_) * 64 + r_) : (cc_) * 64 + r_; \
            *(u32x4*)(O + (size_t)(sq.tl0 + pos_) * 1024 + nb * 128 + c8_) = *(const LAS u32x4*)(HO + r_ * 128 + c8_); } } while (0)
    for (int c = 0; c < nch; ++c) {
        if (c > 0) LRU_FLUSH(c - 1);
#pragma unroll
        for (int i = 0; i < 3; ++i) { const int v_ = tid + 512 * i; if (v_ < 68 * 16) *(LAS u32x4*)(XRAW + (v_ >> 4) * 128 + (v_ & 15) * 8) = xr_[i]; }
        if (c + 1 < nch) LRU_LOADS(c + 1);
        SYNC_LDS();
        {
            float xv[19];
#pragma unroll
            for (int i = 0; i < 19; ++i) xv[i] = bf2f(XRAW[(16 * rg + i) * 128 + ch]);
            asm volatile("" ::: "memory");
#pragma unroll
            for (int i = 0; i < 16; ++i) { const float o = cb + cw[0] * xv[i] + cw[1] * xv[i + 1] + cw[2] * xv[i + 2] + cw[3] * xv[i + 3];
                const int tt = 16 * rg + i, r = dir ? 63 - tt : tt; XC[r * 136 + ch] = f2bf(o); XF[r * 128 + ch] = o; }
        }
        SYNC_LDS();
        {
            const int jl = 16 * w + l15;
            bf16x8 xa[4][4];
#pragma unroll
            for (int mt = 0; mt < 4; ++mt)
#pragma unroll
                for (int ks = 0; ks < 4; ++ks) xa[mt][ks] = lds_frag(XC, 136, mt * 16, ks * 32, lane);
#pragma unroll
            for (int mt = 0; mt < 4; ++mt) { f32x4 a0 = {0.f, 0.f, 0.f, 0.f}, a1 = {0.f, 0.f, 0.f, 0.f};
#pragma unroll
                for (int ks = 0; ks < 4; ++ks) { a0 = MFMA16(xa[mt][ks], wf[0][ks], a0); a1 = MFMA16(xa[mt][ks], wf[1][ks], a1); }
                float av[4], bv[4]; float A = 1.f, B = 0.f;
#pragma unroll
                for (int i = 0; i < 4; ++i) { const int r = mt * 16 + 4 * q4 + i;
                    const float rgate = sigmoid_f(a0[i] + gb0), igate = sigmoid_f(a1[i] + gb1);
                    const float la = -c8 * rgate; av[i] = __expf(la); bv[i] = __builtin_amdgcn_sqrtf(fmaxf(1.f - av[i] * av[i], 0.f)) * igate * XF[r * 128 + jl];
                    A *= av[i]; B = av[i] * B + bv[i]; }
                float hin = hst, hall = hst;
#pragma unroll
                for (int k = 0; k < 4; ++k) { const float Ak = __shfl(A, l15 + 16 * k), Bk = __shfl(B, l15 + 16 * k); hall = Ak * hall + Bk; if (k < q4) hin = hall; }
                hst = hall;
#pragma unroll
                for (int i = 0; i < 4; ++i) { const int r = mt * 16 + 4 * q4 + i; hin = av[i] * hin + bv[i];
                    HO[r * 128 + jl] = f2bf(hin); } }
        }
        SYNC_LDS();
    }
    LRU_FLUSH(nch - 1);
#undef LRU_FLUSH
#undef LRU_LOADS
    if (sq.ctx && q4 == 0) p.out[OUT_LRU + (((size_t)sq.b * 2 + l) * 2 + dir) * 1024 + jc] = hst;
    SYNC_LDS();
}

__device__ __forceinline__ int queue_pop(unsigned* ctr, volatile LAS unsigned* slot) {
    __syncthreads();
    if (threadIdx.x == 0) *slot = __hip_atomic_fetch_add(ctr, 1u, __ATOMIC_RELAXED, __HIP_MEMORY_SCOPE_AGENT);
    __syncthreads();
    return (int)*slot;
}
__device__ __forceinline__ void phase_scan(const Params& p, int l, int g, LAS unsigned char* lds) {
    unsigned* ctl = (unsigned*)(p.ws + WS_CTL);
#if DBG_TIMING == 3
#define ITEM_T(k, call) do { const unsigned long long ta_ = __builtin_amdgcn_s_memrealtime(); call; const unsigned long long tb_ = __builtin_amdgcn_s_memrealtime(); if (threadIdx.x == 0) { atomicMax(ctl + CW_DBG + 64 * (60 + (k)), (unsigned)(tb_ - ta_)); atomicAdd(ctl + CW_DBG + 64 * (63 + (k)), (unsigned)(tb_ - ta_)); } } while (0)
#else
#define ITEM_T(k, call) do { call; } while (0)
#endif
    unsigned* q0 = ctl + CW_Q + 64 * ((l * 2 + g) * 3);
    volatile LAS unsigned* slot = (volatile LAS unsigned*)(lds + LDS_MISC + 64);
    const int nlong = 4, nshort = nseq_of(g) - 4;
    const int total = (nlong + nshort) * 64;
    for (;;) {
        int it = queue_pop(q0, slot); if (it >= total) break;
        int sbase = 0, nsq = nlong;
        if (it >= nlong * 64) { it -= nlong * 64; sbase = nlong; nsq = nshort; }
        if (it < nsq * 16) {
            const Seq sq = seq_of(g, seq_index(g, sbase + (it >> 4))); const int sub = it & 15; ITEM_T(2, gla_item(p, l, sq, sub >> 2, (sub >> 1) & 1, sub & 1, lds));
        } else if (it < nsq * 48) { it -= nsq * 16;
            const Seq sq = seq_of(g, seq_index(g, sbase + (it >> 5))); const int sub = it & 31; ITEM_T(1, mlstm_item(p, l, sq, sub >> 3, (sub >> 2) & 1, sub & 3, lds));
        } else { it -= nsq * 48;
            const Seq sq = seq_of(g, seq_index(g, sbase + (it >> 4))); const int sub = it & 15; ITEM_T(0, lru_item(p, l, sq, sub >> 3, sub & 7, lds));
        }
    }
}

__device__ __forceinline__ float half_wave_sum(float v) {
#pragma unroll
    for (int o = 1; o < 32; o <<= 1) v += __shfl_xor(v, o);
    return v;
}
__device__ __forceinline__ void unpack8(const u32x4 q, float (&f)[8]) {
    f[0] = __uint_as_float(q.x << 16); f[1] = __uint_as_float(q.x & 0xffff0000u); f[2] = __uint_as_float(q.y << 16); f[3] = __uint_as_float(q.y & 0xffff0000u);
    f[4] = __uint_as_float(q.z << 16); f[5] = __uint_as_float(q.z & 0xffff0000u); f[6] = __uint_as_float(q.w << 16); f[7] = __uint_as_float(q.w & 0xffff0000u);
}
__device__ __forceinline__ void phase_combine(const Params& p, int l, int g) {
    const int tid_ = tidx(); const int lane = tid_ & 63, wave = tid_ >> 6;
    const int gw = blockIdx.x * 8 + wave, NGW = gridDim.x * 8;
    const bf16_t* Z = (const bf16_t*)(p.ws + WS_Z);
    const int tg = tg_of(g);
    f32x4 gn[2][2][2];
#pragma unroll
    for (int mx = 0; mx < 2; ++mx)
#pragma unroll
        for (int jj = 0; jj < 2; ++jj)
#pragma unroll
            for (int e = 0; e < 2; ++e) gn[mx][jj][e] = *(const f32x4*)(p.in[mx ? I_MNG : I_GNG] + l * 1024 + jj * 512 + lane * 8 + 4 * e);
    for (int tl = gw; tl < tg; tl += NGW) {
        u32x4 va[3][2], vb[3][2], vg[3][2];
#pragma unroll
        for (int mx = 0; mx < 3; ++mx) { const bf16_t* o0 = o_buf(p, 0, mx) + (size_t)tl * 1024; const bf16_t* o1 = o_buf(p, 1, mx) + (size_t)tl * 1024;
            const int gc = (mx == 0 ? ZC_GA : mx == 1 ? ZC_OB : ZC_YR);
#pragma unroll
            for (int jj = 0; jj < 2; ++jj) { const int c = jj * 512 + lane * 8; va[mx][jj] = *(const u32x4*)(o0 + c); vb[mx][jj] = *(const u32x4*)(o1 + c); vg[mx][jj] = *(const u32x4*)(Z + zoff(tl, gc + c)); } }
#pragma unroll
        for (int mx = 0; mx < 3; ++mx) { bf16_t* o0 = o_buf(p, 0, mx) + (size_t)tl * 1024;
#pragma unroll
            for (int jj = 0; jj < 2; ++jj) { const int c = jj * 512 + lane * 8; float a[8], b[8], gt[8], v[8], o[8];
                unpack8(va[mx][jj], a); unpack8(vb[mx][jj], b); unpack8(vg[mx][jj], gt);
#pragma unroll
                for (int e = 0; e < 8; ++e) v[e] = a[e] + b[e];
                if (mx < 2) {
                    float ss = 0.f;
#pragma unroll
                    for (int e = 0; e < 8; ++e) ss += v[e] * v[e];
                    const float rstd = rsqrtf(half_wave_sum(ss) * (1.f / 256.f) + EPS);
                    const f32x4 g0 = gn[mx][jj][0], g1 = gn[mx][jj][1];
#pragma unroll
                    for (int e = 0; e < 8; ++e) o[e] = v[e] * rstd * (e < 4 ? g0[e] : g1[e - 4]) * (mx ? sigmoid_f(gt[e]) : silu_f(gt[e]));
                } else {
#pragma unroll
                    for (int e = 0; e < 8; ++e) o[e] = v[e] * gelu_tanh_f(gt[e]);
                }
                u32x4 wv; wv.x = cvt_pk_bf16(o[0], o[1]); wv.y = cvt_pk_bf16(o[2], o[3]); wv.z = cvt_pk_bf16(o[4], o[5]); wv.w = cvt_pk_bf16(o[6], o[7]); *(u32x4*)(o0 + c) = wv; } }
    }
}

__device__ __forceinline__ void conv_ldcol(u32x4 (&col)[3], const bf16_t* Hc, int line_l0, int rstride, int q, int LL, bool rv0, bool rv2) {
    const bool okc = q >= 0 && q < LL; const int qc = okc ? q : 0; const unsigned mc = okc ? 0xffffffffu : 0u;
    { u32x4 v = *(const u32x4*)(Hc + ((size_t)(line_l0 + qc) << 8)); v.x &= mc; v.y &= mc; v.z &= mc; v.w &= mc; col[1] = v; }
    if (rv0) { u32x4 v = *(const u32x4*)(Hc + ((size_t)(line_l0 - rstride + qc) << 8)); v.x &= mc; v.y &= mc; v.z &= mc; v.w &= mc; col[0] = v; } else col[0] = (u32x4){0u, 0u, 0u, 0u};
    if (rv2) { u32x4 v = *(const u32x4*)(Hc + ((size_t)(line_l0 + rstride + qc) << 8)); v.x &= mc; v.y &= mc; v.z &= mc; v.w &= mc; col[2] = v; } else col[2] = (u32x4){0u, 0u, 0u, 0u};
}
__device__ __forceinline__ void conv_fma(float (&acc)[8], const float (&wk)[8], const u32x4 v) {
    acc[0] += wk[0] * __uint_as_float(v.x << 16); acc[1] += wk[1] * __uint_as_float(v.x & 0xffff0000u);
    acc[2] += wk[2] * __uint_as_float(v.y << 16); acc[3] += wk[3] * __uint_as_float(v.y & 0xffff0000u);
    acc[4] += wk[4] * __uint_as_float(v.z << 16); acc[5] += wk[5] * __uint_as_float(v.z & 0xffff0000u);
    acc[6] += wk[6] * __uint_as_float(v.w << 16); acc[7] += wk[7] * __uint_as_float(v.w & 0xffff0000u);
}
__device__ __forceinline__ void phase_convact(const Params& p, int l, int g) {
    const int tid_ = tidx(); const int lane = tid_ & 63, wave = tid_ >> 6;
    const int gw = blockIdx.x * 8 + wave, NGW = gridDim.x * 8;
    const bf16_t* H = (const bf16_t*)(p.ws + WS_Z); bf16_t* ACT = (bf16_t*)(p.ws + WS_O);
    const float* cwp = p.in[I_FCW] + (size_t)l * 9 * DFF; const float* cbp = p.in[I_FCB] + (size_t)l * DFF;
    const int gctx = gctx_of(g);
    for (int u = gw; u < (tg_of(g) / 32) * 11; u += NGW) {
        const int cc = u % 11, th = u / 11, f0 = cc * 512 + lane * 8;
        const int tl0 = th * 32;
        const bool ctx = tl0 < gctx;
        float wgt[9][8], bias[8];
#pragma unroll
        for (int k = 0; k < 9; ++k) { const f32x4 a = *(const f32x4*)(cwp + (size_t)k * DFF + f0), b = *(const f32x4*)(cwp + (size_t)k * DFF + f0 + 4);
#pragma unroll
            for (int e = 0; e < 4; ++e) { wgt[k][e] = a[e]; wgt[k][4 + e] = b[e]; } }
        { const f32x4 a = *(const f32x4*)(cbp + f0), b = *(const f32x4*)(cbp + f0 + 4);
#pragma unroll
            for (int e = 0; e < 4; ++e) { bias[e] = a[e]; bias[4 + e] = b[e]; } }
        int line_l0, q0, LL, rstride; bool rv0, rv2;
        if (ctx) { line_l0 = (tl0 >> 8) << 8; q0 = tl0 & 255; LL = 256; rstride = 0; rv0 = false; rv2 = false; }
        else { const int lt = tl0 - gctx, pos0 = lt & 4095, ry = pos0 >> 6; line_l0 = gctx + ((lt >> 12) << 12) + ry * 64; q0 = pos0 & 63; LL = 64; rstride = 64; rv0 = ry >= 1; rv2 = ry <= 62; }
        const bf16_t* Hc = H + zoff(0, f0);
        const bf16_t* Hu = H + zoff(0, DFF + f0);
        u32x4 c0[3], c1[3], c2[3], c3[3];
        conv_ldcol(c0, Hc, line_l0, rstride, q0 - 1, LL, rv0, rv2); conv_ldcol(c1, Hc, line_l0, rstride, q0, LL, rv0, rv2);
        conv_ldcol(c2, Hc, line_l0, rstride, q0 + 1, LL, rv0, rv2); conv_ldcol(c3, Hc, line_l0, rstride, q0 + 2, LL, rv0, rv2);
        u32x4 hur[4];
#pragma unroll
        for (int i = 0; i < 4; ++i) hur[i] = *(const u32x4*)(Hu + ((size_t)(tl0 + i) << 8));
#pragma unroll 4
        for (int x = 0; x < 32; ++x) {
            const u32x4 uv = hur[x & 3];
            hur[x & 3] = *(const u32x4*)(Hu + ((size_t)(tl0 + (x + 4 < 32 ? x + 4 : 31)) << 8));
            u32x4 cn[3]; conv_ldcol(cn, Hc, line_l0, rstride, q0 + x + 3, LL, rv0, rv2);
            float acc[8];
#pragma unroll
            for (int e = 0; e < 8; ++e) acc[e] = bias[e];
#pragma unroll
            for (int dy = 0; dy < 3; ++dy) { conv_fma(acc, wgt[dy * 3 + 0], c0[dy]); conv_fma(acc, wgt[dy * 3 + 1], c1[dy]); conv_fma(acc, wgt[dy * 3 + 2], c2[dy]); }
            float hu[8]; hu[0] = __uint_as_float(uv.x << 16); hu[1] = __uint_as_float(uv.x & 0xffff0000u); hu[2] = __uint_as_float(uv.y << 16); hu[3] = __uint_as_float(uv.y & 0xffff0000u);
            hu[4] = __uint_as_float(uv.z << 16); hu[5] = __uint_as_float(uv.z & 0xffff0000u); hu[6] = __uint_as_float(uv.w << 16); hu[7] = __uint_as_float(uv.w & 0xffff0000u);
            float o[8];
#pragma unroll
            for (int e = 0; e < 8; ++e) o[e] = silu_f(acc[e]) * hu[e];
            u32x4 wv; wv.x = cvt_pk_bf16(o[0], o[1]); wv.y = cvt_pk_bf16(o[2], o[3]); wv.z = cvt_pk_bf16(o[4], o[5]); wv.w = cvt_pk_bf16(o[6], o[7]);
            *(u32x4*)(ACT + (size_t)(tl0 + x) * DFF + f0) = wv;
#pragma unroll
            for (int dy = 0; dy < 3; ++dy) { c0[dy] = c1[dy]; c1[dy] = c2[dy]; c2[dy] = c3[dy]; c3[dy] = cn[dy]; }
        }
    }
}


#ifndef SKIPMASK
#define SKIPMASK 0
#endif
#define PH_SEL(bit, ...) { if constexpr (!((SKIPMASK >> (bit)) & 1)) { __VA_ARGS__ } }
#define PH_A(...) PH_SEL(0, __VA_ARGS__)
#define PH_B(...) PH_SEL(1, __VA_ARGS__)
#define PH_C(...) PH_SEL(2, __VA_ARGS__)
#define PH_D(...) PH_SEL(3, __VA_ARGS__)
#define PH_E(...) PH_SEL(4, __VA_ARGS__)
#define PH_G1(...) PH_SEL(5, __VA_ARGS__)
#define PH_G2(...) PH_SEL(6, __VA_ARGS__)
#define PH_G3(...) PH_SEL(7, __VA_ARGS__)
#define PH_G4(...) PH_SEL(8, __VA_ARGS__)
#define PH_G5(...) PH_SEL(9, __VA_ARGS__)
constexpr int N_PHASES = 49;
__global__ void __launch_bounds__(NTHREADS, 2) fwd_kernel(Params p) {
    extern __shared__ __attribute__((aligned(16))) unsigned char lds_raw[];
    LAS unsigned char* lds = (LAS unsigned char*)lds_raw;
    const int tid = threadIdx.x;
    volatile LAS unsigned* MISC = (volatile LAS unsigned*)(lds + LDS_MISC);
    if (tid < 32) MISC[tid] = 0u;
    __syncthreads();
    unsigned* ctl = (unsigned*)(p.ws + WS_CTL);
#if MK_PER_PHASE
#define GRID_BAR() do { } while (0)
#else
    XcdBarrier bar = xcd_barrier_post(ctl + CW_BAR, MISC + 8);
#define GRID_BAR() xcd_barrier(bar)
#endif
    const int lo = p.ph_lo, hi = p.ph_hi;
    const int G = gridDim.x, bx = blockIdx.x;
    const int vcu = (G % 8 == 0) ? (bx % 8) * (G / 8) + bx / 8 : bx;
#define IN(k) (lo <= (k) && (k) < hi)
#if DBG_TIMING
    unsigned long long t_last = __builtin_amdgcn_s_memrealtime(); unsigned t_acc[8] = {0u, 0u, 0u, 0u, 0u, 0u, 0u, 0u};
#define SEAMG(k, grp) do { if (IN(k) && IN((k) + 1)) GRID_BAR(); { const unsigned long long t_now = __builtin_amdgcn_s_memrealtime(); t_acc[grp] += (unsigned)(t_now - t_last); t_last = t_now; } } while (0)
#else
#define SEAMG(k, grp) do { if (IN(k) && IN((k) + 1)) GRID_BAR(); } while (0)
#endif

    if (IN(0)) { if (bx == 0 && tid < 12) ctl[CW_Q + 64 * tid] = 0u;
        PH_A(phase_mod(p, lds); __syncthreads(); phase_wconv(p, 0, lds);) }
    SEAMG(0, 0);
    for (int l = 0; l < 2; ++l) {
        const int base = 1 + 23 * l;
        if (IN(base)) { PH_A(if (l > 0) phase_wconv(p, l, lds);) }
        if (l > 0) SEAMG(base, 0);
        const float* mod_l = (const float*)(p.ws + WS_MOD) + (size_t)l * 9 * 12288;
        for (int g = 0; g < 2; ++g) {
            const int pb = base + 1 + 11 * g, tg = tg_of(g);
            if (IN(pb + 0)) { PH_B(phase_norm(p, l, g, 0, l == 0);) }
            SEAMG(pb + 0, 1);
            if (IN(pb + 1)) {
                pg8::Gemm gm{(const bf16_t*)(p.ws + WS_U), (const bf16_t*)(p.ws + W_IN), tg, NZ1, D}; pg8::StaticOrder S; S.init(tg, NZ1, G, bx);
                pg8::EpiZ E{(bf16_t*)(p.ws + WS_Z), (float*)(p.ws + WS_SM)};
                PH_G1(pg8::gemm_phase<pg8::EpiZ, pg8::StaticOrder, true, true>(lds, gm, S, E);)
            }
            SEAMG(pb + 1, 2);
            if (IN(pb + 2)) { PH_C(phase_scan(p, l, g, lds);) }
            SEAMG(pb + 2, 3);
            if (IN(pb + 4)) {
                pg8::Gemm gm{(const bf16_t*)(p.ws + WS_U8), (const bf16_t*)(p.ws + WS_WMG8), tg, 3 * D, D / 2}; pg8::StaticOrder S; S.init(tg, 3 * D, G, bx);
                pg8::EpiMG E{(bf16_t*)(p.ws + WS_Z), p.in[I_BMG] + (size_t)l * 3 * D, 1.f / 64.f};
                const bool comb_first = (bx & 1) != 0;
                if (comb_first) { PH_D(phase_combine(p, l, g);) }
                PH_G1(pg8::gemm_phase<pg8::EpiMG, pg8::StaticOrder, true, true, true>(lds, gm, S, E);)
                if (!comb_first) { PH_D(phase_combine(p, l, g);) }
            }
            SEAMG(pb + 4, 2);
            if (IN(pb + 5)) {
                pg8::Gemm gm{o_buf(p, 0, 0), (const bf16_t*)(p.ws + W_BR), 3 * TMAX, 3 * D, 1024}; pg8::BranchOrder S{G, vcu, tg / 256};
                pg8::EpiBranch E{(const bf16_t*)(p.ws + WS_Z), (float*)(p.ws + WS_SLAB) + (size_t)bx * 65536, (bf16_t*)(p.ws + WS_U)};
                PH_G2(pg8::gemm_phase<pg8::EpiBranch, pg8::BranchOrder, true, true>(lds, gm, S, E);)
            }
            SEAMG(pb + 5, 5);
            if (IN(pb + 6)) {
                pg8::Gemm gm{(const bf16_t*)(p.ws + WS_U), (const bf16_t*)(p.ws + W_OUT), tg, D, D}; pg8::StaticOrder S; S.init(tg, D, G, bx);
                const float* xc = l == 0 ? p.in[I_XP] : p.out + OUT_X; const float* xl = l == 0 ? p.in[I_XS] - (size_t)NCTX * D : p.out + OUT_X;
                pg8::EpiResid E{xc, xl, (bf16_t*)(p.out + OUT_X), mod_l, 2, g, l == 0 ? 1 : 0};
                PH_G3(pg8::gemm_phase<pg8::EpiResid, pg8::StaticOrder, true, true>(lds, gm, S, E);)
            }
            SEAMG(pb + 6, 5);
            if (IN(pb + 7)) { PH_B(phase_norm(p, l, g, 1, false);) }
            SEAMG(pb + 7, 1);
            if (IN(pb + 8)) {
                pg8::Gemm gm{(const bf16_t*)(p.ws + WS_U), (const bf16_t*)(p.ws + W_UP), tg, NUP, D}; pg8::StaticOrder S; S.init(tg, NUP, G, bx);
                pg8::EpiBf16 E{(bf16_t*)(p.ws + WS_Z), NUP};
                PH_G4(pg8::gemm_phase<pg8::EpiBf16, pg8::StaticOrder, true, true>(lds, gm, S, E);)
            }
            SEAMG(pb + 8, 6);
            if (IN(pb + 9)) { PH_E(phase_convact(p, l, g);) }
            SEAMG(pb + 9, 4);
            if (IN(pb + 10)) {
                pg8::Gemm gm{(const bf16_t*)(p.ws + WS_O), (const bf16_t*)(p.ws + W_DOWN), tg, D, DFF}; pg8::StaticOrder S; S.init(tg, D, G, bx);
                pg8::EpiResid E{nullptr, nullptr, (bf16_t*)(p.out + OUT_X), mod_l, 5, g, 0, p.ws, l == 1 ? 1 : 0};
                PH_G5(pg8::gemm_phase<pg8::EpiResid, pg8::StaticOrder, true, true>(lds, gm, S, E);)
            }
            SEAMG(pb + 10, 6);
        }
    }
    if (IN(48)) { PH_B(phase_final_norm(p);) }
#if DBG_TIMING
    {
        GRID_BAR();
        { const unsigned long long t_now = __builtin_amdgcn_s_memrealtime(); t_acc[1] += (unsigned)(t_now - t_last); }
        if (bx == 0 && tid == 0) { for (int k = 0; k < 7; ++k) ctl[CW_DBG + 64 * (40 + k)] = DBG_TIMING == 3 ? (k < 3 ? ctl[CW_DBG + 64 * (60 + k)] * 10u : k < 6 ? ctl[CW_DBG + 64 * (60 + k)] / 256u : t_acc[3]) : t_acc[k]; }
        GRID_BAR();
        const size_t offs[8] = {OUT_X, OUT_X + (size_t)NCTX * D, OUT_GLA, OUT_MC, OUT_MN, OUT_MM, OUT_LRU, OUT_END};
        for (int k = 0; k < 7; ++k) { int N = 1 + (int)(ctl[CW_DBG + 64 * (40 + k)] / DBG_TUNIT); if (N > (k == 5 ? 500 : 999)) N = (k == 5 ? 500 : 999);
            if (bx == 0) for (int i = tid; i < N; i += NTHREADS) p.out[offs[k] + i] = __uint_as_float(0xAAAAAAAAu); }
    }
#endif
#undef IN
#undef SEAM
}

extern "C" void kernel_launch(void* const* d_in, const int* in_sizes, int n_in, void* d_out, int out_size, void* d_ws, size_t ws_size, hipStream_t stream) {
    static int grid = 0;
    if (grid == 0) {
        if (ws_size < WS_END) { fprintf(stderr, "kernel_launch: unexpected shapes (n_in %d out %d ws %zu)\n", n_in, out_size, ws_size); grid = -1; return; }
        int dev = 0, cus = 0;
        if (hipGetDevice(&dev) != hipSuccess || hipDeviceGetAttribute(&cus, hipDeviceAttributeMultiprocessorCount, dev) != hipSuccess) { grid = -1; return; }
        if (hipFuncSetAttribute((const void*)fwd_kernel, hipFuncAttributeMaxDynamicSharedMemorySize, LDS_BYTES) != hipSuccess) { fprintf(stderr, "kernel_launch: hipFuncSetAttribute failed\n"); grid = -1; return; }
        int per_cu = 0;
        if (hipOccupancyMaxActiveBlocksPerMultiprocessor(&per_cu, (const void*)fwd_kernel, NTHREADS, LDS_BYTES) != hipSuccess || per_cu < 1) { fprintf(stderr, "kernel_launch: occupancy query says %d\n", per_cu); (void)hipGetLastError(); grid = -1; return; }
        grid = cus;
    }
    if (grid < 0) return;
    (void)hipMemsetAsync((char*)d_ws + WS_CTL, 0, CTL_BYTES, stream);
    Params p{};
    for (int i = 0; i < 32; ++i) p.in[i] = (const float*)d_in[i];
    p.out = (float*)d_out; p.ws = (unsigned char*)d_ws;
#if MK_PER_PHASE
    for (int ph = 0; ph < N_PHASES; ++ph) { if (ph == 1) continue; p.ph_lo = ph; p.ph_hi = ph + 1; hipLaunchKernelGGL(fwd_kernel, dim3(grid), dim3(NTHREADS), LDS_BYTES, stream, p); }
#else
    p.ph_lo = 0; p.ph_hi = N_PHASES;
    hipLaunchKernelGGL(fwd_kernel, dim3(grid), dim3(NTHREADS), LDS_BYTES, stream, p);
#endif
}
```

```cpp
#include <hip/hip_runtime.h>
#include <cstdio>
#include <cstdint>

#ifndef MK_PER_PHASE
#define MK_PER_PHASE 0
#endif

#ifndef DBG_DIR
#define DBG_DIR 0
#endif
#ifndef DBG_CHUNK
#define DBG_CHUNK 0
#endif
#ifndef DBG_CHECKS
#define DBG_CHECKS 0
#endif
#ifndef DBG_TIMING
#define DBG_TIMING 0
#endif
#ifndef DBG_TUNIT
#define DBG_TUNIT 10000u
#endif
#ifndef DBG_MASK
#define DBG_MASK 1
#endif
#ifndef DBG_STATIC_Q
#define DBG_STATIC_Q 0
#endif
#define LAS __attribute__((address_space(3)))
typedef unsigned short bf16_t;
typedef short bf16x8 __attribute__((ext_vector_type(8)));
typedef float f32x4 __attribute__((ext_vector_type(4)));
typedef float f32x2 __attribute__((ext_vector_type(2)));
typedef unsigned u32x4 __attribute__((ext_vector_type(4)));
typedef unsigned u32x2 __attribute__((ext_vector_type(2)));

constexpr int D = 2048, NCTX = 8192, NTOK = 40960, TMAX = 24576;
__host__ __device__ __forceinline__ int tg_of(int g) { return g == 0 ? 24576 : 16384; }
__host__ __device__ __forceinline__ int gctx_of(int g) { return g == 0 ? NCTX : 0; }
__host__ __device__ __forceinline__ int glob_tok(int g, int tl) { return g * TMAX + tl; }
__host__ __device__ __forceinline__ size_t zoff(int t, int c) { return ((size_t)((c >> 8) * TMAX + t) << 8) + (size_t)(c & 255); }
__host__ __device__ __forceinline__ size_t xfin_off(int t);
__host__ __device__ __forceinline__ size_t goff8(int t, int c) { return (size_t)(c >> 8) * TMAX * 512 + ((size_t)t << 8) + (size_t)(c & 255); }
constexpr int ZLD = 11264, NZ1 = 9472, NZ = 15616, DFF = 5632, NUP = 11264;
constexpr int NTHREADS = 512;
constexpr float EPS = 1e-6f;

constexpr size_t MiB = 1u << 20;
constexpr size_t WS_CTL = 0, CTL_BYTES = 1 * MiB;
constexpr size_t WS_MOD = 1 * MiB;
constexpr size_t WS_W = 2 * MiB;
constexpr size_t W_IN = WS_W;
constexpr size_t W_BR = W_IN + (size_t)NZ * D * 2;
constexpr size_t W_OUT = W_BR + (size_t)3 * D * 1024 * 2;
constexpr size_t W_UP = W_OUT + (size_t)D * D * 2;
constexpr size_t W_DOWN = W_UP + (size_t)NUP * D * 2;
constexpr size_t W_LRU = W_DOWN + (size_t)D * DFF * 2;
constexpr size_t W_END = W_LRU + (size_t)32 * 128 * 128 * 2;
static_assert(W_END == 150 * MiB, "weight block");
constexpr size_t WS_U = 150 * MiB;
constexpr size_t WS_SM = 246 * MiB;
constexpr size_t WS_Z = 252 * MiB;
constexpr size_t WS_O = 780 * MiB;
constexpr size_t WS_SLAB = WS_O + 144 * MiB;
constexpr size_t WS_U8 = 1068 * MiB;
constexpr size_t WS_WMG8 = 1116 * MiB;
constexpr size_t WS_END = 1128 * MiB;
__host__ __device__ __forceinline__ size_t xfin_off(int t) {
    return t < TMAX ? WS_Z + ((((size_t)(t >> 10) * TMAX + 16384) << 9) + ((size_t)(t & 1023) << 12)) : WS_U + ((size_t)(t - TMAX) << 12);
}
constexpr size_t WS_DBG = 1076 * MiB;
constexpr int CW_BAR = 4096;
constexpr int CW_DBG = 32768;
constexpr int CW_Q = 16384;

constexpr int ZC_QA = 0, ZC_KA = 512, ZC_VA = 1024, ZC_QB = 2048, ZC_KB = 3072, ZC_VB = 4096, ZC_XR = 5120, ZC_GA = 6144, ZC_OB = 7168, ZC_YR = 8192;

constexpr int LDS_BYTES = 155648;
constexpr int LDS_MISC = 153600;

struct Params {
    const float* in[32];
    float* out;
    unsigned char* ws;
    int ph_lo, ph_hi;
};

__device__ __forceinline__ float bf2f(unsigned short h) { return __uint_as_float(((unsigned)h) << 16); }
__device__ __forceinline__ unsigned short f2bf(float f) { return __builtin_bit_cast(unsigned short, (__bf16)f); }
typedef __bf16 bf16x2_t __attribute__((ext_vector_type(2)));
__device__ __forceinline__ unsigned cvt_pk_bf16(float lo, float hi) { const f32x2 f = {lo, hi}; const bf16x2_t v = __builtin_convertvector(f, bf16x2_t); return __builtin_bit_cast(unsigned, v); }
__device__ __forceinline__ float sigmoid_f(float x) { return __builtin_amdgcn_rcpf(1.f + __expf(-x)); }
__device__ __forceinline__ float silu_f(float x) { return x * sigmoid_f(x); }
__device__ __forceinline__ float logsigmoid_f(float x) { return fminf(x, 0.f) - log1pf(__expf(-fabsf(x))); }
__device__ __forceinline__ float logsigmoid_fast(float x) { return fminf(x, 0.f) - __logf(1.f + __expf(-fabsf(x))); }
__device__ __forceinline__ float softplus_f(float x) { return fmaxf(x, 0.f) + log1pf(__expf(-fabsf(x))); }
__device__ __forceinline__ float gelu_tanh_f(float x) { const float u = 0.7978845608028654f * (x + 0.044715f * x * x * x); const float t = 1.f - 2.f * __builtin_amdgcn_rcpf(1.f + __expf(2.f * u)); return 0.5f * x * (1.f + t); }
__device__ __forceinline__ float wave_sum(float v) {
#pragma unroll
    for (int o = 1; o < 64; o <<= 1) v += __shfl_xor(v, o);
    return v;
}
__device__ __forceinline__ int tidx() { int t = threadIdx.x; asm volatile("" : "+v"(t)); return t; }
#define DPP_F(old_, src_, ctrl_, rmask_) __uint_as_float((unsigned)__builtin_amdgcn_update_dpp((int)__float_as_uint(old_), (int)__float_as_uint(src_), ctrl_, rmask_, 0xf, false))
__device__ __forceinline__ float wave_scan_add(float v) {
    v += DPP_F(0.f, v, 0x111, 0xf); v += DPP_F(0.f, v, 0x112, 0xf); v += DPP_F(0.f, v, 0x114, 0xf); v += DPP_F(0.f, v, 0x118, 0xf);
    v += DPP_F(0.f, v, 0x142, 0xa); v += DPP_F(0.f, v, 0x143, 0xc);
    return v;
}
__device__ __forceinline__ float wave_scan_max(float v) {
    const float ninf = -__builtin_inff();
    v = fmaxf(v, DPP_F(ninf, v, 0x111, 0xf)); v = fmaxf(v, DPP_F(ninf, v, 0x112, 0xf)); v = fmaxf(v, DPP_F(ninf, v, 0x114, 0xf)); v = fmaxf(v, DPP_F(ninf, v, 0x118, 0xf));
    v = fmaxf(v, DPP_F(ninf, v, 0x142, 0xa)); v = fmaxf(v, DPP_F(ninf, v, 0x143, 0xc));
    return v;
}
#define LDS_WAIT() asm volatile("s_waitcnt lgkmcnt(0)" ::: "memory")
#define VM_WAIT() asm volatile("s_waitcnt vmcnt(0)" ::: "memory")
#define SYNC_LDS() do { asm volatile("s_waitcnt lgkmcnt(0)" ::: "memory"); __builtin_amdgcn_s_barrier(); asm volatile("" ::: "memory"); } while (0)

namespace pg8 {
constexpr int BM = 256, BK = 64, HALF = 128, HTB = HALF * BK * 2, STAGE_BYTES = 8 * HTB, NXCD = 8, WGM = 8;
__host__ __device__ __forceinline__ int lds_byte(int r, int c) { const int st = (r >> 4) * 2 + (c >> 5), rr = r & 15, cc = c & 31, ob = rr * 64 + cc * 2; return st * 1024 + (ob ^ (((ob >> 9) & 1) << 5)); }
__host__ __device__ __forceinline__ void stage_rc(int b, int& R, int& C) { const int st = b / 1024, sb = b % 1024, swz = sb ^ (((sb >> 9) & 1) << 5); R = (st >> 1) * 16 + swz / 64; C = (st & 1) * 32 + (swz % 64) / 2; }
__host__ __device__ __forceinline__ int perm32(int rho) { const int n = rho >> 4, i = rho & 15; return 8 * (i >> 2) + 4 * n + (i & 3); }
struct Unit { int pm, pn; };
struct Gemm { const bf16_t* A; const bf16_t* Bt; int M, N, K; };
struct StaticOrder {
    int nM, nN, nwg, G, c;
    __device__ void init(int M, int N, int G_, int c_) { nM = M / BM; nN = N / BM; nwg = nM * nN; G = G_; c = c_; }
    __device__ bool next(int i, Unit& u) const {
        const long L = (long)i * G + c; if (L >= nwg) return false;
        int wgid = (int)L; { const int q = nwg / NXCD, r = nwg % NXCD, xcd = wgid % NXCD, off = wgid / NXCD; wgid = (xcd < r ? xcd * (q + 1) : r * (q + 1) + (xcd - r) * q) + off; }
        const int nig = WGM * nN, gid = wgid / nig, fm = gid * WGM, gsz = (nM - fm) < WGM ? (nM - fm) : WGM;
        u.pm = fm + ((wgid % nig) % gsz); u.pn = (wgid % nig) / gsz; return true;
    }
};
struct BranchOrder {
    int G, c, np;
    __device__ bool next(int i, Unit& u) const {
        const int L = (i / 3) * G + c, n = i % 3; if (L >= np * 8) return false;
        u.pm = n * (TMAX / 256) + (L >> 3); u.pn = n * 8 + (L & 7); return true;
    }
};

typedef int i32x4_t __attribute__((ext_vector_type(4)));
typedef int i32x8_t __attribute__((ext_vector_type(8)));
__device__ __forceinline__ i32x8_t cat16(const bf16x8 lo, const bf16x8 hi) { return __builtin_shufflevector(__builtin_bit_cast(i32x4_t, lo), __builtin_bit_cast(i32x4_t, hi), 0, 1, 2, 3, 4, 5, 6, 7); }
__device__ __forceinline__ void mfma_f8_acc(f32x4& c, const i32x8_t a, const i32x8_t b) { asm volatile("v_mfma_f32_16x16x128_f8f6f4 %0, %1, %2, %0" : "+v"(c) : "v"(a), "v"(b)); }
#define F8_DRAIN() asm volatile("s_nop 15\n\ts_nop 15" ::: "memory")
template <class Epi, class Sched, bool ALIGN_EPI, bool SP2, bool F8 = false>
__device__ __forceinline__ void gemm_phase(LAS unsigned char* lds, const Gemm g, const Sched& S, const Epi& E) {
    const int tid = tidx(), wid = __builtin_amdgcn_readfirstlane(tid >> 6), lane = tid & 63, wr = wid >> 2, wc = wid & 3, fr = lane & 15, fq = lane >> 4;
    static_assert(!F8 || SP2, "the fp8 body is written for the two-group schedule");
    const int K = g.K, nt = K / BK;
    unsigned voffA[2], voffB[2];
#pragma unroll
    for (int i = 0; i < 2; ++i) { int R, C; stage_rc(tid * 16 + i * 8192, R, C); const int Rb = Epi::PERM ? ((R & ~31) + perm32(R & 31)) : R;
        voffA[i] = (unsigned)(R * K + C) * 2u; voffB[i] = (unsigned)(Rb * K + C) * 2u; }
    const size_t kstep = (size_t)(BK * 2);
    const size_t hstep = (size_t)HALF * K * 2;
    const size_t tstep = 2 * hstep;
    const unsigned ldsw = (unsigned)wid * 1024u;
    const int aoff = lds_byte(wr * 64 + fr, fq * 8), boff = lds_byte(wc * 32 + fr, fq * 8);
#define PG8_SA(b, h) (((b) * 2 + (h)) * HTB)
#define PG8_SB(b, h) ((4 + (b) * 2 + (h)) * HTB)
#define PG8_STAGE(bufoff, gbase, voff) do { _Pragma("unroll") for (int _i = 0; _i < 2; ++_i) \
        __builtin_amdgcn_global_load_lds((const unsigned*)((const char*)(gbase) + (voff)[_i]), (LAS unsigned*)(lds + (bufoff) + ldsw + _i * 8192), 16, 0, 0); } while (0)
#define PG8_LDA(dst, b, h) do { _Pragma("unroll") for (int m = 0; m < (F8 ? 2 : 4); ++m) _Pragma("unroll") for (int k = 0; k < 2; ++k) dst[m][k] = *(const LAS bf16x8*)(lds + PG8_SA(b, h) + aoff + m * 2048 + k * 1024); } while (0)
#define PG8_LDB(dst, b, h) do { _Pragma("unroll") for (int n = 0; n < 2; ++n) _Pragma("unroll") for (int k = 0; k < 2; ++k) dst[n][k] = *(const LAS bf16x8*)(lds + PG8_SB(b, h) + boff + n * 2048 + k * 1024); } while (0)
#define PG8_MMA(ai, bj, At, Bt) do { __builtin_amdgcn_s_setprio(1); \
        _Pragma("unroll") for (int m = 0; m < 4; ++m) _Pragma("unroll") for (int n = 0; n < 2; ++n) _Pragma("unroll") for (int k = 0; k < 2; ++k) \
            acc[ai][bj][m][n] = __builtin_amdgcn_mfma_f32_16x16x32_bf16(Bt[n][k], At[m][k], acc[ai][bj][m][n], 0, 0, 0); \
        __builtin_amdgcn_s_setprio(0); } while (0)
#define PG8_F8ROW(ai, m, s) do { _Pragma("unroll") for (int bj = 0; bj < 2; ++bj) _Pragma("unroll") for (int n = 0; n < 2; ++n) \
        mfma_f8_acc(acc[ai][bj][m][n], cat16(bj ? B1[n][0] : B0[n][0], bj ? B1[n][1] : B0[n][1]), cat16(At[s][0], At[s][1])); } while (0)
#define PG8_F8LD(s, m, b, h) do { _Pragma("unroll") for (int k = 0; k < 2; ++k) At[s][k] = *(const LAS bf16x8*)(lds + PG8_SA(b, h) + aoff + (m) * 2048 + k * 1024); } while (0)
#define PG8_MM2(ai, b, h) do { if constexpr (F8) { __builtin_amdgcn_s_setprio(1); \
        PG8_F8ROW(ai, 0, 0); PG8_SCHED; PG8_F8LD(0, 2, b, h); PG8_SCHED; PG8_F8ROW(ai, 1, 1); PG8_SCHED; PG8_F8LD(1, 3, b, h); PG8_SCHED; PG8_WAIT_L(2); PG8_F8ROW(ai, 2, 0); PG8_SCHED; PG8_WAIT_L(0); PG8_F8ROW(ai, 3, 1); \
        __builtin_amdgcn_s_setprio(0); } else { PG8_MMA(ai, 0, At, B0); PG8_MMA(ai, 1, At, B1); } } while (0)
#define PG8_WAIT_V(n) asm volatile("s_waitcnt vmcnt(" #n ")" ::: "memory")
#define PG8_WAIT_L(n) asm volatile("s_waitcnt lgkmcnt(" #n ")" ::: "memory")
#define PG8_BAR __builtin_amdgcn_s_barrier()
#define PG8_SCHED __builtin_amdgcn_sched_barrier(0)
    Unit cur, nxt; int ui = 0;
    if (!S.next(0, cur)) return;
    f32x4 acc[2][2][4][2];
#pragma unroll
    for (int a = 0; a < 2; ++a)
#pragma unroll
        for (int b = 0; b < 2; ++b)
#pragma unroll
            for (int m = 0; m < 4; ++m)
#pragma unroll
                for (int n = 0; n < 2; ++n) acc[a][b][m][n] = (f32x4){0.f, 0.f, 0.f, 0.f};
    bf16x8 At[4][2], B0[2][2], B1[2][2];
    const char* cA = (const char*)g.A + (size_t)cur.pm * tstep; const char* cB = (const char*)g.Bt + (size_t)cur.pn * tstep;
    if constexpr (SP2) {
        PG8_STAGE(PG8_SB(0, 0), cB, voffB); PG8_STAGE(PG8_SB(0, 1), cB + hstep, voffB); PG8_STAGE(PG8_SA(0, 0), cA, voffA); PG8_STAGE(PG8_SA(0, 1), cA + hstep, voffA);
        if (wr == 1) PG8_BAR;
        PG8_WAIT_V(2); PG8_BAR;
        PG8_STAGE(PG8_SB(1, 0), cB + kstep, voffB); PG8_STAGE(PG8_SA(1, 0), cA + kstep, voffA); PG8_STAGE(PG8_SB(1, 1), cB + hstep + kstep, voffB);
        PG8_WAIT_V(6); PG8_BAR;
    } else {
        PG8_STAGE(PG8_SB(0, 0), cB, voffB); PG8_STAGE(PG8_SA(0, 0), cA, voffA); PG8_STAGE(PG8_SB(0, 1), cB + hstep, voffB); PG8_STAGE(PG8_SA(0, 1), cA + hstep, voffA);
        if (wr == 1) PG8_BAR;
        PG8_WAIT_V(4); PG8_BAR;
        PG8_STAGE(PG8_SB(1, 0), cB + kstep, voffB); PG8_STAGE(PG8_SA(1, 0), cA + kstep, voffA); PG8_STAGE(PG8_SB(1, 1), cB + hstep + kstep, voffB);
        PG8_WAIT_V(6); PG8_BAR;
    }
    for (;;) {
        const bool has_next = S.next(ui + 1, nxt);
        const char* nA = has_next ? (const char*)g.A + (size_t)nxt.pm * tstep : cA; const char* nB = has_next ? (const char*)g.Bt + (size_t)nxt.pn * tstep : cB;
        for (int t = 0; t < nt; t += 2) {
            const bool last = (t == nt - 2);
            const char* a1 = cA + (size_t)(t + 1) * kstep;
            const char* a2 = last ? nA : cA + (size_t)(t + 2) * kstep; const char* b2 = last ? nB : cB + (size_t)(t + 2) * kstep;
            const char* a3 = a2 + kstep; const char* b3 = b2 + kstep;
            if constexpr (SP2) {
            PG8_LDB(B0, 0, 0); PG8_LDB(B1, 0, 1); PG8_SCHED; PG8_LDA(At, 0, 0); PG8_STAGE(PG8_SA(1, 1), a1 + hstep, voffA);
            PG8_WAIT_V(8); PG8_WAIT_L(0); PG8_BAR; PG8_MM2(0, 0, 0); PG8_BAR; PG8_SCHED;
            PG8_LDA(At, 0, 1); PG8_STAGE(PG8_SB(0, 0), b2, voffB); PG8_STAGE(PG8_SB(0, 1), b2 + hstep, voffB); PG8_STAGE(PG8_SA(0, 0), a2, voffA);
            PG8_WAIT_V(8); PG8_WAIT_L(0); PG8_BAR; PG8_MM2(1, 0, 1); PG8_BAR; PG8_SCHED;
            PG8_LDB(B0, 1, 0); PG8_LDB(B1, 1, 1); PG8_SCHED; PG8_LDA(At, 1, 0); PG8_STAGE(PG8_SA(0, 1), a2 + hstep, voffA);
            PG8_WAIT_V(8); PG8_WAIT_L(0); PG8_BAR; PG8_MM2(0, 1, 0); PG8_BAR; PG8_SCHED;
            PG8_LDA(At, 1, 1); PG8_STAGE(PG8_SB(1, 0), b3, voffB); PG8_STAGE(PG8_SB(1, 1), b3 + hstep, voffB); PG8_STAGE(PG8_SA(1, 0), a3, voffA);
            PG8_WAIT_V(8); PG8_WAIT_L(0); PG8_BAR; PG8_MM2(1, 1, 1); PG8_BAR; PG8_SCHED;
            } else {
            PG8_LDB(B0, 0, 0); PG8_SCHED; PG8_LDA(At, 0, 0); PG8_STAGE(PG8_SA(1, 1), a1 + hstep, voffA);
            PG8_WAIT_L(8); PG8_BAR; PG8_WAIT_L(0); PG8_MMA(0, 0, At, B0); PG8_BAR; PG8_SCHED;
            PG8_LDB(B1, 0, 1); PG8_STAGE(PG8_SB(0, 0), b2, voffB);
            PG8_BAR; PG8_WAIT_L(0); PG8_MMA(0, 1, At, B1); PG8_BAR;
            PG8_LDA(At, 0, 1); PG8_STAGE(PG8_SA(0, 0), a2, voffA);
            PG8_BAR; PG8_WAIT_L(0); PG8_MMA(1, 0, At, B0); PG8_BAR; PG8_SCHED;
            PG8_STAGE(PG8_SB(0, 1), b2 + hstep, voffB);
            PG8_WAIT_V(6); PG8_BAR; PG8_MMA(1, 1, At, B1); PG8_BAR;
            PG8_LDB(B0, 1, 0); PG8_SCHED; PG8_LDA(At, 1, 0); PG8_STAGE(PG8_SA(0, 1), a2 + hstep, voffA);
            PG8_WAIT_L(8); PG8_BAR; PG8_WAIT_L(0); PG8_MMA(0, 0, At, B0); PG8_BAR; PG8_SCHED;
            PG8_LDB(B1, 1, 1); PG8_STAGE(PG8_SB(1, 0), b3, voffB);
            PG8_BAR; PG8_WAIT_L(0); PG8_MMA(0, 1, At, B1); PG8_BAR;
            PG8_LDA(At, 1, 1); PG8_STAGE(PG8_SA(1, 0), a3, voffA);
            PG8_BAR; PG8_WAIT_L(0); PG8_MMA(1, 0, At, B0); PG8_BAR; PG8_SCHED;
            PG8_STAGE(PG8_SB(1, 1), b3 + hstep, voffB);
            PG8_WAIT_V(6); PG8_BAR; PG8_MMA(1, 1, At, B1); PG8_BAR;
            }
        }
        if constexpr (ALIGN_EPI) { if (wr == 0) PG8_BAR; }
        if constexpr (F8) F8_DRAIN();
        E(acc, cur, wr, wc, fr, fq);
        if (!has_next) break;
#pragma unroll
        for (int a = 0; a < 2; ++a)
#pragma unroll
            for (int b = 0; b < 2; ++b)
#pragma unroll
                for (int m = 0; m < 4; ++m)
#pragma unroll
                    for (int n = 0; n < 2; ++n) acc[a][b][m][n] = (f32x4){0.f, 0.f, 0.f, 0.f};
        cur = nxt; cA = nA; cB = nB; ++ui;
        if constexpr (ALIGN_EPI) { if (wr == 1) PG8_BAR; }
    }
    PG8_WAIT_V(0);
    if constexpr (!ALIGN_EPI) { if (wr == 0) PG8_BAR; }
    PG8_BAR;
#undef PG8_SA
#undef PG8_SB
#undef PG8_STAGE
#undef PG8_LDA
#undef PG8_LDB
#undef PG8_MMA
#undef PG8_F8ROW
#undef PG8_F8LD
#undef PG8_MM2
#undef PG8_WAIT_V
#undef PG8_WAIT_L
#undef PG8_BAR
#undef PG8_SCHED
}


struct EpiZ {
    static constexpr bool PERM = true;
    bf16_t* Z; float* SM;
    __device__ __forceinline__ void operator()(const f32x4 (&acc)[2][2][4][2], const Unit& u, int wr, int wc, int fr, int fq) const {
        const int row0 = u.pm * BM + wr * 64 + fr;
        if (u.pn < 36) {
            const int col0 = u.pn * BM + wc * 32 + 8 * fq;
#pragma unroll
            for (int ai = 0; ai < 2; ++ai)
#pragma unroll
                for (int m = 0; m < 4; ++m) { bf16_t* rowp = Z + zoff(row0 + ai * HALF + m * 16, col0);
#pragma unroll
                    for (int bj = 0; bj < 2; ++bj) { const f32x4 v0 = acc[ai][bj][m][0], v1 = acc[ai][bj][m][1];
                        u32x4 w; w.x = cvt_pk_bf16(v0[0], v0[1]); w.y = cvt_pk_bf16(v0[2], v0[3]); w.z = cvt_pk_bf16(v1[0], v1[1]); w.w = cvt_pk_bf16(v1[2], v1[3]);
                        *(u32x4*)(rowp + bj * HALF) = w; } }
        } else {
            const int lc = wc * 32 + 8 * fq;
            if (lc < 48) {
#pragma unroll
                for (int ai = 0; ai < 2; ++ai)
#pragma unroll
                    for (int m = 0; m < 4; ++m) { float* rowp = SM + (size_t)(row0 + ai * HALF + m * 16) * 64 + lc;
                        *(f32x4*)(rowp) = acc[ai][0][m][0]; *(f32x4*)(rowp + 4) = acc[ai][0][m][1]; }
            }
        }
    }
};
struct EpiMG {
    static constexpr bool PERM = true;
    bf16_t* Z; const float* b_merge; float wscale;
    __device__ __forceinline__ void operator()(const f32x4 (&acc)[2][2][4][2], const Unit& u, int wr, int wc, int fr, int fq) const {
        const int row0 = u.pm * BM + wr * 64 + fr, col0 = u.pn * BM + wc * 32 + 8 * fq;
        unsigned char* Zg = (unsigned char*)Z;
#pragma unroll
        for (int bj = 0; bj < 2; ++bj) {
            const f32x4 b0 = *(const f32x4*)(b_merge + col0 + bj * HALF), b1 = *(const f32x4*)(b_merge + col0 + bj * HALF + 4);
#pragma unroll
            for (int ai = 0; ai < 2; ++ai)
#pragma unroll
                for (int m = 0; m < 4; ++m) { unsigned char* rowp = Zg + goff8(row0 + ai * HALF + m * 16, col0);
                    f32x4 v0 = acc[ai][bj][m][0] * wscale + b0, v1 = acc[ai][bj][m][1] * wscale + b1;
                    unsigned q0[4], q1[4];
#pragma unroll
                    for (int e = 0; e < 4; ++e) { q0[e] = __float_as_uint(__builtin_fmaf(sigmoid_f(v0[e]), 255.f, 8388608.f)); q1[e] = __float_as_uint(__builtin_fmaf(sigmoid_f(v1[e]), 255.f, 8388608.f)); }
                    u32x2 w;
                    w.x = __builtin_amdgcn_perm(q0[1], q0[0], 0x0c0c0400u) | __builtin_amdgcn_perm(q0[3], q0[2], 0x04000c0cu);
                    w.y = __builtin_amdgcn_perm(q1[1], q1[0], 0x0c0c0400u) | __builtin_amdgcn_perm(q1[3], q1[2], 0x04000c0cu);
                    *(u32x2*)(rowp + bj * HALF) = w; }
        }
    }
};
struct EpiBranch {
    static constexpr bool PERM = true;
    const bf16_t* Z; float* slab; bf16_t* MG;
    __device__ __forceinline__ void operator()(const f32x4 (&acc)[2][2][4][2], const Unit& u, int wr, int wc, int fr, int fq) const {
        const int n = u.pn >> 3, pm = u.pm - n * (TMAX / 256), pn = u.pn & 7;
        const int row0 = pm * BM + wr * 64 + fr, col0 = pn * BM + wc * 32 + 8 * fq;
#pragma unroll
        for (int ai = 0; ai < 2; ++ai)
#pragma unroll
            for (int m = 0; m < 4; ++m) { const int row = row0 + ai * HALF + m * 16;
                u32x2 gw[2]; u32x4 pv[2];
#pragma unroll
                for (int bj = 0; bj < 2; ++bj) { gw[bj] = *(const u32x2*)((const unsigned char*)Z + goff8(row, n * D + col0) + bj * HALF);
                    if (n > 0) pv[bj] = *(const u32x4*)(MG + (size_t)row * D + col0 + bj * HALF); }
#pragma unroll
                for (int bj = 0; bj < 2; ++bj) { const u32x2 g = gw[bj]; const float k255 = 1.f / 255.f;
                    f32x4 v0 = acc[ai][bj][m][0] * k255, v1 = acc[ai][bj][m][1] * k255;
                    v0[0] *= (float)(g.x & 0xffu); v0[1] *= (float)((g.x >> 8) & 0xffu); v0[2] *= (float)((g.x >> 16) & 0xffu); v0[3] *= (float)((g.x >> 24) & 0xffu);
                    v1[0] *= (float)(g.y & 0xffu); v1[1] *= (float)((g.y >> 8) & 0xffu); v1[2] *= (float)((g.y >> 16) & 0xffu); v1[3] *= (float)((g.y >> 24) & 0xffu);
                    if (n > 0) { const u32x4 q = pv[bj];
                        v0[0] += __uint_as_float(q.x << 16); v0[1] += __uint_as_float(q.x & 0xffff0000u); v0[2] += __uint_as_float(q.y << 16); v0[3] += __uint_as_float(q.y & 0xffff0000u);
                        v1[0] += __uint_as_float(q.z << 16); v1[1] += __uint_as_float(q.z & 0xffff0000u); v1[2] += __uint_as_float(q.w << 16); v1[3] += __uint_as_float(q.w & 0xffff0000u); }
                    u32x4 w; w.x = cvt_pk_bf16(v0[0], v0[1]); w.y = cvt_pk_bf16(v0[2], v0[3]); w.z = cvt_pk_bf16(v1[0], v1[1]); w.w = cvt_pk_bf16(v1[2], v1[3]);
                    *(u32x4*)(MG + (size_t)row * D + col0 + bj * HALF) = w; }
            }
    }
};
struct EpiResid {
    static constexpr bool PERM = true;
    const float* xin_ctx; const float* xin_lat; bf16_t* XB; const float* mod_l; int gidx; int grp; int in_f32;
    unsigned char* wsb = nullptr; int fin = 0;
    __device__ __forceinline__ void operator()(const f32x4 (&acc)[2][2][4][2], const Unit& u, int wr, int wc, int fr, int fq) const {
        const int t0 = glob_tok(grp, u.pm * BM);
        const int cond = t0 < NCTX ? 8 : (t0 - NCTX) >> 12;
        const float* xin = t0 < NCTX ? xin_ctx : xin_lat;
        const float* gate = mod_l + (size_t)cond * 12288 + gidx * D;
        const int row0 = t0 + wr * 64 + fr, col0 = u.pn * BM + wc * 32 + 8 * fq;
        bf16_t* XO = fin ? (bf16_t*)((uintptr_t)wsb + xfin_off(t0) - (size_t)t0 * D * 2) : XB;
        f32x4 gv[2][2];
#pragma unroll
        for (int bj = 0; bj < 2; ++bj)
#pragma unroll
            for (int n = 0; n < 2; ++n) gv[bj][n] = *(const f32x4*)(gate + col0 + bj * HALF + 4 * n);
#pragma unroll
        for (int ai = 0; ai < 2; ++ai)
#pragma unroll
            for (int m = 0; m < 4; ++m) { const size_t off = (size_t)(row0 + ai * HALF + m * 16) * D + col0;
#pragma unroll
                for (int bj = 0; bj < 2; ++bj) { f32x4 x0, x1;
                    if (in_f32) { x0 = *(const f32x4*)(xin + off + bj * HALF); x1 = *(const f32x4*)(xin + off + bj * HALF + 4); }
                    else { const u32x4 q = *(const u32x4*)(XB + off + bj * HALF);
                        x0[0] = __uint_as_float(q.x << 16); x0[1] = __uint_as_float(q.x & 0xffff0000u); x0[2] = __uint_as_float(q.y << 16); x0[3] = __uint_as_float(q.y & 0xffff0000u);
                        x1[0] = __uint_as_float(q.z << 16); x1[1] = __uint_as_float(q.z & 0xffff0000u); x1[2] = __uint_as_float(q.w << 16); x1[3] = __uint_as_float(q.w & 0xffff0000u); }
                    x0 += gv[bj][0] * acc[ai][bj][m][0]; x1 += gv[bj][1] * acc[ai][bj][m][1];
                    u32x4 w; w.x = cvt_pk_bf16(x0[0], x0[1]); w.y = cvt_pk_bf16(x0[2], x0[3]); w.z = cvt_pk_bf16(x1[0], x1[1]); w.w = cvt_pk_bf16(x1[2], x1[3]);
                    *(u32x4*)(XO + off + bj * HALF) = w; } }
    }
};
struct EpiBf16 {
    static constexpr bool PERM = true;
    bf16_t* O; int ldc;
    __device__ __forceinline__ void operator()(const f32x4 (&acc)[2][2][4][2], const Unit& u, int wr, int wc, int fr, int fq) const {
        const int row0 = u.pm * BM + wr * 64 + fr, col0 = u.pn * BM + wc * 32 + 8 * fq;
#pragma unroll
        for (int ai = 0; ai < 2; ++ai)
#pragma unroll
            for (int m = 0; m < 4; ++m) { bf16_t* rowp = O + zoff(row0 + ai * HALF + m * 16, col0);
#pragma unroll
                for (int bj = 0; bj < 2; ++bj) { const f32x4 v0 = acc[ai][bj][m][0], v1 = acc[ai][bj][m][1];
                    u32x4 w; w.x = cvt_pk_bf16(v0[0], v0[1]); w.y = cvt_pk_bf16(v0[2], v0[3]); w.z = cvt_pk_bf16(v1[0], v1[1]); w.w = cvt_pk_bf16(v1[2], v1[3]);
                    *(u32x4*)(rowp + bj * HALF) = w; } }
    }
};
}

#define XB_TMO      128
#define XB_XCNT(j)  (256  + 64 * (j))
#define XB_XSUB(j)  (1280 + 64 * (j))
#define XB_XGEN(j)  (2304 + 64 * (j))
#define XB_TOP      3328
#define XB_TOPGEN   3392
#define XCD_BAR_WORDS 3456
#define XB_SPIN_CAP (1u << 18)
__device__ __forceinline__ unsigned xb_ld(unsigned* p)              { return __hip_atomic_load(p, __ATOMIC_RELAXED, __HIP_MEMORY_SCOPE_AGENT); }
__device__ __forceinline__ unsigned xb_add(unsigned* p, unsigned v) { return __hip_atomic_fetch_add(p, v, __ATOMIC_RELAXED, __HIP_MEMORY_SCOPE_AGENT); }
__device__ __forceinline__ unsigned xb_xcc_id() { return (unsigned)__builtin_amdgcn_s_getreg((3 << 11) | 20) & 0xFu; }
#define XB_SPIN(cond, bar) do { unsigned _sp = 0; while (cond) { __builtin_amdgcn_s_sleep(1); \
    if ((++_sp & 255u) == 0u) { if (xb_ld(&(bar)[XB_TMO])) break; if (_sp > XB_SPIN_CAP) { atomicAdd(&(bar)[XB_TMO], 1u); break; } } } } while (0)
struct XcdBarrier { unsigned* bar; unsigned x; volatile LAS unsigned* st; };
__device__ __forceinline__ XcdBarrier xcd_barrier_post(unsigned* bar, volatile LAS unsigned* st) {
    XcdBarrier b; b.bar = bar; b.x = xb_xcc_id(); b.st = st;
    if (threadIdx.x == 0) (void)xb_add(&bar[XB_XCNT(b.x)], 1u);
    return b;
}
__device__ __forceinline__ void xcd_barrier_complete(unsigned* bar, unsigned x, unsigned& nloc, unsigned& nx) {
    const unsigned G = gridDim.x * gridDim.y * gridDim.z;
    unsigned sum, cnt, mine, sp = 0u;
    for (;;) {
        sum = 0u; cnt = 0u; mine = 0u;
#pragma unroll
        for (unsigned j = 0; j < 16; ++j) { const unsigned c = xb_ld(&bar[XB_XCNT(j)]); sum += c; cnt += (c > 0u) ? 1u : 0u; mine = (j == x) ? c : mine; }
        if (sum == G) break;
        __builtin_amdgcn_s_sleep(1);
        if ((++sp & 255u) == 0u) { if (xb_ld(&bar[XB_TMO])) break; if (sp > XB_SPIN_CAP) { atomicAdd(&bar[XB_TMO], 1u); break; } }
    }
    nloc = mine > 0u ? mine : 1u; nx = cnt > 0u ? cnt : 1u;
}
__device__ __forceinline__ void xcd_barrier(const XcdBarrier& b) {
    asm volatile("s_waitcnt vmcnt(0)" ::: "memory");
    __syncthreads();
    if (threadIdx.x == 0) {
        unsigned* bar = b.bar;
        __builtin_amdgcn_s_waitcnt(0);
        unsigned nloc = b.st[0], nx = b.st[1];
        if (nloc == 0u) { xcd_barrier_complete(bar, b.x, nloc, nx); b.st[0] = nloc; b.st[1] = nx; }
        const unsigned old = xb_add(&bar[XB_XSUB(b.x)], 1u);
        const unsigned gen = old / nloc;
        if (old + 1u == (gen + 1u) * nloc) {
            __builtin_amdgcn_fence(__ATOMIC_RELEASE, "agent");
            asm volatile("s_waitcnt vmcnt(0)" ::: "memory");
            const unsigned og = xb_add(&bar[XB_TOP], 1u);
            const unsigned tg = og / nx;
            if (og + 1u == (tg + 1u) * nx) xb_add(&bar[XB_TOPGEN], 1u);
            else XB_SPIN(xb_ld(&bar[XB_TOPGEN]) == tg, bar);
            __builtin_amdgcn_fence(__ATOMIC_ACQUIRE, "agent");
            xb_add(&bar[XB_XGEN(b.x)], 1u);
            asm volatile("s_waitcnt vmcnt(0)" ::: "memory");
        } else {
            XB_SPIN(xb_ld(&bar[XB_XGEN(b.x)]) == gen, bar);
            __builtin_amdgcn_fence(__ATOMIC_ACQUIRE, "agent");
            asm volatile("s_waitcnt vmcnt(0)" ::: "memory");
        }
    }
    __syncthreads();
}

enum { I_XP = 0, I_XS, I_SGLA, I_SMC, I_SMN, I_SMM, I_SLRU, I_C, I_CCTX, I_N1G, I_N2G, I_WMOD, I_BMOD, I_WIN, I_GWA, I_GBA, I_GNG, I_MBIF, I_MNG,
       I_LCW, I_LCB, I_LGW, I_LGB, I_LLAM, I_WBR, I_BMG, I_WOUT, I_FUP, I_FCW, I_FCB, I_FDOWN, I_NFG };
constexpr size_t OUT_X = 0;
constexpr size_t OUT_GLA = (size_t)NTOK * D;
constexpr size_t OUT_MC = OUT_GLA + (size_t)32 * 2 * 2 * 4 * 128 * 256;
constexpr size_t OUT_MN = OUT_MC + (size_t)32 * 2 * 2 * 4 * 256 * 256;
constexpr size_t OUT_MM = OUT_MN + (size_t)32 * 2 * 2 * 4 * 256;
constexpr size_t OUT_LRU = OUT_MM + (size_t)32 * 2 * 2 * 4;
constexpr size_t OUT_END = OUT_LRU + (size_t)32 * 2 * 2 * 1024;

struct Seq { int tl0, len, b, ctx; };
__device__ __forceinline__ Seq seq_of(int g, int s) {
    Seq q;
    if (g == 0) { if (s < 32) { q.tl0 = s * 256; q.len = 256; q.b = s; q.ctx = 1; } else { q.tl0 = NCTX + (s - 32) * 4096; q.len = 4096; q.b = s - 32; q.ctx = 0; } }
    else { q.tl0 = s * 4096; q.len = 4096; q.b = 4 + s; q.ctx = 0; }
    return q;
}
__device__ __forceinline__ int seq_index(int g, int k) { return g == 0 ? (k < 4 ? 32 + k : k - 4) : k; }
__device__ __forceinline__ int nseq_of(int g) { return g == 0 ? 36 : 4; }

__device__ __forceinline__ bf16x8 lds_frag(const LAS bf16_t* base, int ld, int row0, int k0, int lane) {
    return *(const LAS bf16x8*)(base + (row0 + (lane & 15)) * ld + k0 + (lane >> 4) * 8);
}
#define MFMA16(x, y, acc) __builtin_amdgcn_mfma_f32_16x16x32_bf16((x), (y), (acc), 0, 0, 0)

__device__ __forceinline__ void phase_mod(const Params& p, LAS unsigned char* lds) {
    LAS float* sc = (LAS float*)lds;
    LAS float* red = (LAS float*)(lds + 9 * 2048 * 4);
    const int tid = tidx();
    if ((int)blockIdx.x >= 384) return;
    for (int i = tid; i < 9 * 2048; i += NTHREADS) { const int r = i >> 11, k = i & 2047; const float v = r < 8 ? p.in[I_C][r * 2048 + k] : p.in[I_CCTX][k]; sc[i] = silu_f(v); }
    __syncthreads();
    float* mod = (float*)(p.ws + WS_MOD);
    for (int u = blockIdx.x; u < 384; u += gridDim.x) {
        const int l = u / 192, cb = u % 192, col = tid & 63, kp = tid >> 6;
        const float* w = p.in[I_WMOD] + (size_t)l * 2048 * 12288 + cb * 64 + col;
        float a[9];
#pragma unroll
        for (int r = 0; r < 9; ++r) a[r] = 0.f;
        for (int k0 = kp * 256; k0 < kp * 256 + 256; k0 += 16) { float wv[16];
#pragma unroll
            for (int kk = 0; kk < 16; ++kk) wv[kk] = w[(size_t)(k0 + kk) * 12288];
#pragma unroll
            for (int kk = 0; kk < 16; ++kk)
#pragma unroll
                for (int r = 0; r < 9; ++r) a[r] += sc[r * 2048 + k0 + kk] * wv[kk]; }
#pragma unroll
        for (int r = 0; r < 9; ++r) red[(kp * 9 + r) * 64 + col] = a[r];
        __syncthreads();
        for (int i = tid; i < 9 * 64; i += NTHREADS) { const int r = i >> 6, c2 = i & 63; float s = 0.f;
#pragma unroll
            for (int q = 0; q < 8; ++q) s += red[(q * 9 + r) * 64 + c2];
            mod[((size_t)l * 9 + r) * 12288 + cb * 64 + c2] = s + p.in[I_BMOD][l * 12288 + cb * 64 + c2]; }
        __syncthreads();
    }
}

__device__ __forceinline__ void transpose_item(const float* W, int K, int Nsrc, int k0, int src_n0, int nvalid, float scale, bf16_t* dst, LAS float* scr, int lane) {
    f32x4 wv[8];
#pragma unroll
    for (int i = 0; i < 8; ++i) { const int v = lane + 64 * i, kk = v >> 3, c4 = (v & 7) * 4; wv[i] = *(const f32x4*)(W + (size_t)(k0 + kk) * Nsrc + src_n0 + c4); }
#pragma unroll
    for (int i = 0; i < 8; ++i) { const int v = lane + 64 * i, kk = v >> 3, c4 = (v & 7) * 4; const float sc_ = c4 < nvalid ? scale : 0.f; LAS float* d_ = scr + kk * 33 + c4;
        d_[0] = wv[i][0] * sc_; d_[1] = wv[i][1] * sc_; d_[2] = wv[i][2] * sc_; d_[3] = wv[i][3] * sc_; }
    LDS_WAIT(); asm volatile("" ::: "memory");
    const int c = lane & 7;
#pragma unroll
    for (int j = 0; j < 4; ++j) { const int n = (lane >> 3) + 8 * j; const LAS float* s = scr + (8 * c) * 33 + n;
        u32x4 o; o.x = cvt_pk_bf16(s[0 * 33], s[1 * 33]); o.y = cvt_pk_bf16(s[2 * 33], s[3 * 33]); o.z = cvt_pk_bf16(s[4 * 33], s[5 * 33]); o.w = cvt_pk_bf16(s[6 * 33], s[7 * 33]);
        *(u32x4*)(dst + (size_t)n * K + k0 + 8 * c) = o; }
    LDS_WAIT(); asm volatile("" ::: "memory");
}
__device__ __forceinline__ void transpose_item_f8(const float* W, int K, int Nsrc, int k0, int src_n0, float scale, unsigned char* dst8, LAS float* scr, int lane) {
    f32x4 wv[8];
#pragma unroll
    for (int i = 0; i < 8; ++i) { const int v = lane + 64 * i, kk = v >> 3, c4 = (v & 7) * 4; wv[i] = *(const f32x4*)(W + (size_t)(k0 + kk) * Nsrc + src_n0 + c4); }
#pragma unroll
    for (int i = 0; i < 8; ++i) { const int v = lane + 64 * i, kk = v >> 3, c4 = (v & 7) * 4; LAS float* d_ = scr + kk * 33 + c4;
        d_[0] = wv[i][0] * scale; d_[1] = wv[i][1] * scale; d_[2] = wv[i][2] * scale; d_[3] = wv[i][3] * scale; }
    LDS_WAIT(); asm volatile("" ::: "memory");
    const int c = lane & 7;
#pragma unroll
    for (int j = 0; j < 4; ++j) { const int n = (lane >> 3) + 8 * j; const LAS float* s = scr + (8 * c) * 33 + n;
        int w0 = 0, w1 = 0;
        w0 = __builtin_amdgcn_cvt_pk_fp8_f32(s[0 * 33], s[1 * 33], w0, false); w0 = __builtin_amdgcn_cvt_pk_fp8_f32(s[2 * 33], s[3 * 33], w0, true);
        w1 = __builtin_amdgcn_cvt_pk_fp8_f32(s[4 * 33], s[5 * 33], w1, false); w1 = __builtin_amdgcn_cvt_pk_fp8_f32(s[6 * 33], s[7 * 33], w1, true);
        u32x2 o; o.x = (unsigned)w0; o.y = (unsigned)w1; *(u32x2*)(dst8 + (size_t)n * K + k0 + 8 * c) = o; }
    LDS_WAIT(); asm volatile("" ::: "memory");
}
__device__ __forceinline__ void phase_wconv(const Params& p, int l, LAS unsigned char* lds) {
    const int tid_ = tidx(); const int lane = tid_ & 63, wave = tid_ >> 6;
    LAS float* scr = (LAS float*)(lds + wave * 16384);
    const int gw = blockIdx.x * 8 + wave, NGW = gridDim.x * 8;
    constexpr int I_IN = 32 * 488, I_BRn = 16 * 64 * 3, I_OUTn = 32 * 64, I_UPn = 32 * 352, I_DNn = 88 * 64, I_LR = 32 * 8;
    constexpr int NITEMS = I_IN + I_BRn + I_OUTn + I_UPn + I_DNn + I_LR;
    for (int it = gw; it < NITEMS; it += NGW) {
        int r = it;
        if (r < I_IN) {
            const int kb = r / 488, nb = r % 488, d0 = nb * 32; int s0, nv = 32; float sc = 1.f;
            if (d0 < 2048) s0 = d0; else if (d0 < 5120) s0 = 3104 + (d0 - 2048); else if (d0 < 6144) s0 = 7216 + (d0 - 5120); else if (d0 < 7168) s0 = 2048 + (d0 - 6144); else if (d0 < 8192) s0 = 6176 + (d0 - 7168); else if (d0 < 9216) s0 = 8240 + (d0 - 8192); else if (d0 < 9248) s0 = 3072; else if (d0 < 9280) { s0 = 7200; nv = 16; } else if (d0 < NZ1) { s0 = 0; nv = 0; } else s0 = d0 - NZ1 + 9264;
            if (d0 < 512) sc = 0.08838834764831845f; else if (d0 >= ZC_KB && d0 < ZC_KB + 1024) sc = 0.0625f;
            if (d0 >= NZ1) { transpose_item_f8(p.in[I_WIN] + (size_t)l * 2048 * 15408, 2048, 15408, kb * 64, s0, 64.f, p.ws + WS_WMG8 + (size_t)(d0 - NZ1) * 2048, scr, lane); continue; }
            transpose_item(p.in[I_WIN] + (size_t)l * 2048 * 15408, 2048, 15408, kb * 64, s0, nv, sc, (bf16_t*)(p.ws + W_IN) + (size_t)d0 * 2048, scr, lane); continue; }
        r -= I_IN;
        if (r < I_BRn) { const int n = r / (16 * 64), q = r % (16 * 64), kb = q / 64, nb = q % 64;
            transpose_item(p.in[I_WBR] + ((size_t)l * 3 + n) * 1024 * 2048, 1024, 2048, kb * 64, nb * 32, 32, 1.f, (bf16_t*)(p.ws + W_BR) + ((size_t)n * 2048 + nb * 32) * 1024, scr, lane); continue; }
        r -= I_BRn;
        if (r < I_OUTn) { const int kb = r / 64, nb = r % 64;
            transpose_item(p.in[I_WOUT] + (size_t)l * 2048 * 2048, 2048, 2048, kb * 64, nb * 32, 32, 1.f, (bf16_t*)(p.ws + W_OUT) + (size_t)(nb * 32) * 2048, scr, lane); continue; }
        r -= I_OUTn;
        if (r < I_UPn) { const int kb = r / 352, nb = r % 352;
            transpose_item(p.in[I_FUP] + (size_t)l * 2048 * NUP, 2048, NUP, kb * 64, nb * 32, 32, 1.f, (bf16_t*)(p.ws + W_UP) + (size_t)(nb * 32) * 2048, scr, lane); continue; }
        r -= I_UPn;
        if (r < I_DNn) { const int kb = r / 64, nb = r % 64;
            transpose_item(p.in[I_FDOWN] + (size_t)l * DFF * 2048, DFF, 2048, kb * 64, nb * 32, 32, 1.f, (bf16_t*)(p.ws + W_DOWN) + (size_t)(nb * 32) * DFF, scr, lane); continue; }
        r -= I_DNn;
        { const int mat = r / 8, q = r % 8, kb = q / 4, nb = q % 4;
            transpose_item(p.in[I_LGW] + ((size_t)l * 32 + mat) * 16384, 128, 128, kb * 64, nb * 32, 32, 1.f, (bf16_t*)(p.ws + W_LRU) + (size_t)mat * 16384 + (size_t)(nb * 32) * 128, scr, lane); }
    }
}

__device__ __forceinline__ void phase_norm(const Params& p, int l, int g, int which, bool from_input) {
    const int tid_ = tidx(); const int lane = tid_ & 63, wave = tid_ >> 6;
    const int gw = blockIdx.x * 8 + wave, NGW = gridDim.x * 8;
    const float* ng = p.in[which ? I_N2G : I_N1G] + l * D;
    const float* mod_l = (const float*)(p.ws + WS_MOD) + (size_t)l * 9 * 12288;
    bf16_t* U = (bf16_t*)(p.ws + WS_U);
    const int tg = tg_of(g), R = (tg + NGW - 1) / NGW;
    f32x4 ga[8], hv[8]; int cond_have = -1;
    for (int tl = gw * R; tl < gw * R + R && tl < tg; ++tl) {
        const int t = glob_tok(g, tl);
        const float* xr = t < NCTX ? p.in[I_XP] + (size_t)t * D : p.in[I_XS] + (size_t)(t - NCTX) * D;
        const bf16_t* xb = (const bf16_t*)(p.out + OUT_X) + (size_t)t * D;
        const int cond = t < NCTX ? 8 : (t - NCTX) >> 12;
        if (cond != cond_have) { cond_have = cond;
            const float* sh = mod_l + (size_t)cond * 12288 + (which * 3) * D; const float* sc = sh + D;
#pragma unroll
            for (int j = 0; j < 4; ++j)
#pragma unroll
                for (int e = 0; e < 2; ++e) { const int c = j * 512 + lane * 8 + 4 * e; ga[2 * j + e] = *(const f32x4*)(ng + c) * (*(const f32x4*)(sc + c) + 1.f); hv[2 * j + e] = *(const f32x4*)(sh + c); } }
        f32x4 v[8]; float s = 0.f;
#pragma unroll
        for (int j = 0; j < 4; ++j) { const int c = j * 512 + lane * 8;
            if (from_input) { v[2 * j] = *(const f32x4*)(xr + c); v[2 * j + 1] = *(const f32x4*)(xr + c + 4); }
            else { const u32x4 q = *(const u32x4*)(xb + c);
                v[2 * j][0] = __uint_as_float(q.x << 16); v[2 * j][1] = __uint_as_float(q.x & 0xffff0000u); v[2 * j][2] = __uint_as_float(q.y << 16); v[2 * j][3] = __uint_as_float(q.y & 0xffff0000u);
                v[2 * j + 1][0] = __uint_as_float(q.z << 16); v[2 * j + 1][1] = __uint_as_float(q.z & 0xffff0000u); v[2 * j + 1][2] = __uint_as_float(q.w << 16); v[2 * j + 1][3] = __uint_as_float(q.w & 0xffff0000u); } }
#pragma unroll
        for (int j = 0; j < 8; ++j) s += (v[j][0] * v[j][0] + v[j][1] * v[j][1]) + (v[j][2] * v[j][2] + v[j][3] * v[j][3]);
        const float rstd = rsqrtf(wave_sum(s) * (1.f / D) + EPS);
#pragma unroll
        for (int j = 0; j < 4; ++j) { const int c = j * 512 + lane * 8;
            const f32x4 o0 = v[2 * j] * rstd * ga[2 * j] + hv[2 * j], o1 = v[2 * j + 1] * rstd * ga[2 * j + 1] + hv[2 * j + 1];
            u32x4 w; w.x = cvt_pk_bf16(o0[0], o0[1]); w.y = cvt_pk_bf16(o0[2], o0[3]); w.z = cvt_pk_bf16(o1[0], o1[1]); w.w = cvt_pk_bf16(o1[2], o1[3]); *(u32x4*)(U + (size_t)tl * D + c) = w;
            if (which == 0) { int w0 = 0, w1 = 0;
                w0 = __builtin_amdgcn_cvt_pk_fp8_f32(o0[0], o0[1], w0, false); w0 = __builtin_amdgcn_cvt_pk_fp8_f32(o0[2], o0[3], w0, true);
                w1 = __builtin_amdgcn_cvt_pk_fp8_f32(o1[0], o1[1], w1, false); w1 = __builtin_amdgcn_cvt_pk_fp8_f32(o1[2], o1[3], w1, true);
                u32x2 q8; q8.x = (unsigned)w0; q8.y = (unsigned)w1; *(u32x2*)(p.ws + WS_U8 + (size_t)tl * D + c) = q8; } }
    }
}
__device__ __forceinline__ void phase_final_norm(const Params& p) {
    const int tid_ = tidx(); const int lane = tid_ & 63, wave = tid_ >> 6;
    const int gw = blockIdx.x * 8 + wave, NGW = gridDim.x * 8;
    f32x4 gn[8];
#pragma unroll
    for (int j = 0; j < 4; ++j)
#pragma unroll
        for (int e = 0; e < 2; ++e) gn[2 * j + e] = *(const f32x4*)(p.in[I_NFG] + j * 512 + lane * 8 + 4 * e);
    for (int t = gw; t < NTOK; t += NGW) {
        const bf16_t* xb = (const bf16_t*)(p.ws + xfin_off(t)); float* xr = p.out + OUT_X + (size_t)t * D;
        f32x4 v[8]; float s = 0.f;
#pragma unroll
        for (int j = 0; j < 4; ++j) { const u32x4 q = *(const u32x4*)(xb + j * 512 + lane * 8);
            v[2 * j][0] = __uint_as_float(q.x << 16); v[2 * j][1] = __uint_as_float(q.x & 0xffff0000u); v[2 * j][2] = __uint_as_float(q.y << 16); v[2 * j][3] = __uint_as_float(q.y & 0xffff0000u);
            v[2 * j + 1][0] = __uint_as_float(q.z << 16); v[2 * j + 1][1] = __uint_as_float(q.z & 0xffff0000u); v[2 * j + 1][2] = __uint_as_float(q.w << 16); v[2 * j + 1][3] = __uint_as_float(q.w & 0xffff0000u); }
#pragma unroll
        for (int j = 0; j < 8; ++j) s += (v[j][0] * v[j][0] + v[j][1] * v[j][1]) + (v[j][2] * v[j][2] + v[j][3] * v[j][3]);
        const float rstd = rsqrtf(wave_sum(s) * (1.f / D) + EPS);
#pragma unroll
        for (int j = 0; j < 4; ++j)
#pragma unroll
            for (int e = 0; e < 2; ++e) *(f32x4*)(xr + j * 512 + lane * 8 + 4 * e) = v[2 * j + e] * rstd * gn[2 * j + e];
    }
}

__device__ __forceinline__ bf16_t* o_buf(const Params& p, int dir, int mixer) { return (bf16_t*)(p.ws + WS_O) + ((size_t)(dir * 3 + mixer) * TMAX) * 1024; }

typedef short s16x4_t __attribute__((ext_vector_type(4)));
__device__ __forceinline__ bf16x8 lds_frag_tr(const LAS bf16_t* base, int ld, int k0, int col0, int lane) {
    const LAS bf16_t* a = base + (k0 + 8 * (lane >> 4) + ((lane & 15) >> 2)) * ld + col0 + 4 * (lane & 3);
    const s16x4_t lo = __builtin_amdgcn_ds_read_tr16_b64_v4i16((LAS s16x4_t*)a), hi = __builtin_amdgcn_ds_read_tr16_b64_v4i16((LAS s16x4_t*)(a + 4 * ld));
    return __builtin_shufflevector(lo, hi, 0, 1, 2, 3, 4, 5, 6, 7);
}
__device__ __forceinline__ void gla_item(const Params& p, int l, const Seq sq, int h, int dir, int slice, LAS unsigned char* lds) {
    LAS bf16_t* QIN = (LAS bf16_t*)(lds);
    LAS bf16_t* KIN = (LAS bf16_t*)(lds + 17408);
    LAS bf16_t* VRAW = (LAS bf16_t*)(lds + 34816);
    LAS bf16_t* ATT = (LAS bf16_t*)(lds + 52224);
    LAS bf16_t* SB0 = (LAS bf16_t*)(lds + 61440);
    LAS bf16_t* RAB = (LAS bf16_t*)(lds + 131072);
    LAS float*  EL  = (LAS float*)(lds + 136192);
    const int tid = tidx(), lane = tid & 63, w = tid >> 6, q4 = lane >> 4, l15 = lane & 15;
    const bf16_t* Z = (const bf16_t*)(p.ws + WS_Z); const float* SM = (const float*)(p.ws + WS_SM);
    bf16_t* O = o_buf(p, dir, 0);
    const int d = tid & 127, rg = tid >> 7;
    const int dq = 16 * w + l15;
    bf16x8 wb1, wb2;
    {
        LAS bf16_t* W1 = (LAS bf16_t*)(lds); LAS bf16_t* W2 = (LAS bf16_t*)(lds + 10240);
        const int jq = tid >> 7; float wv[4];
#pragma unroll
        for (int j = 0; j < 4; ++j) wv[j] = p.in[I_GWA][((size_t)(l * 2 + dir) * 16 + jq * 4 + j) * 512 + h * 128 + d] * 1.4426950408889634f;
        unsigned short hi[4], lo[4];
#pragma unroll
        for (int j = 0; j < 4; ++j) { hi[j] = f2bf(wv[j]); lo[j] = f2bf(wv[j] - bf2f(hi[j])); }
        u32x2 ph, pl; ph.x = hi[0] | ((unsigned)hi[1] << 16); ph.y = hi[2] | ((unsigned)hi[3] << 16); pl.x = lo[0] | ((unsigned)lo[1] << 16); pl.y = lo[2] | ((unsigned)lo[3] << 16);
        *(LAS u32x2*)(W1 + d * 40 + jq * 4) = ph; *(LAS u32x2*)(W1 + d * 40 + 16 + jq * 4) = ph;
        *(LAS u32x2*)(W2 + d * 40 + jq * 4) = pl; *(LAS u32x2*)(W2 + d * 40 + 16 + jq * 4) = (u32x2){0u, 0u};
        SYNC_LDS();
        wb1 = lds_frag(W1, 40, 16 * w, 0, lane); wb2 = lds_frag(W2, 40, 16 * w, 0, lane);
        SYNC_LDS();
    }
    const float bal = p.in[I_GBA][(l * 2 + dir) * 512 + h * 128 + dq] * 1.4426950408889634f;
    f32x4 S[8];
    {
        const float* s0 = p.in[I_SGLA] + ((((size_t)(sq.ctx ? 0 : sq.b) * 2 + l) * 2 + dir) * 4 + h) * 128 * 256; const float zf = sq.ctx ? 0.f : 1.f;
#pragma unroll
        for (int nt = 0; nt < 8; ++nt)
#pragma unroll
            for (int i = 0; i < 4; ++i) S[nt][i] = s0[(size_t)(16 * w + 4 * q4 + i) * 256 + slice * 128 + nt * 16 + l15] * zf;
#pragma unroll
        for (int nt = 0; nt < 8; ++nt) { u32x2 pk; pk.x = cvt_pk_bf16(S[nt][0], S[nt][1]); pk.y = cvt_pk_bf16(S[nt][2], S[nt][3]); *(LAS u32x2*)(SB0 + (nt * 16 + l15) * 136 + 16 * w + 4 * q4) = pk; }
    }
    const int nch = sq.len >> 6;
#define TOKC(cc_, r) (sq.tl0 + (dir ? sq.len - 1 - ((cc_) * 64 + (r)) : (cc_) * 64 + (r)))
    u32x4 qr_[2], kr_[2], vr_[2]; f32x4 ra4 = {0.f, 0.f, 0.f, 0.f};
#define GLA_LOADS(cc_) do { \
        _Pragma("unroll") for (int i = 0; i < 2; ++i) { const int v_ = tid + 512 * i, row_ = v_ >> 4, c8_ = (v_ & 15) * 8; const int tk_ = TOKC(cc_, row_); \
            qr_[i] = *(const u32x4*)(Z + zoff(tk_, ZC_QA + h * 128 + c8_)); kr_[i] = *(const u32x4*)(Z + zoff(tk_, ZC_KA + h * 128 + c8_)); vr_[i] = *(const u32x4*)(Z + zoff(tk_, ZC_VA + h * 256 + slice * 128 + c8_)); } \
        ra4 = *(const f32x4*)(SM + (size_t)TOKC(cc_, (tid >> 2) & 63) * 64 + dir * 16 + (tid & 3) * 4); } while (0)
    GLA_LOADS(0);
    for (int c = 0; c < nch; ++c) {
        LAS bf16_t* SB = SB0 + (c & 1) * (128 * 136); LAS bf16_t* SBN = SB0 + ((c + 1) & 1) * (128 * 136);
        if (tid < 256) { unsigned short hi[4], lo[4];
#pragma unroll
            for (int j = 0; j < 4; ++j) { hi[j] = f2bf(ra4[j]); lo[j] = f2bf(ra4[j] - bf2f(hi[j])); }
            u32x2 ph, pl; ph.x = hi[0] | ((unsigned)hi[1] << 16); ph.y = hi[2] | ((unsigned)hi[3] << 16); pl.x = lo[0] | ((unsigned)lo[1] << 16); pl.y = lo[2] | ((unsigned)lo[3] << 16);
            *(LAS u32x2*)(RAB + (tid >> 2) * 40 + (tid & 3) * 4) = ph; *(LAS u32x2*)(RAB + (tid >> 2) * 40 + 16 + (tid & 3) * 4) = pl; }
#pragma unroll
        for (int i = 0; i < 2; ++i) { const int v_ = tid + 512 * i, row_ = v_ >> 4, c8_ = (v_ & 15) * 8;
            *(LAS u32x4*)(QIN + row_ * 136 + c8_) = qr_[i]; *(LAS u32x4*)(KIN + row_ * 136 + c8_) = kr_[i]; *(LAS u32x4*)(VRAW + row_ * 136 + c8_) = vr_[i]; }
        if (c + 1 < nch) GLA_LOADS(c + 1);
        SYNC_LDS();
        float cumv[4][4], last;
        {
            bf16x8 af[4];
#pragma unroll
            for (int mt2 = 0; mt2 < 4; ++mt2) af[mt2] = lds_frag(RAB, 40, mt2 * 16, 0, lane);
            asm volatile("" ::: "memory");
            float tot[4];
#pragma unroll
            for (int mt2 = 0; mt2 < 4; ++mt2) { f32x4 a = {bal, bal, bal, bal}; a = MFMA16(af[mt2], wb1, a); a = MFMA16(af[mt2], wb2, a);
                float r = 0.f;
#pragma unroll
                for (int e = 0; e < 4; ++e) { r += (fminf(a[e], 0.f) - __builtin_amdgcn_logf(1.f + __builtin_amdgcn_exp2f(-fabsf(a[e])))) * 0.0625f; cumv[mt2][e] = r; }
                float t = r;
                const float s1 = __shfl_up(t, 16); if (q4 >= 1) t += s1;
                const float s2 = __shfl_up(t, 32); if (q4 >= 2) t += s2;
                const float excl = t - r;
#pragma unroll
                for (int e = 0; e < 4; ++e) cumv[mt2][e] += excl;
                tot[mt2] = __shfl(t, 48 + l15); }
            float base = 0.f;
#pragma unroll
            for (int mt2 = 0; mt2 < 4; ++mt2) {
#pragma unroll
                for (int e = 0; e < 4; ++e) cumv[mt2][e] += base;
                base += tot[mt2]; }
            last = base;
        }
        const float elast = __builtin_amdgcn_exp2f(last);
        unsigned qraw[16], kraw[16];
#pragma unroll
        for (int i = 0; i < 16; ++i) { const int row = (i >> 2) * 16 + 4 * q4 + (i & 3); qraw[i] = QIN[row * 136 + dq]; kraw[i] = KIN[row * 136 + dq]; }
        asm volatile("" ::: "memory");
#pragma unroll
        for (int mt2 = 0; mt2 < 4; ++mt2) {
#pragma unroll
            for (int e = 0; e < 4; ++e) { const int i = mt2 * 4 + e, row = mt2 * 16 + 4 * q4 + e; const float cu = cumv[mt2][e];
                const float ex = __builtin_amdgcn_exp2f(cu), ei = __builtin_amdgcn_exp2f(-cu), qf = __uint_as_float(qraw[i] << 16), kf = __uint_as_float(kraw[i] << 16);
                QIN[row * 136 + dq] = f2bf(qf * ex); KIN[row * 136 + dq] = f2bf(kf * ei); } }
        if (q4 == 0) EL[dq] = elast;
        SYNC_LDS();
        const int mt = w >> 1;
        {
            const int nt0 = 2 * (w & 1);
#pragma unroll
            for (int t2 = 0; t2 < 2; ++t2) { const int nt = nt0 + t2; f32x4 a = {0.f, 0.f, 0.f, 0.f};
                if (nt <= mt) { bf16x8 xk[4], yq2[4];
#pragma unroll
                    for (int ks = 0; ks < 4; ++ks) { xk[ks] = lds_frag(KIN, 136, nt * 16, ks * 32, lane); yq2[ks] = lds_frag(QIN, 136, mt * 16, ks * 32, lane); }
                    asm volatile("" ::: "memory");
#pragma unroll
                    for (int ks = 0; ks < 4; ++ks) a = MFMA16(xk[ks], yq2[ks], a);
                }
                const int i = mt * 16 + l15, j0 = nt * 16 + 4 * q4;
#pragma unroll
                for (int e = 0; e < 4; ++e) if (j0 + e > i) a[e] = 0.f;
                u32x2 pk; pk.x = cvt_pk_bf16(a[0], a[1]); pk.y = cvt_pk_bf16(a[2], a[3]); *(LAS u32x2*)(ATT + i * 72 + j0) = pk; }
        }
        SYNC_LDS();
        {
            bf16x8 ya[2], yq[4];
#pragma unroll
            for (int ks = 0; ks < 2; ++ks) ya[ks] = lds_frag(ATT, 72, mt * 16, ks * 32, lane);
#pragma unroll
            for (int ks = 0; ks < 4; ++ks) yq[ks] = lds_frag(QIN, 136, mt * 16, ks * 32, lane);
            bf16_t* orow = O + (size_t)TOKC(c, mt * 16 + l15) * 1024 + h * 256 + slice * 128 + 4 * q4;
#pragma unroll
            for (int t4 = 0; t4 < 4; ++t4) { const int nt = 4 * (w & 1) + t4; f32x4 a = {0.f, 0.f, 0.f, 0.f};
                bf16x8 xv[2], xs[4];
#pragma unroll
                for (int ks = 0; ks < 2; ++ks) xv[ks] = lds_frag_tr(VRAW, 136, ks * 32, nt * 16, lane);
#pragma unroll
                for (int ks = 0; ks < 4; ++ks) xs[ks] = lds_frag(SB, 136, nt * 16, ks * 32, lane);
                asm volatile("" ::: "memory");
#pragma unroll
                for (int ks = 0; ks < 2; ++ks) a = MFMA16(xv[ks], ya[ks], a);
#pragma unroll
                for (int ks = 0; ks < 4; ++ks) a = MFMA16(xs[ks], yq[ks], a);
                u32x2 pk; pk.x = cvt_pk_bf16(a[0], a[1]); pk.y = cvt_pk_bf16(a[2], a[3]);
                *(u32x2*)(orow + nt * 16) = pk; }
        }
        {
            const f32x4 el = *(const LAS f32x4*)(EL + 16 * w + 4 * q4);
            bf16x8 xk[2];
#pragma unroll
            for (int ks = 0; ks < 2; ++ks) xk[ks] = lds_frag_tr(KIN, 136, ks * 32, w * 16, lane);
            bf16x8 yv[8][2];
#pragma unroll
            for (int nt = 0; nt < 8; ++nt)
#pragma unroll
                for (int ks = 0; ks < 2; ++ks) yv[nt][ks] = lds_frag_tr(VRAW, 136, ks * 32, nt * 16, lane);
#pragma unroll
            for (int nt = 0; nt < 8; ++nt) {
#pragma unroll
                for (int ks = 0; ks < 2; ++ks) S[nt] = MFMA16(xk[ks], yv[nt][ks], S[nt]);
                S[nt] = S[nt] * el;
                u32x2 pk; pk.x = cvt_pk_bf16(S[nt][0], S[nt][1]); pk.y = cvt_pk_bf16(S[nt][2], S[nt][3]); *(LAS u32x2*)(SBN + (nt * 16 + l15) * 136 + 16 * w + 4 * q4) = pk; }
        }
        SYNC_LDS();
    }
#undef GLA_LOADS
#undef TOKC
    if (sq.ctx) {
        float* so = p.out + OUT_GLA + ((((size_t)sq.b * 2 + l) * 2 + dir) * 4 + h) * 128 * 256;
#pragma unroll
        for (int nt = 0; nt < 8; ++nt)
#pragma unroll
            for (int i = 0; i < 4; ++i) so[(size_t)(16 * w + 4 * q4 + i) * 256 + slice * 128 + nt * 16 + l15] = S[nt][i];
    }
}

__device__ __forceinline__ void mlstm_item(const Params& p, int l, const Seq sq, int h, int dir, int slice, LAS unsigned char* lds) {
    LAS bf16_t* KN  = (LAS bf16_t*)(lds);
    LAS bf16_t* VRAW = (LAS bf16_t*)(lds + 33792);
    LAS bf16_t* VW   = (LAS bf16_t*)(lds + 45056);
    LAS bf16_t* SMm = (LAS bf16_t*)(lds + 56320);
    LAS bf16_t* CB0 = (LAS bf16_t*)(lds + 65536);
    LAS float*  AA  = (LAS float*)(lds + 150016);
    LAS float*  MX  = AA + 64;
    LAS float*  WP  = AA + 128;
    LAS float*  FL  = AA + 192;
    LAS float*  WL  = AA + 256;
    LAS float*  DEN = AA + 320;
    LAS float*  SC  = AA + 384;
    const int tid = tidx(), lane = tid & 63, w = tid >> 6, q4 = lane >> 4, l15 = lane & 15;
    const bf16_t* Z = (const bf16_t*)(p.ws + WS_Z); const float* SM = (const float*)(p.ws + WS_SM);
    bf16_t* O = o_buf(p, dir, 1);
    const float bi = p.in[I_MBIF][((l * 2 + dir) * 2 + 0) * 4 + h], bfg = p.in[I_MBIF][((l * 2 + dir) * 2 + 1) * 4 + h];
    const size_t sidx = (((size_t)sq.b * 2 + l) * 2 + dir) * 4 + h;
    f32x4 S[2][5];
    {
        const size_t sidx0 = (((size_t)(sq.ctx ? 0 : sq.b) * 2 + l) * 2 + dir) * 4 + h; const float zf = sq.ctx ? 0.f : 1.f;
        const float* c0 = p.in[I_SMC] + sidx0 * 256 * 256; const float* n0 = p.in[I_SMN] + sidx0 * 256;
#pragma unroll
        for (int dt = 0; dt < 2; ++dt)
#pragma unroll
            for (int ct = 0; ct < 5; ++ct)
#pragma unroll
                for (int i = 0; i < 4; ++i) { const int dd = 32 * w + 16 * dt + 4 * q4 + i;
                    if (ct < 4) S[dt][ct][i] = c0[(size_t)dd * 256 + slice * 64 + ct * 16 + l15] * zf; else S[dt][ct][i] = n0[dd] * (l15 == 0 ? zf : 0.f); }
#pragma unroll
        for (int dt = 0; dt < 2; ++dt)
#pragma unroll
            for (int ct = 0; ct < 5; ++ct) { u32x2 pk; pk.x = cvt_pk_bf16(S[dt][ct][0], S[dt][ct][1]); pk.y = cvt_pk_bf16(S[dt][ct][2], S[dt][ct][3]);
                *(LAS u32x2*)(CB0 + (ct * 16 + l15) * 264 + 32 * w + 16 * dt + 4 * q4) = pk; }
        for (int i = tid; i < 64 * 24; i += NTHREADS) { const int rr = i / 24, cc = i % 24; VRAW[rr * 88 + 64 + cc] = cc == 0 ? (bf16_t)0x3F80 : (bf16_t)0; }
        if (tid == 0) SC[1] = sq.ctx ? 0.f : p.in[I_SMM][sidx];
    }
    SYNC_LDS();
    const int mt = w & 3, hf = w >> 2;
    const int nch = sq.len >> 6;
#define TOKC(cc_, r) (sq.tl0 + (dir ? sq.len - 1 - ((cc_) * 64 + (r)) : (cc_) * 64 + (r)))
    u32x4 pkr[4], pvr; float pg_i = 0.f, pg_f = 0.f;
#define MLSTM_LOADS(cc_) do { \
        _Pragma("unroll") for (int i = 0; i < 4; ++i) { const int v_ = tid + 512 * i, row_ = v_ >> 5, c8_ = (v_ & 31) * 8; pkr[i] = *(const u32x4*)(Z + zoff(TOKC(cc_, row_), ZC_KB + h * 256 + c8_)); } \
        { const int row_ = tid >> 3, c8_ = (tid & 7) * 8; pvr = *(const u32x4*)(Z + zoff(TOKC(cc_, row_), ZC_VB + h * 256 + slice * 64 + c8_)); } \
        { const float* sm_ = SM + (size_t)TOKC(cc_, lane) * 64 + 32 + dir * 8 + h; pg_i = sm_[0]; pg_f = sm_[4]; } } while (0)
    MLSTM_LOADS(0);
    for (int c = 0; c < nch; ++c) {
#define TOK(r) (sq.tl0 + (dir ? sq.len - 1 - (c * 64 + (r)) : c * 64 + (r)))
        LAS bf16_t* CB = CB0 + (c & 1) * (80 * 264); LAS bf16_t* CBN = CB0 + ((c + 1) & 1) * (80 * 264);
        bf16x8 qf[8];
        { const bf16_t* qrow = Z + zoff(TOK(mt * 16 + l15), ZC_QB + h * 256) + q4 * 8;
#pragma unroll
            for (int ks = 0; ks < 8; ++ks) qf[ks] = *(const bf16x8*)(qrow + ks * 32); }
        if (w == 0) {
            const float m_prev = SC[1];
            const float gi = pg_i + bi, lf = logsigmoid_fast(pg_f + bfg);
            const float fc = wave_scan_add(lf);
            const float a = gi - fc; const float pm = wave_scan_max(a);
            const float mx = fmaxf(m_prev, pm), mj = fc + mx;
            const float mx63 = __shfl(mx, 63), fc63 = __shfl(fc, 63);
            AA[lane] = a; MX[lane] = mx; WP[lane] = __expf(m_prev - mx); FL[lane] = __expf(-mj); WL[lane] = __expf(a - mx63);
            LDS_WAIT();
            if (lane == 63) { SC[0] = __expf(m_prev - mx63); SC[1] = fc63 + mx63; }
        }
        {
#pragma unroll
            for (int i = 0; i < 4; ++i) { const int v_ = tid + 512 * i, row_ = v_ >> 5, c8_ = (v_ & 31) * 8; *(LAS u32x4*)(KN + row_ * 264 + c8_) = pkr[i]; }
            *(LAS u32x4*)(VRAW + (tid >> 3) * 88 + (tid & 7) * 8) = pvr;
        }
        if (c + 1 < nch) { MLSTM_LOADS(c + 1); }
        SYNC_LDS();
        {
            const int row = tid >> 3, c0 = (tid & 7) * 10; const float wl = WL[row];
            unsigned vr[5];
#pragma unroll
            for (int i = 0; i < 5; ++i) vr[i] = *(const LAS unsigned*)(VRAW + row * 88 + c0 + 2 * i);
            asm volatile("" ::: "memory");
#pragma unroll
            for (int i = 0; i < 5; ++i) *(LAS unsigned*)(VW + row * 88 + c0 + 2 * i) = cvt_pk_bf16(__uint_as_float(vr[i] << 16) * wl, __uint_as_float(vr[i] & 0xffff0000u) * wl);
        }
        {
            const int j = mt * 16 + l15; const float mxj = MX[j];
#pragma unroll
            for (int t2 = 0; t2 < 2; ++t2) { const int nt = 2 * hf + t2; f32x4 a = {0.f, 0.f, 0.f, 0.f};
                if (nt <= mt) { bf16x8 xk[8];
#pragma unroll
                    for (int ks = 0; ks < 8; ++ks) xk[ks] = lds_frag(KN, 264, nt * 16, ks * 32, lane);
                    asm volatile("" ::: "memory");
#pragma unroll
                    for (int ks = 0; ks < 8; ++ks) a = MFMA16(xk[ks], qf[ks], a);
                }
                const int i0 = nt * 16 + 4 * q4; const f32x4 av = *(const LAS f32x4*)(AA + i0);
#pragma unroll
                for (int e = 0; e < 4; ++e) a[e] = (i0 + e <= j) ? a[e] * __expf(av[e] - mxj) : 0.f;
                u32x2 pk; pk.x = cvt_pk_bf16(a[0], a[1]); pk.y = cvt_pk_bf16(a[2], a[3]); *(LAS u32x2*)(SMm + j * 72 + i0) = pk; }
        }
        SYNC_LDS();
        {
            const int j = mt * 16 + l15; const float wpj = WP[j];
            f32x4 nm[3]; bf16x8 ys[2];
#pragma unroll
            for (int ks = 0; ks < 2; ++ks) ys[ks] = lds_frag(SMm, 72, mt * 16, ks * 32, lane);
#pragma unroll
            for (int t3 = 0; t3 < 3; ++t3) { const int ct = t3 < 2 ? hf * 2 + t3 : 4; nm[t3] = (f32x4){0.f, 0.f, 0.f, 0.f};
                bf16x8 xc[8], xv[2];
#pragma unroll
                for (int ks = 0; ks < 8; ++ks) xc[ks] = lds_frag(CB, 264, ct * 16, ks * 32, lane);
#pragma unroll
                for (int ks = 0; ks < 2; ++ks) xv[ks] = lds_frag_tr(VRAW, 88, ks * 32, ct * 16, lane);
                asm volatile("" ::: "memory");
#pragma unroll
                for (int ks = 0; ks < 8; ++ks) nm[t3] = MFMA16(xc[ks], qf[ks], nm[t3]);
                nm[t3] = nm[t3] * wpj;
#pragma unroll
                for (int ks = 0; ks < 2; ++ks) nm[t3] = MFMA16(xv[ks], ys[ks], nm[t3]);
            }
            const float den = __shfl(nm[2][0], l15);
            const float dn = fmaxf(fabsf(den), FL[j]), inv = __builtin_amdgcn_rcpf(dn);
            bf16_t* orow = O + (size_t)TOK(j) * 1024 + h * 256 + slice * 64 + 4 * q4;
#pragma unroll
            for (int t3 = 0; t3 < 2; ++t3) { const int ct = hf * 2 + t3;
                const f32x4 hv = nm[t3] * inv; u32x2 pk; pk.x = cvt_pk_bf16(hv[0], hv[1]); pk.y = cvt_pk_bf16(hv[2], hv[3]); *(u32x2*)(orow + ct * 16) = pk; }
        }
        {
            const float dec = SC[0];
            bf16x8 yv[5][2];
#pragma unroll
            for (int ct = 0; ct < 5; ++ct)
#pragma unroll
                for (int ks = 0; ks < 2; ++ks) yv[ct][ks] = lds_frag_tr(VW, 88, ks * 32, ct * 16, lane);
#pragma unroll
            for (int dt = 0; dt < 2; ++dt) { bf16x8 xa[2];
#pragma unroll
                for (int ks = 0; ks < 2; ++ks) xa[ks] = lds_frag_tr(KN, 264, ks * 32, 32 * w + 16 * dt, lane);
#pragma unroll
                for (int ct = 0; ct < 5; ++ct) { S[dt][ct] = S[dt][ct] * dec;
#pragma unroll
                    for (int ks = 0; ks < 2; ++ks) S[dt][ct] = MFMA16(xa[ks], yv[ct][ks], S[dt][ct]);
                    u32x2 pk; pk.x = cvt_pk_bf16(S[dt][ct][0], S[dt][ct][1]); pk.y = cvt_pk_bf16(S[dt][ct][2], S[dt][ct][3]);
                    *(LAS u32x2*)(CBN + (ct * 16 + l15) * 264 + 32 * w + 16 * dt + 4 * q4) = pk; } }
        }
        SYNC_LDS();
#undef TOK
    }
#undef MLSTM_LOADS
#undef TOKC
    if (sq.ctx) {
        float* co = p.out + OUT_MC + sidx * 256 * 256; float* no = p.out + OUT_MN + sidx * 256;
#pragma unroll
        for (int dt = 0; dt < 2; ++dt)
#pragma unroll
            for (int ct = 0; ct < 5; ++ct)
#pragma unroll
                for (int i = 0; i < 4; ++i) { const int dd = 32 * w + 16 * dt + 4 * q4 + i;
                    if (ct < 4) co[(size_t)dd * 256 + slice * 64 + ct * 16 + l15] = S[dt][ct][i];
                    else if (slice == 0 && l15 == 0) no[dd] = S[dt][ct][i]; }
        if (slice == 0 && tid == 0) p.out[OUT_MM + sidx] = SC[1];
    }
    SYNC_LDS();
}

__device__ __forceinline__ void lru_item(const Params& p, int l, const Seq sq, int dir, int nb, LAS unsigned char* lds) {
    LAS bf16_t* XC = (LAS bf16_t*)(lds);
    LAS float*  XF = (LAS float*)(lds + 17408);
    LAS f32x2*  AI = (LAS f32x2*)(lds + 50176);
    LAS f32x2*  SEG = (LAS f32x2*)(lds + 115712);
    const int tid = tidx(), lane = tid & 63, w = tid >> 6, q4 = lane >> 4, l15 = lane & 15;
    const bf16_t* Z = (const bf16_t*)(p.ws + WS_Z);
    bf16_t* O = o_buf(p, dir, 2);
    const int ch = tid & 127, rg = tid >> 7;
    float cw[4];
#pragma unroll
    for (int j = 0; j < 4; ++j) cw[j] = p.in[I_LCW][((size_t)l * 4 + j) * 1024 + nb * 128 + ch];
    const float cb = p.in[I_LCB][l * 1024 + nb * 128 + ch];
    bf16x8 wf[2][4];
#pragma unroll
    for (int gt = 0; gt < 2; ++gt) { const bf16_t* wt = (const bf16_t*)(p.ws + W_LRU) + (size_t)((dir * 2 + gt) * 8 + nb) * 16384 + (size_t)(16 * w + l15) * 128 + q4 * 8;
#pragma unroll
        for (int ks = 0; ks < 4; ++ks) wf[gt][ks] = *(const bf16x8*)(wt + ks * 32); }
    const int jc = nb * 128 + 16 * w + l15;
    const float gb0 = p.in[I_LGB][((size_t)(l * 2 + dir) * 2 + 0) * 1024 + jc], gb1 = p.in[I_LGB][((size_t)(l * 2 + dir) * 2 + 1) * 1024 + jc];
    const float c8 = 8.f * softplus_f(-p.in[I_LLAM][(size_t)(l * 2 + dir) * 1024 + jc]);
    float hst = sq.ctx ? 0.f : p.in[I_SLRU][(((size_t)sq.b * 2 + l) * 2 + dir) * 1024 + jc];
    const int nch = sq.len >> 6;
    LAS bf16_t* XRAW = (LAS bf16_t*)(lds + 50176);
    LAS bf16_t* HO = (LAS bf16_t*)(lds + 67584);
    u32x4 xr_[3];
#define LRU_LOADS(cc_) do { const int t0_ = dir ? sq.len - 64 * ((cc_) + 1) : 64 * (cc_); \
        _Pragma("unroll") for (int i = 0; i < 3; ++i) { const int v_ = tid + 512 * i, row_ = v_ >> 4, c8_ = (v_ & 15) * 8; const int pos = t0_ - 2 + row_; \
            const bool ok_ = row_ < 67 && pos >= 0 && pos < sq.len; const int pc = ok_ ? pos : 0; const unsigned m_ = ok_ ? 0xffffffffu : 0u; \
            u32x4 q_ = *(const u32x4*)(Z + zoff(sq.tl0 + pc, ZC_XR + nb * 128 + c8_)); q_.x &= m_; q_.y &= m_; q_.z &= m_; q_.w &= m_; xr_[i] = q_; } } while (0)
    LRU_LOADS(0);
#define LRU_FLUSH(cc_) do { _Pragma("unroll") for (int i = 0; i < 2; ++i) { const int v_ = tid + 512 * i, r_ = v_ >> 4, c8_ = (v_ & 15) * 8; const int pos_ = dir ? sq.len - 1 - ((cc_) * 64 + r_) : (cc_) * 64 + r_; \
            *(u32x4*)(O + (size_t)(sq.tl0 + pos_) * 1024 + nb * 128 + c8_) = *(const LAS u32x4*)(HO + r_ * 128 + c8_); } } while (0)
    for (int c = 0; c < nch; ++c) {
        if (c > 0) LRU_FLUSH(c - 1);
#pragma unroll
        for (int i = 0; i < 3; ++i) { const int v_ = tid + 512 * i; if (v_ < 68 * 16) *(LAS u32x4*)(XRAW + (v_ >> 4) * 128 + (v_ & 15) * 8) = xr_[i]; }
        if (c + 1 < nch) LRU_LOADS(c + 1);
        SYNC_LDS();
        {
            float xv[19];
#pragma unroll
            for (int i = 0; i < 19; ++i) xv[i] = bf2f(XRAW[(16 * rg + i) * 128 + ch]);
            asm volatile("" ::: "memory");
#pragma unroll
            for (int i = 0; i < 16; ++i) { const float o = cb + cw[0] * xv[i] + cw[1] * xv[i + 1] + cw[2] * xv[i + 2] + cw[3] * xv[i + 3];
                const int tt = 16 * rg + i, r = dir ? 63 - tt : tt; XC[r * 136 + ch] = f2bf(o); XF[r * 128 + ch] = o; }
        }
        SYNC_LDS();
        {
            const int jl = 16 * w + l15;
            bf16x8 xa[4][4];
#pragma unroll
            for (int mt = 0; mt < 4; ++mt)
#pragma unroll
                for (int ks = 0; ks < 4; ++ks) xa[mt][ks] = lds_frag(XC, 136, mt * 16, ks * 32, lane);
#pragma unroll
            for (int mt = 0; mt < 4; ++mt) { f32x4 a0 = {0.f, 0.f, 0.f, 0.f}, a1 = {0.f, 0.f, 0.f, 0.f};
#pragma unroll
                for (int ks = 0; ks < 4; ++ks) { a0 = MFMA16(xa[mt][ks], wf[0][ks], a0); a1 = MFMA16(xa[mt][ks], wf[1][ks], a1); }
                float av[4], bv[4]; float A = 1.f, B = 0.f;
#pragma unroll
                for (int i = 0; i < 4; ++i) { const int r = mt * 16 + 4 * q4 + i;
                    const float rgate = sigmoid_f(a0[i] + gb0), igate = sigmoid_f(a1[i] + gb1);
                    const float la = -c8 * rgate; av[i] = __expf(la); bv[i] = __builtin_amdgcn_sqrtf(fmaxf(1.f - av[i] * av[i], 0.f)) * igate * XF[r * 128 + jl];
                    A *= av[i]; B = av[i] * B + bv[i]; }
                float hin = hst, hall = hst;
#pragma unroll
                for (int k = 0; k < 4; ++k) { const float Ak = __shfl(A, l15 + 16 * k), Bk = __shfl(B, l15 + 16 * k); hall = Ak * hall + Bk; if (k < q4) hin = hall; }
                hst = hall;
#pragma unroll
                for (int i = 0; i < 4; ++i) { const int r = mt * 16 + 4 * q4 + i; hin = av[i] * hin + bv[i];
                    HO[r * 128 + jl] = f2bf(hin); } }
        }
        SYNC_LDS();
    }
    LRU_FLUSH(nch - 1);
#undef LRU_FLUSH
#undef LRU_LOADS
    if (sq.ctx && q4 == 0) p.out[OUT_LRU + (((size_t)sq.b * 2 + l) * 2 + dir) * 1024 + jc] = hst;
    SYNC_LDS();
}

__device__ __forceinline__ int queue_pop(unsigned* ctr, volatile LAS unsigned* slot) {
    __syncthreads();
    if (threadIdx.x == 0) *slot = __hip_atomic_fetch_add(ctr, 1u, __ATOMIC_RELAXED, __HIP_MEMORY_SCOPE_AGENT);
    __syncthreads();
    return (int)*slot;
}
__device__ __forceinline__ void phase_scan(const Params& p, int l, int g, LAS unsigned char* lds) {
    unsigned* ctl = (unsigned*)(p.ws + WS_CTL);
#if DBG_TIMING == 3
#define ITEM_T(k, call) do { const unsigned long long ta_ = __builtin_amdgcn_s_memrealtime(); call; const unsigned long long tb_ = __builtin_amdgcn_s_memrealtime(); if (threadIdx.x == 0) { atomicMax(ctl + CW_DBG + 64 * (60 + (k)), (unsigned)(tb_ - ta_)); atomicAdd(ctl + CW_DBG + 64 * (63 + (k)), (unsigned)(tb_ - ta_)); } } while (0)
#else
#define ITEM_T(k, call) do { call; } while (0)
#endif
    unsigned* q0 = ctl + CW_Q + 64 * ((l * 2 + g) * 3);
    volatile LAS unsigned* slot = (volatile LAS unsigned*)(lds + LDS_MISC + 64);
    const int nlong = 4, nshort = nseq_of(g) - 4;
    const int total = (nlong + nshort) * 64;
    for (;;) {
        int it = queue_pop(q0, slot); if (it >= total) break;
        int sbase = 0, nsq = nlong;
        if (it >= nlong * 64) { it -= nlong * 64; sbase = nlong; nsq = nshort; }
        if (it < nsq * 16) {
            const Seq sq = seq_of(g, seq_index(g, sbase + (it >> 4))); const int sub = it & 15; ITEM_T(2, gla_item(p, l, sq, sub >> 2, (sub >> 1) & 1, sub & 1, lds));
        } else if (it < nsq * 48) { it -= nsq * 16;
            const Seq sq = seq_of(g, seq_index(g, sbase + (it >> 5))); const int sub = it & 31; ITEM_T(1, mlstm_item(p, l, sq, sub >> 3, (sub >> 2) & 1, sub & 3, lds));
        } else { it -= nsq * 48;
            const Seq sq = seq_of(g, seq_index(g, sbase + (it >> 4))); const int sub = it & 15; ITEM_T(0, lru_item(p, l, sq, sub >> 3, sub & 7, lds));
        }
    }
}

__device__ __forceinline__ float half_wave_sum(float v) {
#pragma unroll
    for (int o = 1; o < 32; o <<= 1) v += __shfl_xor(v, o);
    return v;
}
__device__ __forceinline__ void unpack8(const u32x4 q, float (&f)[8]) {
    f[0] = __uint_as_float(q.x << 16); f[1] = __uint_as_float(q.x & 0xffff0000u); f[2] = __uint_as_float(q.y << 16); f[3] = __uint_as_float(q.y & 0xffff0000u);
    f[4] = __uint_as_float(q.z << 16); f[5] = __uint_as_float(q.z & 0xffff0000u); f[6] = __uint_as_float(q.w << 16); f[7] = __uint_as_float(q.w & 0xffff0000u);
}
__device__ __forceinline__ void phase_combine(const Params& p, int l, int g) {
    const int tid_ = tidx(); const int lane = tid_ & 63, wave = tid_ >> 6;
    const int gw = blockIdx.x * 8 + wave, NGW = gridDim.x * 8;
    const bf16_t* Z = (const bf16_t*)(p.ws + WS_Z);
    const int tg = tg_of(g);
    f32x4 gn[2][2][2];
#pragma unroll
    for (int mx = 0; mx < 2; ++mx)
#pragma unroll
        for (int jj = 0; jj < 2; ++jj)
#pragma unroll
            for (int e = 0; e < 2; ++e) gn[mx][jj][e] = *(const f32x4*)(p.in[mx ? I_MNG : I_GNG] + l * 1024 + jj * 512 + lane * 8 + 4 * e);
    for (int tl = gw; tl < tg; tl += NGW) {
        u32x4 va[3][2], vb[3][2], vg[3][2];
#pragma unroll
        for (int mx = 0; mx < 3; ++mx) { const bf16_t* o0 = o_buf(p, 0, mx) + (size_t)tl * 1024; const bf16_t* o1 = o_buf(p, 1, mx) + (size_t)tl * 1024;
            const int gc = (mx == 0 ? ZC_GA : mx == 1 ? ZC_OB : ZC_YR);
#pragma unroll
            for (int jj = 0; jj < 2; ++jj) { const int c = jj * 512 + lane * 8; va[mx][jj] = *(const u32x4*)(o0 + c); vb[mx][jj] = *(const u32x4*)(o1 + c); vg[mx][jj] = *(const u32x4*)(Z + zoff(tl, gc + c)); } }
#pragma unroll
        for (int mx = 0; mx < 3; ++mx) { bf16_t* o0 = o_buf(p, 0, mx) + (size_t)tl * 1024;
#pragma unroll
            for (int jj = 0; jj < 2; ++jj) { const int c = jj * 512 + lane * 8; float a[8], b[8], gt[8], v[8], o[8];
                unpack8(va[mx][jj], a); unpack8(vb[mx][jj], b); unpack8(vg[mx][jj], gt);
#pragma unroll
                for (int e = 0; e < 8; ++e) v[e] = a[e] + b[e];
                if (mx < 2) {
                    float ss = 0.f;
#pragma unroll
                    for (int e = 0; e < 8; ++e) ss += v[e] * v[e];
                    const float rstd = rsqrtf(half_wave_sum(ss) * (1.f / 256.f) + EPS);
                    const f32x4 g0 = gn[mx][jj][0], g1 = gn[mx][jj][1];
#pragma unroll
                    for (int e = 0; e < 8; ++e) o[e] = v[e] * rstd * (e < 4 ? g0[e] : g1[e - 4]) * (mx ? sigmoid_f(gt[e]) : silu_f(gt[e]));
                } else {
#pragma unroll
                    for (int e = 0; e < 8; ++e) o[e] = v[e] * gelu_tanh_f(gt[e]);
                }
                u32x4 wv; wv.x = cvt_pk_bf16(o[0], o[1]); wv.y = cvt_pk_bf16(o[2], o[3]); wv.z = cvt_pk_bf16(o[4], o[5]); wv.w = cvt_pk_bf16(o[6], o[7]); *(u32x4*)(o0 + c) = wv; } }
    }
}

__device__ __forceinline__ void conv_ldcol(u32x4 (&col)[3], const bf16_t* Hc, int line_l0, int rstride, int q, int LL, bool rv0, bool rv2) {
    const bool okc = q >= 0 && q < LL; const int qc = okc ? q : 0; const unsigned mc = okc ? 0xffffffffu : 0u;
    { u32x4 v = *(const u32x4*)(Hc + ((size_t)(line_l0 + qc) << 8)); v.x &= mc; v.y &= mc; v.z &= mc; v.w &= mc; col[1] = v; }
    if (rv0) { u32x4 v = *(const u32x4*)(Hc + ((size_t)(line_l0 - rstride + qc) << 8)); v.x &= mc; v.y &= mc; v.z &= mc; v.w &= mc; col[0] = v; } else col[0] = (u32x4){0u, 0u, 0u, 0u};
    if (rv2) { u32x4 v = *(const u32x4*)(Hc + ((size_t)(line_l0 + rstride + qc) << 8)); v.x &= mc; v.y &= mc; v.z &= mc; v.w &= mc; col[2] = v; } else col[2] = (u32x4){0u, 0u, 0u, 0u};
}
__device__ __forceinline__ void conv_fma(float (&acc)[8], const float (&wk)[8], const u32x4 v) {
    acc[0] += wk[0] * __uint_as_float(v.x << 16); acc[1] += wk[1] * __uint_as_float(v.x & 0xffff0000u);
    acc[2] += wk[2] * __uint_as_float(v.y << 16); acc[3] += wk[3] * __uint_as_float(v.y & 0xffff0000u);
    acc[4] += wk[4] * __uint_as_float(v.z << 16); acc[5] += wk[5] * __uint_as_float(v.z & 0xffff0000u);
    acc[6] += wk[6] * __uint_as_float(v.w << 16); acc[7] += wk[7] * __uint_as_float(v.w & 0xffff0000u);
}
__device__ __forceinline__ void phase_convact(const Params& p, int l, int g) {
    const int tid_ = tidx(); const int lane = tid_ & 63, wave = tid_ >> 6;
    const int gw = blockIdx.x * 8 + wave, NGW = gridDim.x * 8;
    const bf16_t* H = (const bf16_t*)(p.ws + WS_Z); bf16_t* ACT = (bf16_t*)(p.ws + WS_O);
    const float* cwp = p.in[I_FCW] + (size_t)l * 9 * DFF; const float* cbp = p.in[I_FCB] + (size_t)l * DFF;
    const int gctx = gctx_of(g);
    for (int u = gw; u < (tg_of(g) / 32) * 11; u += NGW) {
        const int cc = u % 11, th = u / 11, f0 = cc * 512 + lane * 8;
        const int tl0 = th * 32;
        const bool ctx = tl0 < gctx;
        float wgt[9][8], bias[8];
#pragma unroll
        for (int k = 0; k < 9; ++k) { const f32x4 a = *(const f32x4*)(cwp + (size_t)k * DFF + f0), b = *(const f32x4*)(cwp + (size_t)k * DFF + f0 + 4);
#pragma unroll
            for (int e = 0; e < 4; ++e) { wgt[k][e] = a[e]; wgt[k][4 + e] = b[e]; } }
        { const f32x4 a = *(const f32x4*)(cbp + f0), b = *(const f32x4*)(cbp + f0 + 4);
#pragma unroll
            for (int e = 0; e < 4; ++e) { bias[e] = a[e]; bias[4 + e] = b[e]; } }
        int line_l0, q0, LL, rstride; bool rv0, rv2;
        if (ctx) { line_l0 = (tl0 >> 8) << 8; q0 = tl0 & 255; LL = 256; rstride = 0; rv0 = false; rv2 = false; }
        else { const int lt = tl0 - gctx, pos0 = lt & 4095, ry = pos0 >> 6; line_l0 = gctx + ((lt >> 12) << 12) + ry * 64; q0 = pos0 & 63; LL = 64; rstride = 64; rv0 = ry >= 1; rv2 = ry <= 62; }
        const bf16_t* Hc = H + zoff(0, f0);
        const bf16_t* Hu = H + zoff(0, DFF + f0);
        u32x4 c0[3], c1[3], c2[3], c3[3];
        conv_ldcol(c0, Hc, line_l0, rstride, q0 - 1, LL, rv0, rv2); conv_ldcol(c1, Hc, line_l0, rstride, q0, LL, rv0, rv2);
        conv_ldcol(c2, Hc, line_l0, rstride, q0 + 1, LL, rv0, rv2); conv_ldcol(c3, Hc, line_l0, rstride, q0 + 2, LL, rv0, rv2);
        u32x4 hur[4];
#pragma unroll
        for (int i = 0; i < 4; ++i) hur[i] = *(const u32x4*)(Hu + ((size_t)(tl0 + i) << 8));
#pragma unroll 4
        for (int x = 0; x < 32; ++x) {
            const u32x4 uv = hur[x & 3];
            hur[x & 3] = *(const u32x4*)(Hu + ((size_t)(tl0 + (x + 4 < 32 ? x + 4 : 31)) << 8));
            u32x4 cn[3]; conv_ldcol(cn, Hc, line_l0, rstride, q0 + x + 3, LL, rv0, rv2);
            float acc[8];
#pragma unroll
            for (int e = 0; e < 8; ++e) acc[e] = bias[e];
#pragma unroll
            for (int dy = 0; dy < 3; ++dy) { conv_fma(acc, wgt[dy * 3 + 0], c0[dy]); conv_fma(acc, wgt[dy * 3 + 1], c1[dy]); conv_fma(acc, wgt[dy * 3 + 2], c2[dy]); }
            float hu[8]; hu[0] = __uint_as_float(uv.x << 16); hu[1] = __uint_as_float(uv.x & 0xffff0000u); hu[2] = __uint_as_float(uv.y << 16); hu[3] = __uint_as_float(uv.y & 0xffff0000u);
            hu[4] = __uint_as_float(uv.z << 16); hu[5] = __uint_as_float(uv.z & 0xffff0000u); hu[6] = __uint_as_float(uv.w << 16); hu[7] = __uint_as_float(uv.w & 0xffff0000u);
            float o[8];
#pragma unroll
            for (int e = 0; e < 8; ++e) o[e] = silu_f(acc[e]) * hu[e];
            u32x4 wv; wv.x = cvt_pk_bf16(o[0], o[1]); wv.y = cvt_pk_bf16(o[2], o[3]); wv.z = cvt_pk_bf16(o[4], o[5]); wv.w = cvt_pk_bf16(o[6], o[7]);
            *(u32x4*)(ACT + (size_t)(tl0 + x) * DFF + f0) = wv;
#pragma unroll
            for (int dy = 0; dy < 3; ++dy) { c0[dy] = c1[dy]; c1[dy] = c2[dy]; c2[dy] = c3[dy]; c3[dy] = cn[dy]; }
        }
    }
}


#ifndef SKIPMASK
#define SKIPMASK 0
#endif
#define PH_SEL(bit, ...) { if constexpr (!((SKIPMASK >> (bit)) & 1)) { __VA_ARGS__ } }
#define PH_A(...) PH_SEL(0, __VA_ARGS__)
#define PH_B(...) PH_SEL(1, __VA_ARGS__)
#define PH_C(...) PH_SEL(2, __VA_ARGS__)
#define PH_D(...) PH_SEL(3, __VA_ARGS__)
#define PH_E(...) PH_SEL(4, __VA_ARGS__)
#define PH_G1(...) PH_SEL(5, __VA_ARGS__)
#define PH_G2(...) PH_SEL(6, __VA_ARGS__)
#define PH_G3(...) PH_SEL(7, __VA_ARGS__)
#define PH_G4(...) PH_SEL(8, __VA_ARGS__)
#define PH_G5(...) PH_SEL(9, __VA_ARGS__)
constexpr int N_PHASES = 49;
__global__ void __launch_bounds__(NTHREADS, 2) fwd_kernel(Params p) {
    extern __shared__ __attribute__((aligned(16))) unsigned char lds_raw[];
    LAS unsigned char* lds = (LAS unsigned char*)lds_raw;
    const int tid = threadIdx.x;
    volatile LAS unsigned* MISC = (volatile LAS unsigned*)(lds + LDS_MISC);
    if (tid < 32) MISC[tid] = 0u;
    __syncthreads();
    unsigned* ctl = (unsigned*)(p.ws + WS_CTL);
#if MK_PER_PHASE
#define GRID_BAR() do { } while (0)
#else
    XcdBarrier bar = xcd_barrier_post(ctl + CW_BAR, MISC + 8);
#define GRID_BAR() xcd_barrier(bar)
#endif
    const int lo = p.ph_lo, hi = p.ph_hi;
    const int G = gridDim.x, bx = blockIdx.x;
    const int vcu = (G % 8 == 0) ? (bx % 8) * (G / 8) + bx / 8 : bx;
#define IN(k) (lo <= (k) && (k) < hi)
#if DBG_TIMING
    unsigned long long t_last = __builtin_amdgcn_s_memrealtime(); unsigned t_acc[8] = {0u, 0u, 0u, 0u, 0u, 0u, 0u, 0u};
#define SEAMG(k, grp) do { if (IN(k) && IN((k) + 1)) GRID_BAR(); { const unsigned long long t_now = __builtin_amdgcn_s_memrealtime(); t_acc[grp] += (unsigned)(t_now - t_last); t_last = t_now; } } while (0)
#else
#define SEAMG(k, grp) do { if (IN(k) && IN((k) + 1)) GRID_BAR(); } while (0)
#endif

    if (IN(0)) { if (bx == 0 && tid < 12) ctl[CW_Q + 64 * tid] = 0u;
        PH_A(phase_mod(p, lds); __syncthreads(); phase_wconv(p, 0, lds);) }
    SEAMG(0, 0);
    for (int l = 0; l < 2; ++l) {
        const int base = 1 + 23 * l;
        if (IN(base)) { PH_A(if (l > 0) phase_wconv(p, l, lds);) }
        if (l > 0) SEAMG(base, 0);
        const float* mod_l = (const float*)(p.ws + WS_MOD) + (size_t)l * 9 * 12288;
        for (int g = 0; g < 2; ++g) {
            const int pb = base + 1 + 11 * g, tg = tg_of(g);
            if (IN(pb + 0)) { PH_B(phase_norm(p, l, g, 0, l == 0);) }
            SEAMG(pb + 0, 1);
            if (IN(pb + 1)) {
                pg8::Gemm gm{(const bf16_t*)(p.ws + WS_U), (const bf16_t*)(p.ws + W_IN), tg, NZ1, D}; pg8::StaticOrder S; S.init(tg, NZ1, G, bx);
                pg8::EpiZ E{(bf16_t*)(p.ws + WS_Z), (float*)(p.ws + WS_SM)};
                PH_G1(pg8::gemm_phase<pg8::EpiZ, pg8::StaticOrder, true, true>(lds, gm, S, E);)
            }
            SEAMG(pb + 1, 2);
            if (IN(pb + 2)) { PH_C(phase_scan(p, l, g, lds);) }
            SEAMG(pb + 2, 3);
            if (IN(pb + 4)) {
                pg8::Gemm gm{(const bf16_t*)(p.ws + WS_U8), (const bf16_t*)(p.ws + WS_WMG8), tg, 3 * D, D / 2}; pg8::StaticOrder S; S.init(tg, 3 * D, G, bx);
                pg8::EpiMG E{(bf16_t*)(p.ws + WS_Z), p.in[I_BMG] + (size_t)l * 3 * D, 1.f / 64.f};
                const bool comb_first = (bx & 1) != 0;
                if (comb_first) { PH_D(phase_combine(p, l, g);) }
                PH_G1(pg8::gemm_phase<pg8::EpiMG, pg8::StaticOrder, true, true, true>(lds, gm, S, E);)
                if (!comb_first) { PH_D(phase_combine(p, l, g);) }
            }
            SEAMG(pb + 4, 2);
            if (IN(pb + 5)) {
                pg8::Gemm gm{o_buf(p, 0, 0), (const bf16_t*)(p.ws + W_BR), 3 * TMAX, 3 * D, 1024}; pg8::BranchOrder S{G, vcu, tg / 256};
                pg8::EpiBranch E{(const bf16_t*)(p.ws + WS_Z), (float*)(p.ws + WS_SLAB) + (size_t)bx * 65536, (bf16_t*)(p.ws + WS_U)};
                PH_G2(pg8::gemm_phase<pg8::EpiBranch, pg8::BranchOrder, true, true>(lds, gm, S, E);)
            }
            SEAMG(pb + 5, 5);
            if (IN(pb + 6)) {
                pg8::Gemm gm{(const bf16_t*)(p.ws + WS_U), (const bf16_t*)(p.ws + W_OUT), tg, D, D}; pg8::StaticOrder S; S.init(tg, D, G, bx);
                const float* xc = l == 0 ? p.in[I_XP] : p.out + OUT_X; const float* xl = l == 0 ? p.in[I_XS] - (size_t)NCTX * D : p.out + OUT_X;
                pg8::EpiResid E{xc, xl, (bf16_t*)(p.out + OUT_X), mod_l, 2, g, l == 0 ? 1 : 0};
                PH_G3(pg8::gemm_phase<pg8::EpiResid, pg8::StaticOrder, true, true>(lds, gm, S, E);)
            }
            SEAMG(pb + 6, 5);
            if (IN(pb + 7)) { PH_B(phase_norm(p, l, g, 1, false);) }
            SEAMG(pb + 7, 1);
            if (IN(pb + 8)) {
                pg8::Gemm gm{(const bf16_t*)(p.ws + WS_U), (const bf16_t*)(p.ws + W_UP), tg, NUP, D}; pg8::StaticOrder S; S.init(tg, NUP, G, bx);
                pg8::EpiBf16 E{(bf16_t*)(p.ws + WS_Z), NUP};
                PH_G4(pg8::gemm_phase<pg8::EpiBf16, pg8::StaticOrder, true, true>(lds, gm, S, E);)
            }
            SEAMG(pb + 8, 6);
            if (IN(pb + 9)) { PH_E(phase_convact(p, l, g);) }
            SEAMG(pb + 9, 4);
            if (IN(pb + 10)) {
                pg8::Gemm gm{(const bf16_t*)(p.ws + WS_O), (const bf16_t*)(p.ws + W_DOWN), tg, D, DFF}; pg8::StaticOrder S; S.init(tg, D, G, bx);
                pg8::EpiResid E{nullptr, nullptr, (bf16_t*)(p.out + OUT_X), mod_l, 5, g, 0, p.ws, l == 1 ? 1 : 0};
                PH_G5(pg8::gemm_phase<pg8::EpiResid, pg8::StaticOrder, true, true>(lds, gm, S, E);)
            }
            SEAMG(pb + 10, 6);
        }
    }
    if (IN(48)) { PH_B(phase_final_norm(p);) }
#if DBG_TIMING
    {
        GRID_BAR();
        { const unsigned long long t_now = __builtin_amdgcn_s_memrealtime(); t_acc[1] += (unsigned)(t_now - t_last); }
        if (bx == 0 && tid == 0) { for (int k = 0; k < 7; ++k) ctl[CW_DBG + 64 * (40 + k)] = DBG_TIMING == 3 ? (k < 3 ? ctl[CW_DBG + 64 * (60 + k)] * 10u : k < 6 ? ctl[CW_DBG + 64 * (60 + k)] / 256u : t_acc[3]) : t_acc[k]; }
        GRID_BAR();
        const size_t offs[8] = {OUT_X, OUT_X + (size_t)NCTX * D, OUT_GLA, OUT_MC, OUT_MN, OUT_MM, OUT_LRU, OUT_END};
        for (int k = 0; k < 7; ++k) { int N = 1 + (int)(ctl[CW_DBG + 64 * (40 + k)] / DBG_TUNIT); if (N > (k == 5 ? 500 : 999)) N = (k == 5 ? 500 : 999);
            if (bx == 0) for (int i = tid; i < N; i += NTHREADS) p.out[offs[k] + i] = __uint_as_float(0xAAAAAAAAu); }
    }
#endif
#undef IN
#undef SEAM
}

extern "C" void kernel_launch(void* const* d_in, const int* in_sizes, int n_in, void* d_out, int out_size, void* d_ws, size_t ws_size, hipStream_t stream) {
    static int grid = 0;
    if (grid == 0) {
        if (ws_size < WS_END) { fprintf(stderr, "kernel_launch: unexpected shapes (n_in %d out %d ws %zu)\n", n_in, out_size, ws_size); grid = -1; return; }
        int dev = 0, cus = 0;
        if (hipGetDevice(&dev) != hipSuccess || hipDeviceGetAttribute(&cus, hipDeviceAttributeMultiprocessorCount, dev) != hipSuccess) { grid = -1; return; }
        if (hipFuncSetAttribute((const void*)fwd_kernel, hipFuncAttributeMaxDynamicSharedMemorySize, LDS_BYTES) != hipSuccess) { fprintf(stderr, "kernel_launch: hipFuncSetAttribute failed\n"); grid = -1; return; }
        int per_cu = 0;
        if (hipOccupancyMaxActiveBlocksPerMultiprocessor(&per_cu, (const void*)fwd_kernel, NTHREADS, LDS_BYTES) != hipSuccess || per_cu < 1) { fprintf(stderr, "kernel_launch: occupancy query says %d\n", per_cu); (void)hipGetLastError(); grid = -1; return; }
        grid = cus;
    }
    if (grid < 0) return;
    (void)hipMemsetAsync((char*)d_ws + WS_CTL, 0, CTL_BYTES, stream);
    Params p{};
    for (int i = 0; i < 32; ++i) p.in[i] = (const float*)d_in[i];
    p.out = (float*)d_out; p.ws = (unsigned char*)d_ws;
#if MK_PER_PHASE
    for (int ph = 0; ph < N_PHASES; ++ph) { if (ph == 1) continue; p.ph_lo = ph; p.ph_hi = ph + 1; hipLaunchKernelGGL(fwd_kernel, dim3(grid), dim3(NTHREADS), LDS_BYTES, stream, p); }
#else
    p.ph_lo = 0; p.ph_hi = N_PHASES;
    hipLaunchKernelGGL(fwd_kernel, dim3(grid), dim3(NTHREADS), LDS_BYTES, stream, p);
#endif
}
```
